# Optimizing an MI355X kernel written in HIP

```python
import jax, jax.numpy as jnp
from jax import lax
import numpy as np

D_MODEL = 2048
BATCH = 4
SEQ = 2048
DEPTH = 1

CHUNK = 64
HEAD_DIM = 128
N_MIX_HEADS = D_MODEL // HEAD_DIM
SB_HEADS = N_MIX_HEADS // 2
RET_HEADS = N_MIX_HEADS - SB_HEADS
SB_WIDTH = SB_HEADS * HEAD_DIM
RET_WIDTH = RET_HEADS * HEAD_DIM
MIX_WIDTH = SB_WIDTH + RET_WIDTH
IN_WIDTH = 3 * SB_WIDTH + 4 * RET_WIDTH
Q_BLOCK = 128
ROPE_THETA = 10000.0
PEER_HEADS = 8
PEER_KEYS = 128
PEER_EXPERTS = PEER_KEYS * PEER_KEYS
PEER_KEY_DIM = 256
PEER_HALF = PEER_KEY_DIM // 2
PEER_TOPK = 16
PEER_TOKEN_BLOCK = 128
LN_EPS = 1e-5
NORM_EPS = 1e-6
DEEPNORM_ALPHA = (2.0 * DEPTH) ** 0.25
DEEPNORM_BETA = (8.0 * DEPTH) ** -0.25

kernel_name = 'hybrid_sb_retention_peer_block'


def layer_norm(x, w, b):
    xf = x.astype(jnp.float32)
    mu = jnp.mean(xf, -1, keepdims=True)
    var = jnp.mean(jnp.square(xf - mu), -1, keepdims=True)
    y = (xf - mu) * lax.rsqrt(var + LN_EPS) * w.astype(jnp.float32) + b.astype(jnp.float32)
    return y.astype(x.dtype)


def to_heads(t, n_heads):
    b, s, _ = t.shape
    return t.reshape(b, s, n_heads, HEAD_DIM).transpose(0, 2, 1, 3).astype(jnp.float32)


def from_heads(t):
    b, h, s, d = t.shape
    return t.transpose(0, 2, 1, 3).reshape(b, s, h * d)


def rotary(t):
    s, d = t.shape[2], t.shape[3]
    inv_freq = ROPE_THETA ** (-jnp.arange(0, d, 2, dtype=jnp.float32) / d)
    ang = jnp.arange(s, dtype=jnp.float32)[:, None] * inv_freq[None, :]
    ang = jnp.concatenate([ang, ang], -1)
    t1, t2 = jnp.split(t, 2, axis=-1)
    return t * jnp.cos(ang) + jnp.concatenate([-t2, t1], -1) * jnp.sin(ang)


def stick_breaking_attention(q, k, v):
    b, h, s, d = q.shape
    scale = d ** -0.5
    outs = []
    for blk in range(s // Q_BLOCK):
        q0 = blk * Q_BLOCK
        kv_len = q0 + Q_BLOCK
        z = jnp.einsum('bhqd,bhkd->bhqk', q[:, :, q0:kv_len], k[:, :, :kv_len]) * scale
        q_pos = q0 + jnp.arange(Q_BLOCK)[:, None]
        k_pos = jnp.arange(kv_len)[None, :]
        mask = k_pos < q_pos
        log_1mb = jnp.where(mask, jax.nn.log_sigmoid(-z), 0.0)
        incl = jnp.cumsum(log_1mb, axis=-1)
        log_a = jax.nn.log_sigmoid(z) + incl[..., -1:] - incl
        a = jnp.where(mask, jnp.exp(log_a), 0.0)
        outs.append(jnp.einsum('bhqk,bhkd->bhqd', a, v[:, :, :kv_len]))
    return jnp.concatenate(outs, axis=2)


def retention(q, k, v):
    b, h, s, d = q.shape
    nc = s // CHUNK
    log_g = jnp.log1p(-(2.0 ** (-5.0 - jnp.arange(h, dtype=jnp.float32))))
    idx = jnp.arange(CHUNK, dtype=jnp.float32)
    intra_decay = jnp.exp(log_g[:, None, None] * jnp.abs(idx[:, None] - idx[None, :]))
    xi = jnp.exp(log_g[:, None] * (idx + 1.0))
    zeta = jnp.exp(log_g[:, None] * (CHUNK - 1.0 - idx))
    chunk_decay = jnp.exp(log_g * CHUNK)
    qc = q.reshape(b, h, nc, CHUNK, d)
    kc = (k * d ** -0.5).reshape(b, h, nc, CHUNK, d)
    vc = v.reshape(b, h, nc, CHUNK, v.shape[-1])
    scores = jnp.einsum('bhnid,bhnjd->bhnij', qc, kc) * intra_decay[None, :, None]
    intra = jnp.einsum('bhnij,bhnjv->bhniv', scores, vc)
    kv = jnp.einsum('bhnjd,bhnjv->nbhdv', kc * zeta[None, :, None, :, None], vc)

    def step(state, kv_n):
        return state * chunk_decay[None, :, None, None] + kv_n, state

    _, prev = lax.scan(step, jnp.zeros(kv.shape[1:], kv.dtype), kv)
    inter = jnp.einsum('bhnid,nbhdv->bhniv', qc, prev) * xi[None, :, None, :, None]
    return (intra + inter).reshape(b, h, s, -1)


def token_mixer(x, w_in, sb_norm_w, ret_norm_w, w_out):
    b, s, _ = x.shape
    proj = x @ w_in
    cuts = [SB_WIDTH, 2 * SB_WIDTH, 3 * SB_WIDTH, 3 * SB_WIDTH + RET_WIDTH,
            3 * SB_WIDTH + 2 * RET_WIDTH, 3 * SB_WIDTH + 3 * RET_WIDTH]
    sb_q, sb_k, sb_v, r_q, r_k, r_v, r_g = jnp.split(proj, cuts, axis=-1)
    sb = stick_breaking_attention(to_heads(sb_q, SB_HEADS), to_heads(sb_k, SB_HEADS), to_heads(sb_v, SB_HEADS))
    sb = sb * lax.rsqrt(jnp.mean(jnp.square(sb), -1, keepdims=True) + NORM_EPS)
    sb = from_heads(sb) * sb_norm_w.astype(jnp.float32)
    ret = retention(rotary(to_heads(r_q, RET_HEADS)), rotary(to_heads(r_k, RET_HEADS)), to_heads(r_v, RET_HEADS))
    mu = jnp.mean(ret, -1, keepdims=True)
    var = jnp.mean(jnp.square(ret - mu), -1, keepdims=True)
    ret = from_heads((ret - mu) * lax.rsqrt(var + NORM_EPS)) * ret_norm_w.astype(jnp.float32)
    ret = jax.nn.silu(r_g.astype(jnp.float32)) * ret
    mixed = jnp.concatenate([sb, ret], axis=-1).astype(x.dtype)
    return mixed @ w_out


def peer_ffn(x, w_pq, sub_keys, expert_u, expert_v):
    b, s, d = x.shape
    n_tok = b * s
    xt = x.reshape(n_tok, d)
    q = (xt @ w_pq).reshape(n_tok, PEER_HEADS, 2, PEER_HALF).astype(jnp.float32)
    scores = jnp.einsum('thcd,hckd->thck', q, sub_keys.astype(jnp.float32))
    s_top, i_top = lax.top_k(scores, PEER_TOPK)
    cand = (s_top[:, :, 0, :, None] + s_top[:, :, 1, None, :]).reshape(n_tok, PEER_HEADS, PEER_TOPK * PEER_TOPK)
    cand_idx = (i_top[:, :, 0, :, None] * PEER_KEYS + i_top[:, :, 1, None, :]).reshape(n_tok, PEER_HEADS, PEER_TOPK * PEER_TOPK)
    best, pos = lax.top_k(cand, PEER_TOPK)
    expert_idx = jnp.take_along_axis(cand_idx, pos, axis=-1)
    gate = jax.nn.softmax(best, axis=-1)
    nb = n_tok // PEER_TOKEN_BLOCK

    def block(args):
        xb, idx_b, g_b = args
        u = jnp.take(expert_u, idx_b, axis=0)
        act = jax.nn.gelu(jnp.einsum('thkd,td->thk', u, xb).astype(jnp.float32), approximate=False)
        v = jnp.take(expert_v, idx_b, axis=0)
        return jnp.einsum('thk,thkd->td', (g_b * act).astype(v.dtype), v)

    out = lax.map(block, (xt.reshape(nb, PEER_TOKEN_BLOCK, d),
                          expert_idx.reshape(nb, PEER_TOKEN_BLOCK, PEER_HEADS, PEER_TOPK),
                          gate.reshape(nb, PEER_TOKEN_BLOCK, PEER_HEADS, PEER_TOPK)))
    return out.reshape(b, s, d).astype(x.dtype)


def setup_inputs(seed: int = 0) -> dict:
    key = jax.random.key(seed)
    ks = jax.random.split(key, 14)
    f32 = jnp.float32

    def nrm(k, shape, scale):
        return scale * jax.random.normal(k, shape, f32)

    return {
        'x': jax.random.normal(ks[0], (BATCH, SEQ, D_MODEL), f32),
        'w_in': nrm(ks[1], (DEPTH, D_MODEL, IN_WIDTH), D_MODEL ** -0.5),
        'sb_norm_w': 1.0 + nrm(ks[2], (DEPTH, SB_WIDTH), 0.02),
        'ret_norm_w': 1.0 + nrm(ks[3], (DEPTH, RET_WIDTH), 0.02),
        'w_out': nrm(ks[4], (DEPTH, MIX_WIDTH, D_MODEL), DEEPNORM_BETA * MIX_WIDTH ** -0.5),
        'ln1_w': 1.0 + nrm(ks[5], (DEPTH, D_MODEL), 0.02),
        'ln1_b': nrm(ks[6], (DEPTH, D_MODEL), 0.02),
        'w_pq': nrm(ks[7], (DEPTH, D_MODEL, PEER_HEADS * PEER_KEY_DIM), D_MODEL ** -0.5),
        'sub_keys': nrm(ks[8], (DEPTH, PEER_HEADS, 2, PEER_KEYS, PEER_HALF), PEER_HALF ** -0.5),
        'expert_u': nrm(ks[9], (DEPTH, PEER_EXPERTS, D_MODEL), D_MODEL ** -0.5),
        'expert_v': nrm(ks[10], (DEPTH, PEER_EXPERTS, D_MODEL), DEEPNORM_BETA),
        'ln2_w': 1.0 + nrm(ks[11], (DEPTH, D_MODEL), 0.02),
        'ln2_b': nrm(ks[12], (DEPTH, D_MODEL), 0.02),
    }


def reference(x, w_in, sb_norm_w, ret_norm_w, w_out, ln1_w, ln1_b, w_pq, sub_keys,
              expert_u, expert_v, ln2_w, ln2_b):
    for layer in range(DEPTH):
        mix = token_mixer(x, w_in[layer], sb_norm_w[layer], ret_norm_w[layer], w_out[layer])
        x = layer_norm(DEEPNORM_ALPHA * x + mix, ln1_w[layer], ln1_b[layer])
        ffn = peer_ffn(x, w_pq[layer], sub_keys[layer], expert_u[layer], expert_v[layer])
        x = layer_norm(DEEPNORM_ALPHA * x + ffn, ln2_w[layer], ln2_b[layer])
    return x
```

```cpp
#include <hip/hip_runtime.h>
#include <math.h>
#include <stdint.h>

namespace {
constexpr int D = 2048, NB = 4, S = 2048, T = NB * S, HD = 128, INW = 7168;
constexpr int NKEYS = 128, TOPK = 16, PH = 8;
constexpr float ALPHA = 1.189207115002721f;

__device__ __forceinline__ float wave_sum(float v) {
#pragma unroll
  for (int o = 32; o > 0; o >>= 1) v += __shfl_xor(v, o);
  return v;
}
__device__ __forceinline__ float wave_max(float v) {
#pragma unroll
  for (int o = 32; o > 0; o >>= 1) v = fmaxf(v, __shfl_xor(v, o));
  return v;
}
__device__ __forceinline__ int wave_min_i(int v) {
#pragma unroll
  for (int o = 32; o > 0; o >>= 1) v = min(v, __shfl_xor(v, o));
  return v;
}

__global__ __launch_bounds__(256) void k_gemm(const float* __restrict__ A, const float* __restrict__ Bm, float* __restrict__ C, int M, int N, int K) {
  __shared__ float As[16][68];
  __shared__ float Bs[16][68];
  const int tx = threadIdx.x & 15, ty = threadIdx.x >> 4;
  const int m0 = blockIdx.y * 64, n0 = blockIdx.x * 64;
  float acc[4][4];
#pragma unroll
  for (int i = 0; i < 4; ++i)
#pragma unroll
    for (int j = 0; j < 4; ++j) acc[i][j] = 0.f;
  for (int k0 = 0; k0 < K; k0 += 16) {
    {
      const int r = threadIdx.x >> 2, c = (threadIdx.x & 3) * 4;
      const float4 v = *(const float4*)(A + (size_t)(m0 + r) * K + k0 + c);
      As[c][r] = v.x; As[c + 1][r] = v.y; As[c + 2][r] = v.z; As[c + 3][r] = v.w;
    }
    {
      const int r = threadIdx.x >> 4, c = (threadIdx.x & 15) * 4;
      const float4 v = *(const float4*)(Bm + (size_t)(k0 + r) * N + n0 + c);
      *(float4*)&Bs[r][c] = v;
    }
    __syncthreads();
#pragma unroll
    for (int kk = 0; kk < 16; ++kk) {
      const float4 a = *(const float4*)&As[kk][ty * 4];
      const float4 b = *(const float4*)&Bs[kk][tx * 4];
      const float av[4] = {a.x, a.y, a.z, a.w}, bv[4] = {b.x, b.y, b.z, b.w};
#pragma unroll
      for (int i = 0; i < 4; ++i)
#pragma unroll
        for (int j = 0; j < 4; ++j) acc[i][j] += av[i] * bv[j];
    }
    __syncthreads();
  }
#pragma unroll
  for (int i = 0; i < 4; ++i) {
    float4 v = {acc[i][0], acc[i][1], acc[i][2], acc[i][3]};
    *(float4*)(C + (size_t)(m0 + ty * 4 + i) * N + n0 + tx * 4) = v;
  }
}

__global__ __launch_bounds__(256) void k_rot(const float* __restrict__ proj, float* __restrict__ rq, float* __restrict__ rk) {
  const int gid = blockIdx.x * 256 + threadIdx.x;
  const int row = gid >> 10, col = gid & 1023;
  const int d = col & 127, i = d & 63;
  const int s = row & (S - 1);
  const float inv_freq = (float)pow(10000.0, -(2.0 * i) / 128.0);
  const float ang = (float)s * inv_freq;
  const float cs = (float)cos((double)ang), sn = (float)sin((double)ang);
  const float* pq = proj + (size_t)row * INW + 3072 + col;
  const float* pk = proj + (size_t)row * INW + 4096 + col;
  const float q = pq[0], k = pk[0];
  float qo, ko;
  if (d < 64) { qo = -pq[64]; ko = -pk[64]; } else { qo = pq[-64]; ko = pk[-64]; }
  rq[gid] = q * cs + qo * sn;
  rk[gid] = k * cs + ko * sn;
}

__global__ __launch_bounds__(256) void k_sb(const float* __restrict__ proj, const float* __restrict__ sbw, float* __restrict__ mixed) {
  const int w = blockIdx.x * 4 + (threadIdx.x >> 6), lane = threadIdx.x & 63;
  const int t = w & (S - 1), h = (w >> 11) & 7, b = w >> 14;
  const float* base = proj + (size_t)b * S * INW + h * HD + lane * 2;
  const float2 q = *(const float2*)(base + (size_t)t * INW);
  float2 o = {0.f, 0.f};
  float run = 0.f;
  const float scale = 0.08838834764831845f;
  for (int s = t - 1; s >= 0; --s) {
    const float2 k = *(const float2*)(base + (size_t)s * INW + 1024);
    const float2 v = *(const float2*)(base + (size_t)s * INW + 2048);
    const float z = wave_sum(q.x * k.x + q.y * k.y) * scale;
    const float l1p = log1pf(expf(-fabsf(z)));
    const float sp = fmaxf(z, 0.f) + l1p;
    const float ls = fminf(z, 0.f) - l1p;
    const float a = expf(ls - run);
    o.x += a * v.x; o.y += a * v.y;
    run += sp;
    if (run > 104.f) break;
  }
  const float ms = wave_sum(o.x * o.x + o.y * o.y) * (1.f / 128.f);
  const float r = rsqrtf(ms + 1e-6f);
  const float2 wv = *(const float2*)(sbw + h * HD + lane * 2);
  float2 res = {o.x * r * wv.x, o.y * r * wv.y};
  *(float2*)(mixed + (size_t)(b * S + t) * D + h * HD + lane * 2) = res;
}

__global__ __launch_bounds__(256) void k_ret(const float* __restrict__ proj, const float* __restrict__ rq, const float* __restrict__ rk,
                                              const float* __restrict__ rnw, float* __restrict__ mixed) {
  const int w = blockIdx.x * 4 + (threadIdx.x >> 6), lane = threadIdx.x & 63;
  const int t = w & (S - 1), h = (w >> 11) & 7, b = w >> 14;
  const size_t rowb = (size_t)b * S;
  const float2 q = *(const float2*)(rq + (rowb + t) * 1024 + h * HD + lane * 2);
  const float log_g = log1pf(-exp2f(-5.f - (float)h));
  const float scale = 0.08838834764831845f;
  const int s_end = ((t >> 6) + 1) << 6;
  float2 o = {0.f, 0.f};
  for (int s = 0; s < s_end; ++s) {
    const float2 k = *(const float2*)(rk + (rowb + s) * 1024 + h * HD + lane * 2);
    const float2 v = *(const float2*)(proj + (rowb + s) * INW + 5120 + h * HD + lane * 2);
    const float dist = fabsf((float)(t - s));
    const float z = wave_sum(q.x * k.x + q.y * k.y) * scale * expf(log_g * dist);
    o.x += z * v.x; o.y += z * v.y;
  }
  const float mu = wave_sum(o.x + o.y) * (1.f / 128.f);
  const float dx = o.x - mu, dy = o.y - mu;
  const float var = wave_sum(dx * dx + dy * dy) * (1.f / 128.f);
  const float r = rsqrtf(var + 1e-6f);
  const float2 wv = *(const float2*)(rnw + h * HD + lane * 2);
  const float2 g = *(const float2*)(proj + (rowb + t) * INW + 6144 + h * HD + lane * 2);
  const float sx = g.x / (1.f + expf(-g.x)), sy = g.y / (1.f + expf(-g.y));
  float2 res = {dx * r * wv.x * sx, dy * r * wv.y * sy};
  *(float2*)(mixed + (rowb + t) * D + 1024 + h * HD + lane * 2) = res;
}

__global__ __launch_bounds__(256) void k_ln(const float* __restrict__ xin, const float* __restrict__ add, const float* __restrict__ w,
                                             const float* __restrict__ bb, float* __restrict__ out) {
  __shared__ float red[8];
  const int row = blockIdx.x, tid = threadIdx.x;
  float y[8];
#pragma unroll
  for (int i = 0; i < 2; ++i) {
    const float4 a = *(const float4*)(xin + (size_t)row * D + i * 1024 + tid * 4);
    const float4 m = *(const float4*)(add + (size_t)row * D + i * 1024 + tid * 4);
    y[i * 4 + 0] = ALPHA * a.x + m.x; y[i * 4 + 1] = ALPHA * a.y + m.y; y[i * 4 + 2] = ALPHA * a.z + m.z; y[i * 4 + 3] = ALPHA * a.w + m.w;
  }
  float s = 0.f;
#pragma unroll
  for (int i = 0; i < 8; ++i) s += y[i];
  s = wave_sum(s);
  if ((tid & 63) == 0) red[tid >> 6] = s;
  __syncthreads();
  const float mu = (red[0] + red[1] + red[2] + red[3]) * (1.f / D);
  float q = 0.f;
#pragma unroll
  for (int i = 0; i < 8; ++i) { const float d = y[i] - mu; q += d * d; }
  q = wave_sum(q);
  if ((tid & 63) == 0) red[4 + (tid >> 6)] = q;
  __syncthreads();
  const float var = (red[4] + red[5] + red[6] + red[7]) * (1.f / D);
  const float r = rsqrtf(var + 1e-5f);
#pragma unroll
  for (int i = 0; i < 2; ++i) {
    const float4 wv = *(const float4*)(w + i * 1024 + tid * 4);
    const float4 bv = *(const float4*)(bb + i * 1024 + tid * 4);
    float4 o;
    o.x = (y[i * 4 + 0] - mu) * r * wv.x + bv.x; o.y = (y[i * 4 + 1] - mu) * r * wv.y + bv.y;
    o.z = (y[i * 4 + 2] - mu) * r * wv.z + bv.z; o.w = (y[i * 4 + 3] - mu) * r * wv.w + bv.w;
    *(float4*)(out + (size_t)row * D + i * 1024 + tid * 4) = o;
  }
}

__global__ __launch_bounds__(256) void k_route(const float* __restrict__ qp, const float* __restrict__ sk, int* __restrict__ eidx, float* __restrict__ egate) {
  __shared__ float s_top[4][2][16];
  __shared__ int i_top[4][2][16];
  const int wv = threadIdx.x >> 6, lane = threadIdx.x & 63;
  const int th = blockIdx.x * 4 + wv;
  const int t = th >> 3, h = th & 7;
  const float NEG = -3.0e38f;
#pragma unroll 1
  for (int c = 0; c < 2; ++c) {
    const float* q = qp + (size_t)t * D + h * 256 + c * 128;
    const float* k0 = sk + ((size_t)((h * 2 + c) * NKEYS + lane)) * 128;
    const float* k1 = k0 + 64 * 128;
    float v0 = 0.f, v1 = 0.f;
    for (int d = 0; d < 128; d += 4) {
      const float4 qq = *(const float4*)(q + d);
      const float4 a = *(const float4*)(k0 + d);
      const float4 bq = *(const float4*)(k1 + d);
      v0 += qq.x * a.x + qq.y * a.y + qq.z * a.z + qq.w * a.w;
      v1 += qq.x * bq.x + qq.y * bq.y + qq.z * bq.z + qq.w * bq.w;
    }
    for (int it = 0; it < 16; ++it) {
      const float m = wave_max(fmaxf(v0, v1));
      int cand = 9999;
      if (v1 == m) cand = lane + 64;
      if (v0 == m) cand = lane;
      const int sel = wave_min_i(cand);
      if (sel == lane) v0 = NEG;
      if (sel == lane + 64) v1 = NEG;
      if (lane == 0) { s_top[wv][c][it] = m; i_top[wv][c][it] = sel; }
    }
  }
  __syncthreads();
  float cv[4];
#pragma unroll
  for (int j = 0; j < 4; ++j) { const int n = lane * 4 + j; cv[j] = s_top[wv][0][n >> 4] + s_top[wv][1][n & 15]; }
  float mybest = 0.f; int mypos = 0;
  for (int it = 0; it < 16; ++it) {
    float lm = fmaxf(fmaxf(cv[0], cv[1]), fmaxf(cv[2], cv[3]));
    const float m = wave_max(lm);
    int cand = 9999;
#pragma unroll
    for (int j = 3; j >= 0; --j) if (cv[j] == m) cand = lane * 4 + j;
    const int sel = wave_min_i(cand);
#pragma unroll
    for (int j = 0; j < 4; ++j) if (sel == lane * 4 + j) cv[j] = NEG;
    if (lane == it) { mybest = m; mypos = sel; }
  }
  const float mx = __shfl(mybest, 0);
  float e = (lane < 16) ? expf(mybest - mx) : 0.f;
  const float den = wave_sum(e);
  if (lane < 16) {
    const int ex = i_top[wv][0][mypos >> 4] * NKEYS + i_top[wv][1][mypos & 15];
    eidx[(size_t)th * 16 + lane] = ex;
    egate[(size_t)th * 16 + lane] = e / den;
  }
}

__global__ __launch_bounds__(256) void k_peer(const float* __restrict__ x1, const int* __restrict__ eidx, const float* __restrict__ egate,
                                               const float* __restrict__ eu, const float* __restrict__ ev, const float* __restrict__ w,
                                               const float* __restrict__ bb, float* __restrict__ out) {
  __shared__ float xs[D];
  __shared__ float hh[128];
  __shared__ int ei[128];
  __shared__ float red[8];
  const int t = blockIdx.x, tid = threadIdx.x, wv = tid >> 6, lane = tid & 63;
#pragma unroll
  for (int i = 0; i < 2; ++i) *(float4*)&xs[i * 1024 + tid * 4] = *(const float4*)(x1 + (size_t)t * D + i * 1024 + tid * 4);
  if (tid < 128) ei[tid] = eidx[(size_t)t * 128 + tid];
  __syncthreads();
  for (int a = wv * 32; a < wv * 32 + 32; ++a) {
    const float* u = eu + (size_t)ei[a] * D;
    float s = 0.f;
#pragma unroll
    for (int i = 0; i < 8; ++i) {
      const float4 uv = *(const float4*)(u + (i * 64 + lane) * 4);
      const float4 xv = *(const float4*)&xs[(i * 64 + lane) * 4];
      s += uv.x * xv.x + uv.y * xv.y + uv.z * xv.z + uv.w * xv.w;
    }
    s = wave_sum(s);
    const float act = 0.5f * s * (1.f + erff(s * 0.7071067811865476f));
    if (lane == 0) hh[a] = egate[(size_t)t * 128 + a] * act;
  }
  __syncthreads();
  float acc[8];
#pragma unroll
  for (int i = 0; i < 8; ++i) acc[i] = 0.f;
  for (int a = 0; a < 128; ++a) {
    const float* v = ev + (size_t)ei[a] * D;
    const float g = hh[a];
    const float4 v0 = *(const float4*)(v + tid * 4);
    const float4 v1 = *(const float4*)(v + 1024 + tid * 4);
    acc[0] += g * v0.x; acc[1] += g * v0.y; acc[2] += g * v0.z; acc[3] += g * v0.w;
    acc[4] += g * v1.x; acc[5] += g * v1.y; acc[6] += g * v1.z; acc[7] += g * v1.w;
  }
  float y[8];
#pragma unroll
  for (int i = 0; i < 8; ++i) y[i] = ALPHA * xs[(i >> 2) * 1024 + tid * 4 + (i & 3)] + acc[i];
  float s = 0.f;
#pragma unroll
  for (int i = 0; i < 8; ++i) s += y[i];
  s = wave_sum(s);
  if (lane == 0) red[wv] = s;
  __syncthreads();
  const float mu = (red[0] + red[1] + red[2] + red[3]) * (1.f / D);
  float q = 0.f;
#pragma unroll
  for (int i = 0; i < 8; ++i) { const float d = y[i] - mu; q += d * d; }
  q = wave_sum(q);
  if (lane == 0) red[4 + wv] = q;
  __syncthreads();
  const float var = (red[4] + red[5] + red[6] + red[7]) * (1.f / D);
  const float r = rsqrtf(var + 1e-5f);
#pragma unroll
  for (int i = 0; i < 2; ++i) {
    const float4 wv4 = *(const float4*)(w + i * 1024 + tid * 4);
    const float4 bv = *(const float4*)(bb + i * 1024 + tid * 4);
    float4 o;
    o.x = (y[i * 4 + 0] - mu) * r * wv4.x + bv.x; o.y = (y[i * 4 + 1] - mu) * r * wv4.y + bv.y;
    o.z = (y[i * 4 + 2] - mu) * r * wv4.z + bv.z; o.w = (y[i * 4 + 3] - mu) * r * wv4.w + bv.w;
    *(float4*)(out + (size_t)t * D + i * 1024 + tid * 4) = o;
  }
}
}

extern "C" void kernel_launch(void* const* d_in, const int* in_sizes, int n_in, void* d_out, int out_size, void* d_ws, size_t ws_size,
                              hipStream_t stream) {
  const float* x = (const float*)d_in[0];
  const float* w_in = (const float*)d_in[1];
  const float* sbw = (const float*)d_in[2];
  const float* rnw = (const float*)d_in[3];
  const float* w_out = (const float*)d_in[4];
  const float* ln1w = (const float*)d_in[5];
  const float* ln1b = (const float*)d_in[6];
  const float* w_pq = (const float*)d_in[7];
  const float* sk = (const float*)d_in[8];
  const float* eu = (const float*)d_in[9];
  const float* ev = (const float*)d_in[10];
  const float* ln2w = (const float*)d_in[11];
  const float* ln2b = (const float*)d_in[12];
  float* out = (float*)d_out;
  char* ws = (char*)d_ws;
  const size_t MiB = 1024 * 1024;
  float* proj = (float*)(ws);
  float* rq = (float*)(ws + 224 * MiB);
  float* rk = (float*)(ws + 256 * MiB);
  float* mixed = (float*)(ws + 288 * MiB);
  int* eidx = (int*)(ws + 352 * MiB);
  float* egate = (float*)(ws + 356 * MiB);
  float* mix = (float*)(ws);
  float* x1 = (float*)(ws + 64 * MiB);
  float* qp = (float*)(ws + 128 * MiB);

  k_gemm<<<dim3(INW / 64, T / 64), 256, 0, stream>>>(x, w_in, proj, T, INW, D);
  k_rot<<<T * 1024 / 256, 256, 0, stream>>>(proj, rq, rk);
  k_sb<<<NB * 8 * S / 4, 256, 0, stream>>>(proj, sbw, mixed);
  k_ret<<<NB * 8 * S / 4, 256, 0, stream>>>(proj, rq, rk, rnw, mixed);
  k_gemm<<<dim3(D / 64, T / 64), 256, 0, stream>>>(mixed, w_out, mix, T, D, D);
  k_ln<<<T, 256, 0, stream>>>(x, mix, ln1w, ln1b, x1);
  k_gemm<<<dim3(D / 64, T / 64), 256, 0, stream>>>(x1, w_pq, qp, T, D, D);
  k_route<<<T * PH / 4, 256, 0, stream>>>(qp, sk, eidx, egate);
  k_peer<<<T, 256, 0, stream>>>(x1, eidx, egate, eu, ev, ln2w, ln2b, out);
}
```

```cpp
#include <hip/hip_runtime.h>
#include <stdint.h>
#include <math.h>
#define MK_N_LAUNCHES 9
namespace pg8 {
#define PG8_LAS __attribute__((address_space(3)))
typedef unsigned short bf16_t;
typedef short bf16x8 __attribute__((ext_vector_type(8)));
typedef float f32x4 __attribute__((ext_vector_type(4)));
typedef unsigned u32x4 __attribute__((ext_vector_type(4)));
constexpr int BM = 256, BK = 64, HALF = 128, HTB = HALF * BK * 2  , STAGE_BYTES = 8 * HTB, NXCD = 8, WGM = 8;

__host__ __device__ __forceinline__ int lds_byte(int r, int c) { const int st = (r >> 4) * 2 + (c >> 5), rr = r & 15, cc = c & 31, ob = rr * 64 + cc * 2; return st * 1024 + (ob ^ (((ob >> 9) & 1) << 5)); }
__host__ __device__ __forceinline__ void stage_rc(int b, int& R, int& C) { const int st = b / 1024, sb = b % 1024, swz = sb ^ (((sb >> 9) & 1) << 5); R = (st >> 1) * 16 + swz / 64; C = (st & 1) * 32 + (swz % 64) / 2; }
__host__ __device__ __forceinline__ int perm32(int rho) { const int n = rho >> 4, i = rho & 15; return 8 * (i >> 2) + 4 * n + (i & 3); }

struct Unit { int pm, pn; };
struct Gemm { const bf16_t* A; const bf16_t* Bt; int M, N, K; };

struct StaticOrder {
    int nM, nN, nwg, G, c;
    __host__ __device__ void init(int M, int N, int G_, int c_) { nM = M / BM; nN = N / BM; nwg = nM * nN; G = G_; c = c_; }
    __host__ __device__ bool next(int i, Unit& u) const {
        const long L = (long)i * G + c; if (L >= nwg) return false;
        int wgid = (int)L; { const int q = nwg / NXCD, r = nwg % NXCD, xcd = wgid % NXCD, off = wgid / NXCD; wgid = (xcd < r ? xcd * (q + 1) : r * (q + 1) + (xcd - r) * q) + off; }
        const int nig = WGM * nN, gid = wgid / nig, fm = gid * WGM, gsz = (nM - fm) < WGM ? (nM - fm) : WGM;
        u.pm = fm + ((wgid % nig) % gsz); u.pn = (wgid % nig) / gsz; return true;
    }
    __device__ __forceinline__ void a_ready(const Unit&) const {}
    __device__ __forceinline__ void done(const Unit&) const {}
};
typedef __bf16 bf16x2_t __attribute__((ext_vector_type(2)));
typedef float f32x2_t __attribute__((ext_vector_type(2)));
__device__ __forceinline__ unsigned pk2(float lo, float hi) { f32x2_t v = {lo, hi}; bf16x2_t r = __builtin_convertvector(v, bf16x2_t); return __builtin_bit_cast(unsigned, r); }
struct EpiBf16Plain {
    static constexpr bool PERM = true, AFTER_DRAIN = false;
    bf16_t* O; int ldc;
    __device__ __forceinline__ void operator()(const f32x4 (&acc)[2][2][4][2], const Unit& u, int wr, int wc, int fr, int fq) const {
        const int row0 = u.pm * BM + wr * 64 + fr, col0 = u.pn * BM + wc * 32 + 8 * fq;
#pragma unroll
        for (int ai = 0; ai < 2; ++ai)
#pragma unroll
            for (int m = 0; m < 4; ++m) { bf16_t* rowp = O + (size_t)(row0 + ai * HALF + m * 16) * ldc + col0;
#pragma unroll
                for (int bj = 0; bj < 2; ++bj) { const f32x4 v0 = acc[ai][bj][m][0], v1 = acc[ai][bj][m][1];
                    u32x4 w; w.x = pk2(v0[0], v0[1]); w.y = pk2(v0[2], v0[3]); w.z = pk2(v1[0], v1[1]); w.w = pk2(v1[2], v1[3]);
                    *(u32x4*)(rowp + bj * HALF) = w; } }
    }
};
struct EpiResF32 {
    static constexpr bool PERM = false, AFTER_DRAIN = false;
    float* C; int ldc; const float* base; float alpha;
    __device__ __forceinline__ void operator()(const f32x4 (&acc)[2][2][4][2], const Unit& u, int wr, int wc, int fr, int fq) const {
        const int row0 = u.pm * BM + wr * 64 + fr, col0 = u.pn * BM + wc * 32 + 4 * fq;
#pragma unroll
        for (int ai = 0; ai < 2; ++ai)
#pragma unroll
            for (int m = 0; m < 4; ++m) { const size_t ro = (size_t)(row0 + ai * HALF + m * 16) * ldc + col0;
#pragma unroll
                for (int bj = 0; bj < 2; ++bj)
#pragma unroll
                    for (int n = 0; n < 2; ++n) { const f32x4 b = *(const f32x4*)(base + ro + bj * HALF + n * 16);
                        *(f32x4*)(C + ro + bj * HALF + n * 16) = acc[ai][bj][m][n] + b * alpha; } }
    }
};

template <class Epi, class Sched, bool STAMP = false>
__device__ __forceinline__ void gemm_phase(PG8_LAS unsigned char* lds, const Gemm g, const Sched& S, const Epi& E, unsigned long long* stamps) {
    const int tid = threadIdx.x, wid = __builtin_amdgcn_readfirstlane(tid >> 6), lane = tid & 63, wr = wid >> 2, wc = wid & 3, fr = lane & 15, fq = lane >> 4;
    const int K = g.K, nt = K / BK;
    int ts_lo = 0, ts_hi = 0, nts = 0; const unsigned long long rt_entry = STAMP ? (unsigned long long)wall_clock64() : 0ull;
#define PG8_STAMP() do { if (STAMP && wid == 0 && nts < 64) { const unsigned long long _c = (unsigned long long)clock64(); \
        ts_lo = (lane == nts) ? (int)(unsigned)_c : ts_lo; ts_hi = (lane == nts) ? (int)(unsigned)(_c >> 32) : ts_hi; ++nts; } } while (0)
    PG8_STAMP();
    unsigned voffA[2], voffB[2];
#pragma unroll
    for (int i = 0; i < 2; ++i) { int R, C; stage_rc(tid * 16 + i * 8192, R, C); const int Rb = Epi::PERM ? ((R & ~31) + perm32(R & 31)) : R;
        voffA[i] = (unsigned)(R * K + C) * 2u; voffB[i] = (unsigned)(Rb * K + C) * 2u; }
    const size_t kstep = (size_t)(BK * 2);
    const size_t hstep = (size_t)HALF * K * 2;
    const size_t tstep = 2 * hstep;
    const unsigned ldsw = (unsigned)wid * 1024u;
    const int aoff = lds_byte(wr * 64 + fr, fq * 8), boff = lds_byte(wc * 32 + fr, fq * 8);
#define PG8_SA(b, h) (((b) * 2 + (h)) * HTB)
#define PG8_SB(b, h) ((4 + (b) * 2 + (h)) * HTB)
#define PG8_STAGE(bufoff, gbase, voff) do { _Pragma("unroll") for (int _i = 0; _i < 2; ++_i) \
        __builtin_amdgcn_global_load_lds((const unsigned*)((const char*)(gbase) + (voff)[_i]), (PG8_LAS unsigned*)(lds + (bufoff) + ldsw + _i * 8192), 16, 0, 0); } while (0)
#define PG8_LDA(dst, b, h) do { _Pragma("unroll") for (int m = 0; m < 4; ++m) _Pragma("unroll") for (int k = 0; k < 2; ++k) dst[m][k] = *(const PG8_LAS bf16x8*)(lds + PG8_SA(b, h) + aoff + m * 2048 + k * 1024); } while (0)
#define PG8_LDB(dst, b, h) do { _Pragma("unroll") for (int n = 0; n < 2; ++n) _Pragma("unroll") for (int k = 0; k < 2; ++k) dst[n][k] = *(const PG8_LAS bf16x8*)(lds + PG8_SB(b, h) + boff + n * 2048 + k * 1024); } while (0)
#define PG8_MMA(ai, bj, At, Bt) do { __builtin_amdgcn_s_setprio(1); _Pragma("unroll") for (int m = 0; m < 4; ++m) _Pragma("unroll") for (int n = 0; n < 2; ++n) _Pragma("unroll") for (int k = 0; k < 2; ++k) \
        acc[ai][bj][m][n] = __builtin_amdgcn_mfma_f32_16x16x32_bf16(Bt[n][k], At[m][k], acc[ai][bj][m][n], 0, 0, 0); __builtin_amdgcn_s_setprio(0); } while (0)
#define PG8_WAIT_V(n) asm volatile("s_waitcnt vmcnt(" #n ")" ::: "memory")
#define PG8_WAIT_L(n) asm volatile("s_waitcnt lgkmcnt(" #n ")" ::: "memory")
#define PG8_BAR __builtin_amdgcn_s_barrier()
#define PG8_SCHED __builtin_amdgcn_sched_barrier(0)
    Unit cur, nxt; int ui = 0;
    if (!S.next(0, cur)) return;
    f32x4 acc[2][2][4][2];
#pragma unroll
    for (int a = 0; a < 2; ++a)
#pragma unroll
        for (int b = 0; b < 2; ++b)
#pragma unroll
            for (int m = 0; m < 4; ++m)
#pragma unroll
                for (int n = 0; n < 2; ++n) acc[a][b][m][n] = (f32x4){0.f, 0.f, 0.f, 0.f};
    bf16x8 At[4][2], B0[2][2], B1[2][2];
    const char* cA = (const char*)g.A + (size_t)cur.pm * tstep; const char* cB = (const char*)g.Bt + (size_t)cur.pn * tstep;
    S.a_ready(cur);
    PG8_STAGE(PG8_SB(0, 0), cB, voffB); PG8_STAGE(PG8_SA(0, 0), cA, voffA); PG8_STAGE(PG8_SB(0, 1), cB + hstep, voffB); PG8_STAGE(PG8_SA(0, 1), cA + hstep, voffA);
    if (wr == 1) PG8_BAR;
    PG8_WAIT_V(4); PG8_BAR;
    PG8_STAGE(PG8_SB(1, 0), cB + kstep, voffB); PG8_STAGE(PG8_SA(1, 0), cA + kstep, voffA); PG8_STAGE(PG8_SB(1, 1), cB + hstep + kstep, voffB);
    PG8_WAIT_V(6); PG8_BAR;
    PG8_STAMP();
    for (;;) {
        const bool has_next = S.next(ui + 1, nxt);
        const char* nA = has_next ? (const char*)g.A + (size_t)nxt.pm * tstep : cA; const char* nB = has_next ? (const char*)g.Bt + (size_t)nxt.pn * tstep : cB;
        for (int t = 0; t < nt; t += 2) {
            const bool last = (t == nt - 2);
            const char* a1 = cA + (size_t)(t + 1) * kstep;
            const char* a2 = last ? nA : cA + (size_t)(t + 2) * kstep; const char* b2 = last ? nB : cB + (size_t)(t + 2) * kstep;
            const char* a3 = a2 + kstep; const char* b3 = b2 + kstep;
            if (last && has_next) S.a_ready(nxt);
            PG8_LDB(B0, 0, 0); PG8_SCHED; PG8_LDA(At, 0, 0); PG8_STAGE(PG8_SA(1, 1), a1 + hstep, voffA);
            PG8_WAIT_L(8); PG8_BAR; PG8_WAIT_L(0); PG8_MMA(0, 0, At, B0); PG8_BAR; PG8_SCHED;
            PG8_LDB(B1, 0, 1); PG8_STAGE(PG8_SB(0, 0), b2, voffB);
            PG8_BAR; PG8_WAIT_L(0); PG8_MMA(0, 1, At, B1); PG8_BAR;
            PG8_LDA(At, 0, 1); PG8_STAGE(PG8_SA(0, 0), a2, voffA);
            PG8_BAR; PG8_WAIT_L(0); PG8_MMA(1, 0, At, B0); PG8_BAR; PG8_SCHED;
            PG8_STAGE(PG8_SB(0, 1), b2 + hstep, voffB);
            PG8_WAIT_V(6); PG8_BAR; PG8_MMA(1, 1, At, B1); PG8_BAR;
            PG8_LDB(B0, 1, 0); PG8_SCHED; PG8_LDA(At, 1, 0); PG8_STAGE(PG8_SA(0, 1), a2 + hstep, voffA);
            PG8_WAIT_L(8); PG8_BAR; PG8_WAIT_L(0); PG8_MMA(0, 0, At, B0); PG8_BAR; PG8_SCHED;
            PG8_LDB(B1, 1, 1); PG8_STAGE(PG8_SB(1, 0), b3, voffB);
            PG8_BAR; PG8_WAIT_L(0); PG8_MMA(0, 1, At, B1); PG8_BAR;
            PG8_LDA(At, 1, 1); PG8_STAGE(PG8_SA(1, 0), a3, voffA);
            PG8_BAR; PG8_WAIT_L(0); PG8_MMA(1, 0, At, B0); PG8_BAR; PG8_SCHED;
            PG8_STAGE(PG8_SB(1, 1), b3 + hstep, voffB);
            PG8_WAIT_V(6); PG8_BAR; PG8_MMA(1, 1, At, B1); PG8_BAR;
        }
        PG8_STAMP();
        if constexpr (!Epi::AFTER_DRAIN) { E(acc, cur, wr, wc, fr, fq); S.done(cur); }
        PG8_STAMP();
        if (!has_next) break;
#pragma unroll
        for (int a = 0; a < 2; ++a)
#pragma unroll
            for (int b = 0; b < 2; ++b)
#pragma unroll
                for (int m = 0; m < 4; ++m)
#pragma unroll
                    for (int n = 0; n < 2; ++n) acc[a][b][m][n] = (f32x4){0.f, 0.f, 0.f, 0.f};
        cur = nxt; cA = nA; cB = nB; ++ui;
    }
    PG8_WAIT_V(0);
    if (wr == 0) PG8_BAR;
    PG8_BAR;
    if constexpr (Epi::AFTER_DRAIN) { E.fused(acc, cur, wr, wc, fr, fq, lds, wid, lane); S.done(cur); }
    PG8_STAMP();
    if (STAMP && wid == 0) { stamps[lane] = lane < nts ? (((unsigned long long)(unsigned)ts_hi << 32) | (unsigned)ts_lo) : 0ull;
        if (lane == 62) stamps[62] = rt_entry; if (lane == 63) stamps[63] = (unsigned long long)wall_clock64(); }
#undef PG8_STAMP
#undef PG8_SA
#undef PG8_SB
#undef PG8_STAGE
#undef PG8_LDA
#undef PG8_LDB
#undef PG8_MMA
#undef PG8_WAIT_V
#undef PG8_WAIT_L
#undef PG8_BAR
#undef PG8_SCHED
}
}
#define XB_TMO      128
#define XB_XCNT(j)  (256  + 64 * (j))
#define XB_XSUB(j)  (1280 + 64 * (j))
#define XB_XGEN(j)  (2304 + 64 * (j))
#define XB_TOP      3328
#define XB_TOPGEN   3392
#define XCD_BAR_WORDS 3456
#define XB_SPIN_CAP (1u << 18)
#define LAS __attribute__((address_space(3)))

__device__ __forceinline__ unsigned xb_ld(unsigned* p)              { return __hip_atomic_load(p, __ATOMIC_RELAXED, __HIP_MEMORY_SCOPE_AGENT); }
__device__ __forceinline__ unsigned xb_add(unsigned* p, unsigned v) { return __hip_atomic_fetch_add(p, v, __ATOMIC_RELAXED, __HIP_MEMORY_SCOPE_AGENT); }
__device__ __forceinline__ unsigned xb_xcc_id() { return (unsigned)__builtin_amdgcn_s_getreg((3 << 11) | 20) & 0xFu; }
#define XB_SPIN(cond, bar) do { unsigned _sp = 0; while (cond) { __builtin_amdgcn_s_sleep(1); \
    if ((++_sp & 255u) == 0u) { if (xb_ld(&(bar)[XB_TMO])) break; if (_sp > XB_SPIN_CAP) { atomicAdd(&(bar)[XB_TMO], 1u); break; } } } } while (0)

struct XcdBarrier {
    unsigned* bar; unsigned x;
    volatile LAS unsigned* st;
};

__device__ __forceinline__ XcdBarrier xcd_barrier_post(unsigned* bar, volatile LAS unsigned* st) {
    XcdBarrier b; b.bar = bar; b.x = xb_xcc_id(); b.st = st;
    if (threadIdx.x == 0) (void)xb_add(&bar[XB_XCNT(b.x)], 1u);
    return b;
}
__device__ __forceinline__ void xcd_barrier_complete(unsigned* bar, unsigned x, unsigned& nloc, unsigned& nx) {
    const unsigned G = gridDim.x * gridDim.y * gridDim.z;
    unsigned sum, cnt, mine, sp = 0u;
    for (;;) {
        sum = 0u; cnt = 0u; mine = 0u;
#pragma unroll
        for (unsigned j = 0; j < 16; ++j) { const unsigned c = xb_ld(&bar[XB_XCNT(j)]); sum += c; cnt += (c > 0u) ? 1u : 0u; mine = (j == x) ? c : mine; }
        if (sum == G) break;
        __builtin_amdgcn_s_sleep(1);
        if ((++sp & 255u) == 0u) { if (xb_ld(&bar[XB_TMO])) break; if (sp > XB_SPIN_CAP) { atomicAdd(&bar[XB_TMO], 1u); break; } }
    }
    nloc = mine > 0u ? mine : 1u; nx = cnt > 0u ? cnt : 1u;
}

__device__ __forceinline__ void xcd_barrier(const XcdBarrier& b) {
    asm volatile("s_waitcnt vmcnt(0)" ::: "memory");
    __syncthreads();
    if (threadIdx.x == 0) {
        unsigned* bar = b.bar;
        __builtin_amdgcn_s_waitcnt(0);
        unsigned nloc = b.st[0], nx = b.st[1];
        if (nloc == 0u) { xcd_barrier_complete(bar, b.x, nloc, nx); b.st[0] = nloc; b.st[1] = nx; }
        const unsigned old = xb_add(&bar[XB_XSUB(b.x)], 1u);
        const unsigned gen = old / nloc;
        if (old + 1u == (gen + 1u) * nloc) {
            __builtin_amdgcn_fence(__ATOMIC_RELEASE, "agent");
            asm volatile("s_waitcnt vmcnt(0)" ::: "memory");
            const unsigned og = xb_add(&bar[XB_TOP], 1u);
            const unsigned tg = og / nx;
            if (og + 1u == (tg + 1u) * nx) xb_add(&bar[XB_TOPGEN], 1u);
            else XB_SPIN(xb_ld(&bar[XB_TOPGEN]) == tg, bar);
            __builtin_amdgcn_fence(__ATOMIC_ACQUIRE, "agent");
            xb_add(&bar[XB_XGEN(b.x)], 1u);
            asm volatile("s_waitcnt vmcnt(0)" ::: "memory");
        } else {
            XB_SPIN(xb_ld(&bar[XB_XGEN(b.x)]) == gen, bar);
            __builtin_amdgcn_fence(__ATOMIC_ACQUIRE, "agent");
            asm volatile("s_waitcnt vmcnt(0)" ::: "memory");
        }
    }
    __syncthreads();
}
namespace mk {
typedef unsigned short bf16_t;
typedef float f32x4 __attribute__((ext_vector_type(4)));
using pg8::pk2;
constexpr int D = 2048, NB = 4, S = 2048, T = NB * S, HD = 128, INW = 7168;
constexpr int NKEYS = 128;
constexpr float ALPHA = 1.189207115002721f;
constexpr int NTHR = 512;
constexpr size_t MiB = (size_t)1 << 20;
constexpr size_t WS_CTL = 0;
constexpr size_t CTL_BYTES = 64 * 1024;
constexpr size_t WS_XB = 1 * MiB;
constexpr size_t WS_WIN = 33 * MiB;
constexpr size_t WS_WOUT = 61 * MiB;
constexpr size_t WS_WPQ = 69 * MiB;
constexpr size_t WS_ROT = 78 * MiB;
constexpr size_t WS_PROJ = 80 * MiB;
constexpr size_t WS_MIXED = 192 * MiB;
constexpr size_t WS_Y1 = 224 * MiB;
constexpr size_t WS_X1B = 288 * MiB;
constexpr size_t WS_QP = 320 * MiB;
constexpr size_t WS_EIDX = 352 * MiB;
constexpr size_t WS_EGATE = 356 * MiB;
constexpr size_t WS_END = 360 * MiB;
constexpr int LDS_MISC = 2048;
constexpr int LDS_BYTES = pg8::STAGE_BYTES + LDS_MISC;

__device__ __forceinline__ float bflo(unsigned u) { return __uint_as_float(u << 16); }
__device__ __forceinline__ float bfhi(unsigned u) { return __uint_as_float(u & 0xffff0000u); }
__device__ __forceinline__ float wave_sum(float v) {
#pragma unroll
  for (int o = 32; o > 0; o >>= 1) v += __shfl_xor(v, o);
  return v;
}
__device__ __forceinline__ float wave_max(float v) {
#pragma unroll
  for (int o = 32; o > 0; o >>= 1) v = fmaxf(v, __shfl_xor(v, o));
  return v;
}
__device__ __forceinline__ int wave_min_i(int v) {
#pragma unroll
  for (int o = 32; o > 0; o >>= 1) v = min(v, __shfl_xor(v, o));
  return v;
}

struct Ctx {
  const float* in[13];
  float* out;
  unsigned char* ws;
  LAS unsigned char* lds;
  int tid, lane, wave, G;
};

__device__ __forceinline__ void transpose_bf16(const Ctx& c, const float* __restrict__ w, bf16_t* __restrict__ wt, int K, int N) {
  LAS float* tile = (LAS float*)c.lds;
  const int ntk = K / 64, ntiles = ntk * (N / 64);
  for (int tile_i = blockIdx.x; tile_i < ntiles; tile_i += c.G) {
    const int k0 = (tile_i % ntk) * 64, n0 = (tile_i / ntk) * 64;
    {
      const int r = c.tid >> 3, c8 = (c.tid & 7) * 8;
      const float4 a = *(const float4*)(w + (size_t)(k0 + r) * N + n0 + c8);
      const float4 b = *(const float4*)(w + (size_t)(k0 + r) * N + n0 + c8 + 4);
      LAS float* p = tile + r * 65 + c8;
      p[0] = a.x; p[1] = a.y; p[2] = a.z; p[3] = a.w; p[4] = b.x; p[5] = b.y; p[6] = b.z; p[7] = b.w;
    }
    __syncthreads();
    {
      const int n = c.tid >> 3, k8 = (c.tid & 7) * 8;
      float v[8];
#pragma unroll
      for (int j = 0; j < 8; ++j) v[j] = tile[(k8 + j) * 65 + n];
      uint4 o; o.x = pk2(v[0], v[1]); o.y = pk2(v[2], v[3]); o.z = pk2(v[4], v[5]); o.w = pk2(v[6], v[7]);
      *(uint4*)(wt + (size_t)(n0 + n) * K + k0 + k8) = o;
    }
    __syncthreads();
  }
}
__device__ __forceinline__ void p0_prologue(const Ctx& c) {
  const size_t gtid = (size_t)blockIdx.x * NTHR + c.tid, gstride = (size_t)c.G * NTHR;
  {
    const float4* x4 = (const float4*)c.in[0];
    uint4* xb4 = (uint4*)(c.ws + WS_XB);
    for (size_t i = gtid; i < (size_t)T * D / 8; i += gstride) {
      const float4 a = x4[2 * i], b = x4[2 * i + 1];
      uint4 o; o.x = pk2(a.x, a.y); o.y = pk2(a.z, a.w); o.z = pk2(b.x, b.y); o.w = pk2(b.z, b.w);
      xb4[i] = o;
    }
  }
  transpose_bf16(c, c.in[1], (bf16_t*)(c.ws + WS_WIN), D, INW);
  transpose_bf16(c, c.in[4], (bf16_t*)(c.ws + WS_WOUT), D, D);
  transpose_bf16(c, c.in[7], (bf16_t*)(c.ws + WS_WPQ), D, D);
  {
    float* cs = (float*)(c.ws + WS_ROT);
    float* sn = cs + S * 64;
    for (size_t i = gtid; i < (size_t)S * 64; i += gstride) {
      const int s = (int)(i >> 6), f = (int)(i & 63);
      const float inv_freq = (float)pow(10000.0, -(2.0 * f) / 128.0);
      const float ang = (float)s * inv_freq;
      cs[i] = (float)cos((double)ang);
      sn[i] = (float)sin((double)ang);
    }
  }
}

__device__ __forceinline__ void p2_rotate(const Ctx& c) {
  bf16_t* proj = (bf16_t*)(c.ws + WS_PROJ);
  const float* cs = (const float*)(c.ws + WS_ROT);
  const float* sn = cs + S * 64;
  const size_t gtid = (size_t)blockIdx.x * NTHR + c.tid, gstride = (size_t)c.G * NTHR;
  for (size_t it = gtid; it < (size_t)T * 128; it += gstride) {
    const int row = (int)(it >> 7), rem = (int)(it & 127);
    const int which = rem >> 6, h = (rem >> 3) & 7, i0 = (rem & 7) * 8;
    const int s = row & (S - 1);
    bf16_t* p = proj + (size_t)row * INW + 3072 + which * 1024 + h * HD + i0;
    const uint4 lo = *(const uint4*)p, hi = *(const uint4*)(p + 64);
    const float4 c0 = *(const float4*)(cs + s * 64 + i0), c1 = *(const float4*)(cs + s * 64 + i0 + 4);
    const float4 s0 = *(const float4*)(sn + s * 64 + i0), s1 = *(const float4*)(sn + s * 64 + i0 + 4);
    const float cv[8] = {c0.x, c0.y, c0.z, c0.w, c1.x, c1.y, c1.z, c1.w};
    const float sv[8] = {s0.x, s0.y, s0.z, s0.w, s1.x, s1.y, s1.z, s1.w};
    const unsigned lw[4] = {lo.x, lo.y, lo.z, lo.w}, hw[4] = {hi.x, hi.y, hi.z, hi.w};
    unsigned ol[4], oh[4];
#pragma unroll
    for (int j = 0; j < 4; ++j) {
      const float l0 = bflo(lw[j]), l1 = bfhi(lw[j]), h0 = bflo(hw[j]), h1 = bfhi(hw[j]);
      const float nl0 = l0 * cv[2 * j] - h0 * sv[2 * j], nl1 = l1 * cv[2 * j + 1] - h1 * sv[2 * j + 1];
      const float nh0 = h0 * cv[2 * j] + l0 * sv[2 * j], nh1 = h1 * cv[2 * j + 1] + l1 * sv[2 * j + 1];
      ol[j] = pk2(nl0, nl1); oh[j] = pk2(nh0, nh1);
    }
    uint4 a; a.x = ol[0]; a.y = ol[1]; a.z = ol[2]; a.w = ol[3];
    uint4 b; b.x = oh[0]; b.y = oh[1]; b.z = oh[2]; b.w = oh[3];
    *(uint4*)p = a; *(uint4*)(p + 64) = b;
  }
}

__device__ __forceinline__ void p3_attn_naive(const Ctx& c) {
  const bf16_t* proj = (const bf16_t*)(c.ws + WS_PROJ);
  bf16_t* mixed = (bf16_t*)(c.ws + WS_MIXED);
  const float* sbw = c.in[2];
  const float* rnw = c.in[3];
  const int lane = c.lane, gw = blockIdx.x * 8 + c.wave, NW = c.G * 8;
  const float scale = 0.08838834764831845f;
  for (int r = gw; r < NB * 8 * S; r += NW) {
    const int bh = r >> 11, t = r & (S - 1), b = bh >> 3, h = bh & 7;
    const bf16_t* base = proj + (size_t)b * S * INW + h * HD + lane * 2;
    const unsigned qw = *(const unsigned*)(base + (size_t)t * INW);
    const float qx = bflo(qw), qy = bfhi(qw);
    float ox = 0.f, oy = 0.f, run = 0.f;
    for (int s = t - 1; s >= 0; --s) {
      const unsigned kw = *(const unsigned*)(base + (size_t)s * INW + 1024);
      const unsigned vw = *(const unsigned*)(base + (size_t)s * INW + 2048);
      const float z = wave_sum(qx * bflo(kw) + qy * bfhi(kw)) * scale;
      const float l1p = log1pf(expf(-fabsf(z)));
      const float sp = fmaxf(z, 0.f) + l1p;
      const float ls = fminf(z, 0.f) - l1p;
      const float a = expf(ls - run);
      ox += a * bflo(vw); oy += a * bfhi(vw);
      run += sp;
      if (run > 104.f) break;
    }
    const float ms = wave_sum(ox * ox + oy * oy) * (1.f / 128.f);
    const float rr = rsqrtf(ms + 1e-6f);
    const float2 wv = *(const float2*)(sbw + h * HD + lane * 2);
    *(unsigned*)(mixed + (size_t)(b * S + t) * D + h * HD + lane * 2) = pk2(ox * rr * wv.x, oy * rr * wv.y);
  }
  for (int r = gw; r < NB * 8 * S; r += NW) {
    const int bh = r >> 11, tt = r & (S - 1), b = bh >> 3, h = bh & 7;
    const int t = (bh & 1) ? (S - 1 - tt) : tt;
    const bf16_t* base = proj + (size_t)b * S * INW + h * HD + lane * 2;
    const unsigned qw = *(const unsigned*)(base + (size_t)t * INW + 3072);
    const float qx = bflo(qw), qy = bfhi(qw);
    const float log_g = log1pf(-exp2f(-5.f - (float)h));
    const int s_end = ((t >> 6) + 1) << 6;
    float ox = 0.f, oy = 0.f;
    for (int s = 0; s < s_end; ++s) {
      const unsigned kw = *(const unsigned*)(base + (size_t)s * INW + 4096);
      const unsigned vw = *(const unsigned*)(base + (size_t)s * INW + 5120);
      const float dist = fabsf((float)(t - s));
      const float z = wave_sum(qx * bflo(kw) + qy * bfhi(kw)) * scale * expf(log_g * dist);
      ox += z * bflo(vw); oy += z * bfhi(vw);
    }
    const float mu = wave_sum(ox + oy) * (1.f / 128.f);
    const float dx = ox - mu, dy = oy - mu;
    const float var = wave_sum(dx * dx + dy * dy) * (1.f / 128.f);
    const float rr = rsqrtf(var + 1e-6f);
    const float2 wv = *(const float2*)(rnw + h * HD + lane * 2);
    const unsigned gwd = *(const unsigned*)(base + (size_t)t * INW + 6144);
    const float gx = bflo(gwd), gy = bfhi(gwd);
    const float sx = gx / (1.f + expf(-gx)), sy = gy / (1.f + expf(-gy));
    *(unsigned*)(mixed + (size_t)(b * S + t) * D + 1024 + h * HD + lane * 2) = pk2(dx * rr * wv.x * sx, dy * rr * wv.y * sy);
  }
}

__device__ __forceinline__ void p5_ln1(const Ctx& c) {
  float* y1 = (float*)(c.ws + WS_Y1);
  bf16_t* x1b = (bf16_t*)(c.ws + WS_X1B);
  const float* w = c.in[5];
  const float* bb = c.in[6];
  const int lane = c.lane, gw = blockIdx.x * 8 + c.wave, NW = c.G * 8;
  for (int row = gw; row < T; row += NW) {
    float* p = y1 + (size_t)row * D;
    f32x4 v[8];
    float s = 0.f;
#pragma unroll
    for (int i = 0; i < 8; ++i) { v[i] = *(const f32x4*)(p + (i * 64 + lane) * 4); s += (v[i][0] + v[i][1]) + (v[i][2] + v[i][3]); }
    const float mu = wave_sum(s) * (1.f / D);
    float q = 0.f;
#pragma unroll
    for (int i = 0; i < 8; ++i) { const f32x4 d = v[i] - mu; q += (d[0] * d[0] + d[1] * d[1]) + (d[2] * d[2] + d[3] * d[3]); }
    const float rr = rsqrtf(wave_sum(q) * (1.f / D) + 1e-5f);
#pragma unroll
    for (int i = 0; i < 8; ++i) {
      const int col = (i * 64 + lane) * 4;
      const f32x4 wv = *(const f32x4*)(w + col), bv = *(const f32x4*)(bb + col);
      const f32x4 o = (v[i] - mu) * rr * wv + bv;
      *(f32x4*)(p + col) = o;
      uint2 pkd; pkd.x = pk2(o[0], o[1]); pkd.y = pk2(o[2], o[3]);
      *(uint2*)(x1b + (size_t)row * D + col) = pkd;
    }
  }
}

__device__ __forceinline__ void p7_route_naive(const Ctx& c) {
  const bf16_t* qp = (const bf16_t*)(c.ws + WS_QP);
  const float* sk = c.in[8];
  int* eidx = (int*)(c.ws + WS_EIDX);
  float* egate = (float*)(c.ws + WS_EGATE);
  const int lane = c.lane, gw = blockIdx.x * 8 + c.wave, NW = c.G * 8;
  const float NEG = -3.0e38f;
  for (int th = gw; th < T * 8; th += NW) {
    const int t = th >> 3, h = th & 7;
    float st0 = 0.f, st1 = 0.f; int it0 = 0, it1 = 0;
#pragma unroll 1
    for (int cc = 0; cc < 2; ++cc) {
      const bf16_t* q = qp + (size_t)t * D + h * 256 + cc * 128;
      const float* k0 = sk + ((size_t)((h * 2 + cc) * NKEYS + lane)) * 128;
      const float* k1 = k0 + 64 * 128;
      float v0 = 0.f, v1 = 0.f;
      for (int d = 0; d < 128; d += 4) {
        const uint2 qq = *(const uint2*)(q + d);
        const float q0 = bflo(qq.x), q1 = bfhi(qq.x), q2 = bflo(qq.y), q3 = bfhi(qq.y);
        const float4 a = *(const float4*)(k0 + d);
        const float4 bq = *(const float4*)(k1 + d);
        v0 += q0 * a.x + q1 * a.y + q2 * a.z + q3 * a.w;
        v1 += q0 * bq.x + q1 * bq.y + q2 * bq.z + q3 * bq.w;
      }
      float mys = 0.f; int myi = 0;
      for (int it = 0; it < 16; ++it) {
        const float m = wave_max(fmaxf(v0, v1));
        int cand = 9999;
        if (v1 == m) cand = lane + 64;
        if (v0 == m) cand = lane;
        const int sel = wave_min_i(cand);
        if (sel == lane) v0 = NEG;
        if (sel == lane + 64) v1 = NEG;
        if (lane == it) { mys = m; myi = sel; }
      }
      if (cc == 0) { st0 = mys; it0 = myi; } else { st1 = mys; it1 = myi; }
    }
    float cv[4];
#pragma unroll
    for (int j = 0; j < 4; ++j) cv[j] = __shfl(st0, lane >> 2) + __shfl(st1, (lane & 3) * 4 + j);
    float mybest = 0.f; int mypos = 0;
    for (int it = 0; it < 16; ++it) {
      const float lm = fmaxf(fmaxf(cv[0], cv[1]), fmaxf(cv[2], cv[3]));
      const float m = wave_max(lm);
      int cand = 9999;
#pragma unroll
      for (int j = 3; j >= 0; --j) if (cv[j] == m) cand = lane * 4 + j;
      const int sel = wave_min_i(cand);
#pragma unroll
      for (int j = 0; j < 4; ++j) if (sel == lane * 4 + j) cv[j] = NEG;
      if (lane == it) { mybest = m; mypos = sel; }
    }
    const float mx = __shfl(mybest, 0);
    const float e = (lane < 16) ? expf(mybest - mx) : 0.f;
    const float den = wave_sum(e);
    const int ia = __shfl(it0, mypos >> 4), ib = __shfl(it1, mypos & 15);
    if (lane < 16) {
      eidx[(size_t)th * 16 + lane] = ia * NKEYS + ib;
      egate[(size_t)th * 16 + lane] = e / den;
    }
  }
}

__device__ __forceinline__ void p8_peer_naive(const Ctx& c) {
  const float* x1 = (const float*)(c.ws + WS_Y1);
  const int* eidx = (const int*)(c.ws + WS_EIDX);
  const float* egate = (const float*)(c.ws + WS_EGATE);
  const float* eu = c.in[9];
  const float* ev = c.in[10];
  const float* w = c.in[11];
  const float* bb = c.in[12];
  LAS float* xs = (LAS float*)c.lds;
  LAS float* hh = xs + D;
  LAS int* ei = (LAS int*)(hh + 128);
  LAS float* red = (LAS float*)(ei + 128);
  const int tid = c.tid, lane = c.lane, wv = c.wave;
  for (int t = blockIdx.x; t < T; t += c.G) {
    *(f32x4*)(xs + tid * 4) = *(const f32x4*)(x1 + (size_t)t * D + tid * 4);
    if (tid < 128) ei[tid] = eidx[(size_t)t * 128 + tid];
    __syncthreads();
    for (int a = wv * 16; a < wv * 16 + 16; ++a) {
      const float* u = eu + (size_t)ei[a] * D;
      float s = 0.f;
#pragma unroll
      for (int i = 0; i < 8; ++i) {
        const f32x4 uv = *(const f32x4*)(u + (i * 64 + lane) * 4);
        const f32x4 xv = *(const LAS f32x4*)(xs + (i * 64 + lane) * 4);
        s += uv[0] * xv[0] + uv[1] * xv[1] + uv[2] * xv[2] + uv[3] * xv[3];
      }
      s = wave_sum(s);
      const float act = 0.5f * s * (1.f + erff(s * 0.7071067811865476f));
      if (lane == 0) hh[a] = egate[(size_t)t * 128 + a] * act;
    }
    __syncthreads();
    f32x4 acc = {0.f, 0.f, 0.f, 0.f};
    for (int a = 0; a < 128; ++a) {
      const f32x4 v = *(const f32x4*)(ev + (size_t)ei[a] * D + tid * 4);
      acc += v * hh[a];
    }
    const f32x4 y = *(const LAS f32x4*)(xs + tid * 4) * ALPHA + acc;
    float s = wave_sum((y[0] + y[1]) + (y[2] + y[3]));
    if (lane == 0) red[wv] = s;
    __syncthreads();
    float mu = 0.f;
#pragma unroll
    for (int i = 0; i < 8; ++i) mu += red[i];
    mu *= (1.f / D);
    const f32x4 d = y - mu;
    float q = wave_sum((d[0] * d[0] + d[1] * d[1]) + (d[2] * d[2] + d[3] * d[3]));
    if (lane == 0) red[8 + wv] = q;
    __syncthreads();
    float var = 0.f;
#pragma unroll
    for (int i = 0; i < 8; ++i) var += red[8 + i];
    const float rr = rsqrtf(var * (1.f / D) + 1e-5f);
    const f32x4 wv4 = *(const f32x4*)(w + tid * 4), bv = *(const f32x4*)(bb + tid * 4);
    *(f32x4*)(c.out + (size_t)t * D + tid * 4) = d * rr * wv4 + bv;
    __syncthreads();
  }
}

#ifndef MK_N_LAUNCHES
#define MK_N_LAUNCHES 1
#endif
constexpr int NPHASE = 9;
struct Args { const float* in[13]; float* out; unsigned char* ws; int ph_lo, ph_hi; };

__global__ void __launch_bounds__(NTHR, 2) k_main(Args a) {
  extern __shared__ __attribute__((aligned(16))) unsigned char lds_raw[];
  Ctx c;
#pragma unroll
  for (int i = 0; i < 13; ++i) c.in[i] = a.in[i];
  c.out = a.out; c.ws = a.ws; c.lds = (LAS unsigned char*)lds_raw;
  c.tid = threadIdx.x; c.lane = c.tid & 63; c.wave = __builtin_amdgcn_readfirstlane(c.tid >> 6); c.G = gridDim.x;
  volatile LAS unsigned* misc = (volatile LAS unsigned*)(c.lds + pg8::STAGE_BYTES);
  if (c.tid < 16) misc[c.tid] = 0u;
  __syncthreads();
  const int lo = a.ph_lo, hi = a.ph_hi;
  XcdBarrier bar; bar.bar = (unsigned*)(c.ws + WS_CTL); bar.x = 0; bar.st = misc;
  if (hi - lo > 1) bar = xcd_barrier_post((unsigned*)(c.ws + WS_CTL), misc);
#define IN(k) (lo <= (k) && (k) < hi)
#define SEAM(k) do { if (IN(k) && IN((k) + 1)) xcd_barrier(bar); } while (0)
  bf16_t* xb = (bf16_t*)(c.ws + WS_XB);
  if (IN(0)) { p0_prologue(c); } SEAM(0);
  if (IN(1)) {
    pg8::Gemm g{xb, (const bf16_t*)(c.ws + WS_WIN), T, INW, D};
    pg8::StaticOrder so; so.init(T, INW, c.G, (int)blockIdx.x);
    pg8::EpiBf16Plain E{(bf16_t*)(c.ws + WS_PROJ), INW};
    pg8::gemm_phase<pg8::EpiBf16Plain, pg8::StaticOrder, false>(c.lds, g, so, E, nullptr);
  } SEAM(1);
  if (IN(2)) { p2_rotate(c); } SEAM(2);
  if (IN(3)) { p3_attn_naive(c); } SEAM(3);
  if (IN(4)) {
    pg8::Gemm g{(const bf16_t*)(c.ws + WS_MIXED), (const bf16_t*)(c.ws + WS_WOUT), T, D, D};
    pg8::StaticOrder so; so.init(T, D, c.G, (int)blockIdx.x);
    pg8::EpiResF32 E{(float*)(c.ws + WS_Y1), D, c.in[0], ALPHA};
    pg8::gemm_phase<pg8::EpiResF32, pg8::StaticOrder, false>(c.lds, g, so, E, nullptr);
  } SEAM(4);
  if (IN(5)) { p5_ln1(c); } SEAM(5);
  if (IN(6)) {
    pg8::Gemm g{(const bf16_t*)(c.ws + WS_X1B), (const bf16_t*)(c.ws + WS_WPQ), T, D, D};
    pg8::StaticOrder so; so.init(T, D, c.G, (int)blockIdx.x);
    pg8::EpiBf16Plain E{(bf16_t*)(c.ws + WS_QP), D};
    pg8::gemm_phase<pg8::EpiBf16Plain, pg8::StaticOrder, false>(c.lds, g, so, E, nullptr);
  } SEAM(6);
  if (IN(7)) { p7_route_naive(c); } SEAM(7);
  if (IN(8)) { p8_peer_naive(c); }
#undef IN
#undef SEAM
}
}

extern "C" void kernel_launch(void* const* d_in, const int* in_sizes, int n_in, void* d_out, int out_size, void* d_ws, size_t ws_size,
                              hipStream_t stream) {
  using namespace mk;
  static int grid = 0;
  if (grid == 0) {
    if (n_in != 13 || ws_size < WS_END) { grid = -1; return; }
    int dev = 0, cus = 0, per_cu = 0;
    if (hipGetDevice(&dev) != hipSuccess || hipDeviceGetAttribute(&cus, hipDeviceAttributeMultiprocessorCount, dev) != hipSuccess) { grid = -1; return; }
    if (hipFuncSetAttribute((const void*)k_main, hipFuncAttributeMaxDynamicSharedMemorySize, LDS_BYTES) != hipSuccess) { grid = -1; return; }
    if (hipOccupancyMaxActiveBlocksPerMultiprocessor(&per_cu, (const void*)k_main, NTHR, LDS_BYTES) != hipSuccess || per_cu < 1) { (void)hipGetLastError(); per_cu = 1; }
    grid = cus;
  }
  if (grid < 0) return;
  (void)hipMemsetAsync((char*)d_ws + WS_CTL, 0, CTL_BYTES, stream);
  Args a{};
  for (int i = 0; i < 13; ++i) a.in[i] = (const float*)d_in[i];
  a.out = (float*)d_out; a.ws = (unsigned char*)d_ws;
#if MK_N_LAUNCHES == 1
  a.ph_lo = 0; a.ph_hi = NPHASE;
  hipLaunchKernelGGL(k_main, dim3(grid), dim3(NTHR), LDS_BYTES, stream, a);
#else
  for (int p = 0; p < NPHASE; ++p) { a.ph_lo = p; a.ph_hi = p + 1; hipLaunchKernelGGL(k_main, dim3(grid), dim3(NTHR), LDS_BYTES, stream, a); }
#endif
}
```

```cpp
#include <hip/hip_runtime.h>
#include <stdint.h>
#include <math.h>
__device__ __forceinline__ int mk_lane_id() { return (int)__builtin_amdgcn_mbcnt_hi(~0u, __builtin_amdgcn_mbcnt_lo(~0u, 0u)); }
#define MK_N_LAUNCHES 1
namespace pg8 {
#define PG8_LAS __attribute__((address_space(3)))
typedef unsigned short bf16_t;
typedef short bf16x8 __attribute__((ext_vector_type(8)));
typedef float f32x4 __attribute__((ext_vector_type(4)));
typedef unsigned u32x4 __attribute__((ext_vector_type(4)));
constexpr int BM = 256, BK = 64, HALF = 128, HTB = HALF * BK * 2  , STAGE_BYTES = 8 * HTB, NXCD = 8, WGM = 8;

__host__ __device__ __forceinline__ int lds_byte(int r, int c) { const int st = (r >> 4) * 2 + (c >> 5), rr = r & 15, cc = c & 31, ob = rr * 64 + cc * 2; return st * 1024 + (ob ^ (((ob >> 9) & 1) << 5)); }
__host__ __device__ __forceinline__ void stage_rc(int b, int& R, int& C) { const int st = b / 1024, sb = b % 1024, swz = sb ^ (((sb >> 9) & 1) << 5); R = (st >> 1) * 16 + swz / 64; C = (st & 1) * 32 + (swz % 64) / 2; }
__host__ __device__ __forceinline__ int perm32(int rho) { const int n = rho >> 4, i = rho & 15; return 8 * (i >> 2) + 4 * n + (i & 3); }

struct Unit { int pm, pn; };
struct Gemm { const bf16_t* A; const bf16_t* Bt; int M, N, K; };

struct StaticOrder {
    int nM, nN, nwg, G, c;
    __host__ __device__ void init(int M, int N, int G_, int c_) { nM = M / BM; nN = N / BM; nwg = nM * nN; G = G_; c = c_; }
    __host__ __device__ bool next(int i, Unit& u) const {
        const long L = (long)i * G + c; if (L >= nwg) return false;
        int wgid = (int)L; { const int q = nwg / NXCD, r = nwg % NXCD, xcd = wgid % NXCD, off = wgid / NXCD; wgid = (xcd < r ? xcd * (q + 1) : r * (q + 1) + (xcd - r) * q) + off; }
        const int nig = WGM * nN, gid = wgid / nig, fm = gid * WGM, gsz = (nM - fm) < WGM ? (nM - fm) : WGM;
        u.pm = fm + ((wgid % nig) % gsz); u.pn = (wgid % nig) / gsz; return true;
    }
    __device__ __forceinline__ void a_ready(const Unit&) const {}
    __device__ __forceinline__ void done(const Unit&) const {}
};
typedef __bf16 bf16x2_t __attribute__((ext_vector_type(2)));
typedef float f32x2_t __attribute__((ext_vector_type(2)));
__device__ __forceinline__ unsigned pk2(float lo, float hi) { f32x2_t v = {lo, hi}; bf16x2_t r = __builtin_convertvector(v, bf16x2_t); return __builtin_bit_cast(unsigned, r); }
struct EpiBf16Plain {
    static constexpr bool PERM = true, AFTER_DRAIN = false;
    bf16_t* O; int ldc;
    __device__ __forceinline__ void operator()(const f32x4 (&acc)[2][2][4][2], const Unit& u, int wr, int wc, int fr, int fq) const {
        const int row0 = u.pm * BM + wr * 64 + fr, col0 = u.pn * BM + wc * 32 + 8 * fq;
#pragma unroll
        for (int ai = 0; ai < 2; ++ai)
#pragma unroll
            for (int m = 0; m < 4; ++m) { bf16_t* rowp = O + (size_t)(row0 + ai * HALF + m * 16) * ldc + col0;
#pragma unroll
                for (int bj = 0; bj < 2; ++bj) { const f32x4 v0 = acc[ai][bj][m][0], v1 = acc[ai][bj][m][1];
                    u32x4 w; w.x = pk2(v0[0], v0[1]); w.y = pk2(v0[2], v0[3]); w.z = pk2(v1[0], v1[1]); w.w = pk2(v1[2], v1[3]);
                    *(u32x4*)(rowp + bj * HALF) = w; } }
    }
};
struct EpiResF32 {
    static constexpr bool PERM = false, AFTER_DRAIN = false;
    float* C; int ldc; const float* base; float alpha;
    __device__ __forceinline__ void operator()(const f32x4 (&acc)[2][2][4][2], const Unit& u, int wr, int wc, int fr, int fq) const {
        const int row0 = u.pm * BM + wr * 64 + fr, col0 = u.pn * BM + wc * 32 + 4 * fq;
#pragma unroll
        for (int ai = 0; ai < 2; ++ai)
#pragma unroll
            for (int m = 0; m < 4; ++m) { const size_t ro = (size_t)(row0 + ai * HALF + m * 16) * ldc + col0;
#pragma unroll
                for (int bj = 0; bj < 2; ++bj)
#pragma unroll
                    for (int n = 0; n < 2; ++n) { const f32x4 b = *(const f32x4*)(base + ro + bj * HALF + n * 16);
                        *(f32x4*)(C + ro + bj * HALF + n * 16) = acc[ai][bj][m][n] + b * alpha; } }
    }
};
struct EpiProjRot {
    static constexpr bool PERM = true, AFTER_DRAIN = false;
    bf16_t* O; int ldc; int rot_lo, rot_hi; const float* cs; const float* sn; int seq_mask;
    __device__ __forceinline__ void operator()(const f32x4 (&acc)[2][2][4][2], const Unit& u, int wr, int wc, int fr, int fq) const {
        const int row0 = u.pm * BM + wr * 64 + fr, colt = u.pn * BM, col0 = colt + wc * 32 + 8 * fq;
        const bool rot = (colt >= rot_lo) && (colt < rot_hi);
#pragma unroll
        for (int ai = 0; ai < 2; ++ai)
#pragma unroll
            for (int m = 0; m < 4; ++m) { const int row = row0 + ai * HALF + m * 16; bf16_t* rowp = O + (size_t)row * ldc;
#pragma unroll
                for (int bj = 0; bj < 2; ++bj) { const f32x4 v0 = acc[ai][bj][m][0], v1 = acc[ai][bj][m][1];
                    if (!rot) { u32x4 w; w.x = pk2(v0[0], v0[1]); w.y = pk2(v0[2], v0[3]); w.z = pk2(v1[0], v1[1]); w.w = pk2(v1[2], v1[3]);
                        *(u32x4*)(rowp + col0 + bj * HALF) = w; }
                    else { const int d0 = 16 * wc + 4 * fq;
                        const f32x4 c4 = *(const f32x4*)(cs + (size_t)(row & seq_mask) * 64 + d0), s4 = *(const f32x4*)(sn + (size_t)(row & seq_mask) * 64 + d0);
                        const f32x4 lo = v0 * c4 - v1 * s4, hi = v1 * c4 + v0 * s4;
                        uint2 wl, wh; wl.x = pk2(lo[0], lo[1]); wl.y = pk2(lo[2], lo[3]); wh.x = pk2(hi[0], hi[1]); wh.y = pk2(hi[2], hi[3]);
                        bf16_t* hp = rowp + colt + bj * HALF + d0;
                        *(uint2*)hp = wl; *(uint2*)(hp + 64) = wh; } } }
    }
};

template <class Epi, class Sched, bool STAMP = false>
__device__ __forceinline__ void gemm_phase(PG8_LAS unsigned char* lds, const Gemm g, const Sched& S, const Epi& E, unsigned long long* stamps, const int wid) {
    const int lane = mk_lane_id(), tid = wid * 64 + lane, wr = wid >> 2, wc = wid & 3, fr = lane & 15, fq = lane >> 4;
    const int K = g.K, nt = K / BK;
    int ts_lo = 0, ts_hi = 0, nts = 0; const unsigned long long rt_entry = STAMP ? (unsigned long long)wall_clock64() : 0ull;
#define PG8_STAMP() do { if (STAMP && wid == 0 && nts < 64) { const unsigned long long _c = (unsigned long long)clock64(); \
        ts_lo = (lane == nts) ? (int)(unsigned)_c : ts_lo; ts_hi = (lane == nts) ? (int)(unsigned)(_c >> 32) : ts_hi; ++nts; } } while (0)
    PG8_STAMP();
    unsigned voffA[2], voffB[2];
#pragma unroll
    for (int i = 0; i < 2; ++i) { int R, C; stage_rc(tid * 16 + i * 8192, R, C); const int Rb = Epi::PERM ? ((R & ~31) + perm32(R & 31)) : R;
        voffA[i] = (unsigned)(R * K + C) * 2u; voffB[i] = (unsigned)(Rb * K + C) * 2u; }
    const size_t kstep = (size_t)(BK * 2);
    const size_t hstep = (size_t)HALF * K * 2;
    const size_t tstep = 2 * hstep;
    const unsigned ldsw = (unsigned)wid * 1024u;
    const int aoff = lds_byte(wr * 64 + fr, fq * 8), boff = lds_byte(wc * 32 + fr, fq * 8);
#define PG8_SA(b, h) (((b) * 2 + (h)) * HTB)
#define PG8_SB(b, h) ((4 + (b) * 2 + (h)) * HTB)
#define PG8_STAGE(bufoff, gbase, voff) do { _Pragma("unroll") for (int _i = 0; _i < 2; ++_i) \
        __builtin_amdgcn_global_load_lds((const unsigned*)((const char*)(gbase) + (voff)[_i]), (PG8_LAS unsigned*)(lds + (bufoff) + ldsw + _i * 8192), 16, 0, 0); } while (0)
#define PG8_LDA(dst, b, h) do { _Pragma("unroll") for (int m = 0; m < 4; ++m) _Pragma("unroll") for (int k = 0; k < 2; ++k) dst[m][k] = *(const PG8_LAS bf16x8*)(lds + PG8_SA(b, h) + aoff + m * 2048 + k * 1024); } while (0)
#define PG8_LDB(dst, b, h) do { _Pragma("unroll") for (int n = 0; n < 2; ++n) _Pragma("unroll") for (int k = 0; k < 2; ++k) dst[n][k] = *(const PG8_LAS bf16x8*)(lds + PG8_SB(b, h) + boff + n * 2048 + k * 1024); } while (0)
#define PG8_MMA(ai, bj, At, Bt) do { __builtin_amdgcn_s_setprio(1); _Pragma("unroll") for (int m = 0; m < 4; ++m) _Pragma("unroll") for (int n = 0; n < 2; ++n) _Pragma("unroll") for (int k = 0; k < 2; ++k) \
        acc[ai][bj][m][n] = __builtin_amdgcn_mfma_f32_16x16x32_bf16(Bt[n][k], At[m][k], acc[ai][bj][m][n], 0, 0, 0); __builtin_amdgcn_s_setprio(0); } while (0)
#define PG8_WAIT_V(n) asm volatile("s_waitcnt vmcnt(" #n ")" ::: "memory")
#define PG8_WAIT_L(n) asm volatile("s_waitcnt lgkmcnt(" #n ")" ::: "memory")
#define PG8_BAR __builtin_amdgcn_s_barrier()
#define PG8_SCHED __builtin_amdgcn_sched_barrier(0)
    Unit cur, nxt; int ui = 0;
    if (!S.next(0, cur)) return;
    f32x4 acc[2][2][4][2];
#pragma unroll
    for (int a = 0; a < 2; ++a)
#pragma unroll
        for (int b = 0; b < 2; ++b)
#pragma unroll
            for (int m = 0; m < 4; ++m)
#pragma unroll
                for (int n = 0; n < 2; ++n) acc[a][b][m][n] = (f32x4){0.f, 0.f, 0.f, 0.f};
    bf16x8 At[4][2], B0[2][2], B1[2][2];
    const char* cA = (const char*)g.A + (size_t)cur.pm * tstep; const char* cB = (const char*)g.Bt + (size_t)cur.pn * tstep;
    S.a_ready(cur);
    PG8_STAGE(PG8_SB(0, 0), cB, voffB); PG8_STAGE(PG8_SA(0, 0), cA, voffA); PG8_STAGE(PG8_SB(0, 1), cB + hstep, voffB); PG8_STAGE(PG8_SA(0, 1), cA + hstep, voffA);
    if (wr == 1) PG8_BAR;
    PG8_WAIT_V(4); PG8_BAR;
    PG8_STAGE(PG8_SB(1, 0), cB + kstep, voffB); PG8_STAGE(PG8_SA(1, 0), cA + kstep, voffA); PG8_STAGE(PG8_SB(1, 1), cB + hstep + kstep, voffB);
    PG8_WAIT_V(6); PG8_BAR;
    PG8_STAMP();
    for (;;) {
        const bool has_next = S.next(ui + 1, nxt);
        const char* nA = has_next ? (const char*)g.A + (size_t)nxt.pm * tstep : cA; const char* nB = has_next ? (const char*)g.Bt + (size_t)nxt.pn * tstep : cB;
        for (int t = 0; t < nt; t += 2) {
            const bool last = (t == nt - 2);
            const char* a1 = cA + (size_t)(t + 1) * kstep;
            const char* a2 = last ? nA : cA + (size_t)(t + 2) * kstep; const char* b2 = last ? nB : cB + (size_t)(t + 2) * kstep;
            const char* a3 = a2 + kstep; const char* b3 = b2 + kstep;
            if (last && has_next) S.a_ready(nxt);
            PG8_LDB(B0, 0, 0); PG8_SCHED; PG8_LDA(At, 0, 0); PG8_STAGE(PG8_SA(1, 1), a1 + hstep, voffA);
            PG8_WAIT_L(8); PG8_BAR; PG8_WAIT_L(0); PG8_MMA(0, 0, At, B0); PG8_BAR; PG8_SCHED;
            PG8_LDB(B1, 0, 1); PG8_STAGE(PG8_SB(0, 0), b2, voffB);
            PG8_BAR; PG8_WAIT_L(0); PG8_MMA(0, 1, At, B1); PG8_BAR;
            PG8_LDA(At, 0, 1); PG8_STAGE(PG8_SA(0, 0), a2, voffA);
            PG8_BAR; PG8_WAIT_L(0); PG8_MMA(1, 0, At, B0); PG8_BAR; PG8_SCHED;
            PG8_STAGE(PG8_SB(0, 1), b2 + hstep, voffB);
            PG8_WAIT_V(6); PG8_BAR; PG8_MMA(1, 1, At, B1); PG8_BAR;
            PG8_LDB(B0, 1, 0); PG8_SCHED; PG8_LDA(At, 1, 0); PG8_STAGE(PG8_SA(0, 1), a2 + hstep, voffA);
            PG8_WAIT_L(8); PG8_BAR; PG8_WAIT_L(0); PG8_MMA(0, 0, At, B0); PG8_BAR; PG8_SCHED;
            PG8_LDB(B1, 1, 1); PG8_STAGE(PG8_SB(1, 0), b3, voffB);
            PG8_BAR; PG8_WAIT_L(0); PG8_MMA(0, 1, At, B1); PG8_BAR;
            PG8_LDA(At, 1, 1); PG8_STAGE(PG8_SA(1, 0), a3, voffA);
            PG8_BAR; PG8_WAIT_L(0); PG8_MMA(1, 0, At, B0); PG8_BAR; PG8_SCHED;
            PG8_STAGE(PG8_SB(1, 1), b3 + hstep, voffB);
            PG8_WAIT_V(6); PG8_BAR; PG8_MMA(1, 1, At, B1); PG8_BAR;
        }
        PG8_STAMP();
        if constexpr (!Epi::AFTER_DRAIN) { E(acc, cur, wr, wc, fr, fq); S.done(cur); }
        PG8_STAMP();
        if (!has_next) break;
#pragma unroll
        for (int a = 0; a < 2; ++a)
#pragma unroll
            for (int b = 0; b < 2; ++b)
#pragma unroll
                for (int m = 0; m < 4; ++m)
#pragma unroll
                    for (int n = 0; n < 2; ++n) acc[a][b][m][n] = (f32x4){0.f, 0.f, 0.f, 0.f};
        cur = nxt; cA = nA; cB = nB; ++ui;
    }
    PG8_WAIT_V(0);
    if (wr == 0) PG8_BAR;
    PG8_BAR;
    if constexpr (Epi::AFTER_DRAIN) { E.fused(acc, cur, wr, wc, fr, fq, lds, wid, lane); S.done(cur); }
    PG8_STAMP();
    if (STAMP && wid == 0) { stamps[lane] = lane < nts ? (((unsigned long long)(unsigned)ts_hi << 32) | (unsigned)ts_lo) : 0ull;
        if (lane == 62) stamps[62] = rt_entry; if (lane == 63) stamps[63] = (unsigned long long)wall_clock64(); }
#undef PG8_STAMP
#undef PG8_SA
#undef PG8_SB
#undef PG8_STAGE
#undef PG8_LDA
#undef PG8_LDB
#undef PG8_MMA
#undef PG8_WAIT_V
#undef PG8_WAIT_L
#undef PG8_BAR
#undef PG8_SCHED
}
}
#define XB_TMO      128
#define XB_XCNT(j)  (256  + 64 * (j))
#define XB_XSUB(j)  (1280 + 64 * (j))
#define XB_XGEN(j)  (2304 + 64 * (j))
#define XB_TOP      3328
#define XB_TOPGEN   3392
#define XCD_BAR_WORDS 3456
#define XB_SPIN_CAP (1u << 18)
#define LAS __attribute__((address_space(3)))

__device__ __forceinline__ unsigned xb_ld(unsigned* p)              { return __hip_atomic_load(p, __ATOMIC_RELAXED, __HIP_MEMORY_SCOPE_AGENT); }
__device__ __forceinline__ unsigned xb_add(unsigned* p, unsigned v) { return __hip_atomic_fetch_add(p, v, __ATOMIC_RELAXED, __HIP_MEMORY_SCOPE_AGENT); }
__device__ __forceinline__ unsigned xb_xcc_id() { return (unsigned)__builtin_amdgcn_s_getreg((3 << 11) | 20) & 0xFu; }
#define XB_SPIN(cond, bar) do { unsigned _sp = 0; while (cond) { __builtin_amdgcn_s_sleep(1); \
    if ((++_sp & 255u) == 0u) { if (xb_ld(&(bar)[XB_TMO])) break; if (_sp > XB_SPIN_CAP) { atomicAdd(&(bar)[XB_TMO], 1u); break; } } } } while (0)

struct XcdBarrier {
    unsigned wave;
    unsigned* bar; unsigned x;
    volatile LAS unsigned* st;
};

__device__ __forceinline__ XcdBarrier xcd_barrier_post(unsigned* bar, volatile LAS unsigned* st, unsigned wave) {
    XcdBarrier b; b.wave = wave; b.bar = bar; b.x = xb_xcc_id(); b.st = st;
    if (wave == 0u && mk_lane_id() == 0) (void)xb_add(&bar[XB_XCNT(b.x)], 1u);
    return b;
}
__device__ __forceinline__ void xcd_barrier_complete(unsigned* bar, unsigned x, unsigned& nloc, unsigned& nx) {
    const unsigned G = gridDim.x * gridDim.y * gridDim.z;
    unsigned sum, cnt, mine, sp = 0u;
    for (;;) {
        sum = 0u; cnt = 0u; mine = 0u;
#pragma unroll
        for (unsigned j = 0; j < 16; ++j) { const unsigned c = xb_ld(&bar[XB_XCNT(j)]); sum += c; cnt += (c > 0u) ? 1u : 0u; mine = (j == x) ? c : mine; }
        if (sum == G) break;
        __builtin_amdgcn_s_sleep(1);
        if ((++sp & 255u) == 0u) { if (xb_ld(&bar[XB_TMO])) break; if (sp > XB_SPIN_CAP) { atomicAdd(&bar[XB_TMO], 1u); break; } }
    }
    nloc = mine > 0u ? mine : 1u; nx = cnt > 0u ? cnt : 1u;
}

__device__ __forceinline__ void xcd_barrier(const XcdBarrier& b) {
    asm volatile("s_waitcnt vmcnt(0)" ::: "memory");
    __syncthreads();
    if (b.wave == 0u && mk_lane_id() == 0) {
        unsigned* bar = b.bar;
        __builtin_amdgcn_s_waitcnt(0);
        unsigned nloc = b.st[0], nx = b.st[1];
        if (nloc == 0u) { xcd_barrier_complete(bar, b.x, nloc, nx); b.st[0] = nloc; b.st[1] = nx; }
        const unsigned old = xb_add(&bar[XB_XSUB(b.x)], 1u);
        const unsigned gen = old / nloc;
        if (old + 1u == (gen + 1u) * nloc) {
            __builtin_amdgcn_fence(__ATOMIC_RELEASE, "agent");
            asm volatile("s_waitcnt vmcnt(0)" ::: "memory");
            const unsigned og = xb_add(&bar[XB_TOP], 1u);
            const unsigned tg = og / nx;
            if (og + 1u == (tg + 1u) * nx) xb_add(&bar[XB_TOPGEN], 1u);
            else XB_SPIN(xb_ld(&bar[XB_TOPGEN]) == tg, bar);
            __builtin_amdgcn_fence(__ATOMIC_ACQUIRE, "agent");
            xb_add(&bar[XB_XGEN(b.x)], 1u);
            asm volatile("s_waitcnt vmcnt(0)" ::: "memory");
        } else {
            XB_SPIN(xb_ld(&bar[XB_XGEN(b.x)]) == gen, bar);
            __builtin_amdgcn_fence(__ATOMIC_ACQUIRE, "agent");
            asm volatile("s_waitcnt vmcnt(0)" ::: "memory");
        }
    }
    __syncthreads();
}
namespace mk {
typedef unsigned short bf16_t;
typedef float f32x4 __attribute__((ext_vector_type(4)));
using pg8::pk2;
constexpr int D = 2048, NB = 4, S = 2048, T = NB * S, HD = 128, INW = 7168;
constexpr int NKEYS = 128;
constexpr float ALPHA = 1.189207115002721f;
constexpr int NTHR = 512;
constexpr size_t MiB = (size_t)1 << 20;
constexpr size_t WS_CTL = 0;
constexpr size_t CTL_BYTES = 64 * 1024;
constexpr size_t WS_XB = 1 * MiB;
constexpr size_t WS_WIN = 33 * MiB;
constexpr size_t WS_WOUT = 61 * MiB;
constexpr size_t WS_WPQ = 69 * MiB;
constexpr size_t WS_SKB = 77 * MiB;
constexpr size_t WS_ROT = 78 * MiB;
constexpr size_t WS_PROJ = 80 * MiB;
constexpr size_t WS_MIXED = 192 * MiB;
constexpr size_t WS_Y1 = 224 * MiB;
constexpr size_t WS_X1B = 288 * MiB;
constexpr size_t WS_QP = 320 * MiB;
constexpr size_t WS_EIDX = 352 * MiB;
constexpr size_t WS_EGATE = 356 * MiB;
constexpr size_t WS_PREV = 360 * MiB;
constexpr size_t WS_SE = 392 * MiB;
constexpr size_t WS_SG = 396 * MiB;
constexpr size_t WS_UQ = 417 * MiB;
constexpr size_t WS_VQ = 449 * MiB;
constexpr size_t WS_SU = 400 * MiB;
constexpr size_t WS_SV = 400 * MiB + 65536;
constexpr size_t WS_SX = 400 * MiB + 131072;
constexpr size_t WS_X1Q = 401 * MiB;
constexpr size_t WS_END = 481 * MiB;
constexpr size_t CTL_QUEUE = 32768;
constexpr int LDS_MISC = 2048;
constexpr int LDS_BYTES = pg8::STAGE_BYTES + LDS_MISC;

__device__ __forceinline__ float bflo(unsigned u) { return __uint_as_float(u << 16); }
__device__ __forceinline__ float bfhi(unsigned u) { return __uint_as_float(u & 0xffff0000u); }
__device__ __forceinline__ float wave_sum(float v) {
#pragma unroll
  for (int o = 32; o > 0; o >>= 1) v += __shfl_xor(v, o);
  return v;
}
__device__ __forceinline__ float wave_max(float v) {
#pragma unroll
  for (int o = 32; o > 0; o >>= 1) v = fmaxf(v, __shfl_xor(v, o));
  return v;
}
__device__ __forceinline__ int wave_min_i(int v) {
#pragma unroll
  for (int o = 32; o > 0; o >>= 1) v = min(v, __shfl_xor(v, o));
  return v;
}

struct Ctx {
  const float* in[13];
  float* out;
  unsigned char* ws;
  LAS unsigned char* lds;
  int wave, G;
};

__device__ __forceinline__ void transpose_bf16(const Ctx& c, const float* __restrict__ w, bf16_t* __restrict__ wt, int K, int N, int rot_lo = 0, int rot_hi = 0) {
  LAS float* tile = (LAS float*)c.lds;
  const int ntk = K / 64, ntiles = ntk * (N / 64);
  for (int tile_i = blockIdx.x; tile_i < ntiles; tile_i += c.G) {
    const int k0 = (tile_i % ntk) * 64, n0 = (tile_i / ntk) * 64;
    {
      const int r = (c.wave * 64 + mk_lane_id()) >> 3, c8 = ((c.wave * 64 + mk_lane_id()) & 7) * 8;
      const float4 a = *(const float4*)(w + (size_t)(k0 + r) * N + n0 + c8);
      const float4 b = *(const float4*)(w + (size_t)(k0 + r) * N + n0 + c8 + 4);
      LAS float* p = tile + r * 65 + c8;
      p[0] = a.x; p[1] = a.y; p[2] = a.z; p[3] = a.w; p[4] = b.x; p[5] = b.y; p[6] = b.z; p[7] = b.w;
    }
    __syncthreads();
    {
      const int n = (c.wave * 64 + mk_lane_id()) >> 3, k8 = ((c.wave * 64 + mk_lane_id()) & 7) * 8;
      float v[8];
#pragma unroll
      for (int j = 0; j < 8; ++j) v[j] = tile[(k8 + j) * 65 + n];
      uint4 o; o.x = pk2(v[0], v[1]); o.y = pk2(v[2], v[3]); o.z = pk2(v[4], v[5]); o.w = pk2(v[6], v[7]);
      int nrow = n0 + n;
      if (nrow >= rot_lo && nrow < rot_hi) { const int d = nrow & 127; nrow = (nrow & ~127) + 8 * ((d & 63) >> 2) + (d & 3) + 4 * (d >> 6); }
      *(uint4*)(wt + (size_t)nrow * K + k0 + k8) = o;
    }
    __syncthreads();
  }
}
__device__ __forceinline__ void p0_prologue(const Ctx& c) {
  const size_t gtid = (size_t)blockIdx.x * NTHR + (c.wave * 64 + mk_lane_id()), gstride = (size_t)c.G * NTHR;
  {
    const float4* x4 = (const float4*)c.in[0];
    uint4* xb4 = (uint4*)(c.ws + WS_XB);
    for (size_t i = gtid; i < (size_t)T * D / 8; i += gstride) {
      const float4 a = x4[2 * i], b = x4[2 * i + 1];
      uint4 o; o.x = pk2(a.x, a.y); o.y = pk2(a.z, a.w); o.z = pk2(b.x, b.y); o.w = pk2(b.z, b.w);
      xb4[i] = o;
    }
  }
  transpose_bf16(c, c.in[1], (bf16_t*)(c.ws + WS_WIN), D, INW, 3072, 5120);
  transpose_bf16(c, c.in[4], (bf16_t*)(c.ws + WS_WOUT), D, D);
  transpose_bf16(c, c.in[7], (bf16_t*)(c.ws + WS_WPQ), D, D);
  {
    const float4* s4 = (const float4*)c.in[8];
    uint4* d4 = (uint4*)(c.ws + WS_SKB);
    for (size_t i = gtid; i < (size_t)8 * 2 * 128 * 128 / 8; i += gstride) {
      const float4 a = s4[2 * i], b = s4[2 * i + 1];
      uint4 o; o.x = pk2(a.x, a.y); o.y = pk2(a.z, a.w); o.z = pk2(b.x, b.y); o.w = pk2(b.z, b.w);
      d4[i] = o;
    }
  }
  {
    float* cs = (float*)(c.ws + WS_ROT);
    float* sn = cs + S * 64;
    for (size_t i = gtid; i < (size_t)S * 64; i += gstride) {
      const int s = (int)(i >> 6), f = (int)(i & 63);
      const float inv_freq = (float)pow(10000.0, -(2.0 * f) / 128.0);
      const float ang = (float)s * inv_freq;
      cs[i] = (float)cos((double)ang);
      sn[i] = (float)sin((double)ang);
    }
  }
}

__device__ __forceinline__ void p2_rotate(const Ctx& c) {
  bf16_t* proj = (bf16_t*)(c.ws + WS_PROJ);
  const float* cs = (const float*)(c.ws + WS_ROT);
  const float* sn = cs + S * 64;
  const size_t gtid = (size_t)blockIdx.x * NTHR + (c.wave * 64 + mk_lane_id()), gstride = (size_t)c.G * NTHR;
  for (size_t it = gtid; it < (size_t)T * 128; it += gstride) {
    const int row = (int)(it >> 7), rem = (int)(it & 127);
    const int which = rem >> 6, h = (rem >> 3) & 7, i0 = (rem & 7) * 8;
    const int s = row & (S - 1);
    bf16_t* p = proj + (size_t)row * INW + 3072 + which * 1024 + h * HD + i0;
    const uint4 lo = *(const uint4*)p, hi = *(const uint4*)(p + 64);
    const float4 c0 = *(const float4*)(cs + s * 64 + i0), c1 = *(const float4*)(cs + s * 64 + i0 + 4);
    const float4 s0 = *(const float4*)(sn + s * 64 + i0), s1 = *(const float4*)(sn + s * 64 + i0 + 4);
    const float cv[8] = {c0.x, c0.y, c0.z, c0.w, c1.x, c1.y, c1.z, c1.w};
    const float sv[8] = {s0.x, s0.y, s0.z, s0.w, s1.x, s1.y, s1.z, s1.w};
    const unsigned lw[4] = {lo.x, lo.y, lo.z, lo.w}, hw[4] = {hi.x, hi.y, hi.z, hi.w};
    unsigned ol[4], oh[4];
#pragma unroll
    for (int j = 0; j < 4; ++j) {
      const float l0 = bflo(lw[j]), l1 = bfhi(lw[j]), h0 = bflo(hw[j]), h1 = bfhi(hw[j]);
      const float nl0 = l0 * cv[2 * j] - h0 * sv[2 * j], nl1 = l1 * cv[2 * j + 1] - h1 * sv[2 * j + 1];
      const float nh0 = h0 * cv[2 * j] + l0 * sv[2 * j], nh1 = h1 * cv[2 * j + 1] + l1 * sv[2 * j + 1];
      ol[j] = pk2(nl0, nl1); oh[j] = pk2(nh0, nh1);
    }
    uint4 a; a.x = ol[0]; a.y = ol[1]; a.z = ol[2]; a.w = ol[3];
    uint4 b; b.x = oh[0]; b.y = oh[1]; b.z = oh[2]; b.w = oh[3];
    *(uint4*)p = a; *(uint4*)(p + 64) = b;
  }
}

__device__ __forceinline__ void quant_rows(const Ctx& c, int rr0, int nrows) {
  const int lane = mk_lane_id();
  for (int rr = rr0; rr < rr0 + nrows; ++rr) {
    const int which = rr >> 14, row = rr & 16383;
    const float* src = (which ? c.in[10] : c.in[9]) + (size_t)row * D;
    f32x4 v[8];
    float mx = 0.f;
#pragma unroll
    for (int i = 0; i < 8; ++i) {
      v[i] = *(const f32x4*)(src + (i * 64 + lane) * 4);
      mx = fmaxf(mx, fmaxf(fmaxf(fabsf(v[i][0]), fabsf(v[i][1])), fmaxf(fabsf(v[i][2]), fabsf(v[i][3]))));
    }
    mx = fmaxf(wave_max(mx), 1e-30f);
    const float inv = 127.f / mx;
    unsigned* dst = (unsigned*)(c.ws + (which ? WS_VQ : WS_UQ) + (size_t)row * D);
    const int off = which ? 128 : 0;
#pragma unroll
    for (int i = 0; i < 8; ++i) {
      unsigned w = 0;
#pragma unroll
      for (int k = 0; k < 4; ++k) { const int q = (int)rintf(v[i][k] * inv) + off; w |= ((unsigned)q & 255u) << (8 * k); }
      dst[i * 64 + lane] = w;
    }
    if (lane == 0) ((float*)(c.ws + (which ? WS_SV : WS_SU)))[row] = mx * (1.f / 127.f);
  }
}

__device__ __forceinline__ void p3_attn_naive(const Ctx& c) {
  const bf16_t* proj = (const bf16_t*)(c.ws + WS_PROJ);
  bf16_t* mixed = (bf16_t*)(c.ws + WS_MIXED);
  const float* sbw = c.in[2];
  const float* rnw = c.in[3];
  const int lane = mk_lane_id(), gw = blockIdx.x * 8 + c.wave, NW = c.G * 8;
  const float scale = 0.08838834764831845f;
  for (int r = gw; r < NB * 8 * S; r += NW) {
    const int bh = r >> 11, t = r & (S - 1), b = bh >> 3, h = bh & 7;
    const bf16_t* base = proj + (size_t)b * S * INW + h * HD + lane * 2;
    const unsigned qw = *(const unsigned*)(base + (size_t)t * INW);
    const float qx = bflo(qw), qy = bfhi(qw);
    float ox = 0.f, oy = 0.f, run = 0.f;
    for (int s = t - 1; s >= 0; --s) {
      const unsigned kw = *(const unsigned*)(base + (size_t)s * INW + 1024);
      const unsigned vw = *(const unsigned*)(base + (size_t)s * INW + 2048);
      const float z = wave_sum(qx * bflo(kw) + qy * bfhi(kw)) * scale;
      const float l1p = log1pf(expf(-fabsf(z)));
      const float sp = fmaxf(z, 0.f) + l1p;
      const float ls = fminf(z, 0.f) - l1p;
      const float a = expf(ls - run);
      ox += a * bflo(vw); oy += a * bfhi(vw);
      run += sp;
      if (run > 104.f) break;
    }
    const float ms = wave_sum(ox * ox + oy * oy) * (1.f / 128.f);
    const float rr = rsqrtf(ms + 1e-6f);
    const float2 wv = *(const float2*)(sbw + h * HD + lane * 2);
    *(unsigned*)(mixed + (size_t)(b * S + t) * D + h * HD + lane * 2) = pk2(ox * rr * wv.x, oy * rr * wv.y);
  }
  for (int r = gw; r < NB * 8 * S; r += NW) {
    const int bh = r >> 11, tt = r & (S - 1), b = bh >> 3, h = bh & 7;
    const int t = (bh & 1) ? (S - 1 - tt) : tt;
    const bf16_t* base = proj + (size_t)b * S * INW + h * HD + lane * 2;
    const unsigned qw = *(const unsigned*)(base + (size_t)t * INW + 3072);
    const float qx = bflo(qw), qy = bfhi(qw);
    const float log_g = log1pf(-exp2f(-5.f - (float)h));
    const int s_end = ((t >> 6) + 1) << 6;
    float ox = 0.f, oy = 0.f;
    for (int s = 0; s < s_end; ++s) {
      const unsigned kw = *(const unsigned*)(base + (size_t)s * INW + 4096);
      const unsigned vw = *(const unsigned*)(base + (size_t)s * INW + 5120);
      const float dist = fabsf((float)(t - s));
      const float z = wave_sum(qx * bflo(kw) + qy * bfhi(kw)) * scale * expf(log_g * dist);
      ox += z * bflo(vw); oy += z * bfhi(vw);
    }
    const float mu = wave_sum(ox + oy) * (1.f / 128.f);
    const float dx = ox - mu, dy = oy - mu;
    const float var = wave_sum(dx * dx + dy * dy) * (1.f / 128.f);
    const float rr = rsqrtf(var + 1e-6f);
    const float2 wv = *(const float2*)(rnw + h * HD + lane * 2);
    const unsigned gwd = *(const unsigned*)(base + (size_t)t * INW + 6144);
    const float gx = bflo(gwd), gy = bfhi(gwd);
    const float sx = gx / (1.f + expf(-gx)), sy = gy / (1.f + expf(-gy));
    *(unsigned*)(mixed + (size_t)(b * S + t) * D + 1024 + h * HD + lane * 2) = pk2(dx * rr * wv.x * sx, dy * rr * wv.y * sy);
  }
}

typedef short bf16x8 __attribute__((ext_vector_type(8)));
typedef short s16x4 __attribute__((ext_vector_type(4)));
typedef float f32x16 __attribute__((ext_vector_type(16)));
typedef unsigned u32x4 __attribute__((ext_vector_type(4)));
#define MFMA32(a, b, c) __builtin_amdgcn_mfma_f32_32x32x16_bf16((a), (b), (c), 0, 0, 0)
constexpr int WAVE_LDS = 10240;
constexpr int VRS = 320;
constexpr float SCALE = 0.08838834764831845f;
constexpr float LOG2E = 1.4426950408889634f;
__device__ __forceinline__ int crow(int reg, int h) { return (reg & 3) + 8 * (reg >> 2) + 4 * h; }
__device__ __forceinline__ int krow(int s, int h, int j) { return 16 * s + 8 * (j >> 2) + 4 * h + (j & 3); }
__device__ __forceinline__ bf16x8 pack8(const f32x16& x, const int s) {
  u32x4 p;
  p[0] = pk2(x[8 * s + 0], x[8 * s + 1]); p[1] = pk2(x[8 * s + 2], x[8 * s + 3]);
  p[2] = pk2(x[8 * s + 4], x[8 * s + 5]); p[3] = pk2(x[8 * s + 6], x[8 * s + 7]);
  return __builtin_bit_cast(bf16x8, p);
}
__device__ __forceinline__ s16x4 tr16(LAS unsigned char* p) { return __builtin_amdgcn_ds_read_tr16_b64_v4i16((LAS s16x4*)p); }
__device__ __forceinline__ bf16x8 cat8(s16x4 lo, s16x4 hi) { return __builtin_shufflevector(lo, hi, 0, 1, 2, 3, 4, 5, 6, 7); }
__device__ __forceinline__ void wave_lds_fence() { asm volatile("s_waitcnt lgkmcnt(0)" ::: "memory"); }
__device__ __forceinline__ float half_sum(float v) {
#pragma unroll
  for (int o = 16; o > 0; o >>= 1) v += __shfl_xor(v, o);
  return v;
}
__device__ __forceinline__ void vtile_load(u32x4 (&vr)[8], const bf16_t* vbase, int lane) {
#pragma unroll
  for (int it = 0; it < 8; ++it) vr[it] = *(const u32x4*)(vbase + (size_t)(4 * it + (lane >> 4)) * INW + (lane & 15) * 8);
}
__device__ __forceinline__ void vtile_store(const u32x4 (&vr)[8], LAS unsigned char* wl, int lane) {
#pragma unroll
  for (int it = 0; it < 8; ++it) *(LAS u32x4*)(wl + (4 * it + (lane >> 4)) * VRS + (lane & 15) * 16) = vr[it];
}
__device__ __forceinline__ void pv_accum(f32x16 (&o)[4], const f32x16& a, LAS unsigned char* wl, int lane) {
  const int h = lane >> 5, i16 = lane & 15, q = i16 >> 2, p = i16 & 3, blk = (lane >> 4) & 1;
  const bf16x8 pa0 = pack8(a, 0), pa1 = pack8(a, 1);
  LAS unsigned char* b0 = wl + (4 * h + q) * VRS + (16 * blk + 4 * p) * 2;
#pragma unroll
  for (int cidx = 0; cidx < 4; ++cidx) {
#pragma unroll
    for (int s = 0; s < 2; ++s) {
      const s16x4 lo = tr16(b0 + (16 * s) * VRS + cidx * 64);
      const s16x4 hi = tr16(b0 + (16 * s + 8) * VRS + cidx * 64);
      o[cidx] = MFMA32(s == 0 ? pa0 : pa1, cat8(lo, hi), o[cidx]);
    }
  }
}

__device__ __forceinline__ void sb_task(const Ctx& c, int task, LAS unsigned char* wl) {
  const bf16_t* proj = (const bf16_t*)(c.ws + WS_PROJ);
  bf16_t* mixed = (bf16_t*)(c.ws + WS_MIXED);
  const float* sbw = c.in[2];
  const int lane = mk_lane_id(), r = lane & 31, h = lane >> 5;
  const int qb = task & 63, bh = task >> 6, b = bh >> 3, hd = bh & 7, q0 = qb * 32;
  const bf16_t* base = proj + (size_t)b * S * INW + hd * HD;
  bf16x8 qf[8];
#pragma unroll
  for (int s = 0; s < 8; ++s) qf[s] = *(const bf16x8*)(base + (size_t)(q0 + r) * INW + 16 * s + 8 * h);
  bf16x8 tf[2];
#pragma unroll
  for (int s = 0; s < 2; ++s)
#pragma unroll
    for (int jj = 0; jj < 8; ++jj) tf[s][jj] = (krow(s, h, jj) > r) ? (short)0x3F80 : (short)0;
  f32x16 o[4];
#pragma unroll
  for (int cidx = 0; cidx < 4; ++cidx)
#pragma unroll
    for (int i = 0; i < 16; ++i) o[cidx][i] = 0.f;
  float R = 0.f;
  const float c2 = SCALE * LOG2E;
  for (int k0 = q0; k0 >= 0; k0 -= 32) {
    u32x4 vr[8];
    vtile_load(vr, base + 2048 + (size_t)k0 * INW, lane);
    f32x16 st;
#pragma unroll
    for (int i = 0; i < 16; ++i) st[i] = 0.f;
#pragma unroll
    for (int s = 0; s < 8; ++s) {
      const bf16x8 kf = *(const bf16x8*)(base + 1024 + (size_t)(k0 + r) * INW + 16 * s + 8 * h);
      st = MFMA32(kf, qf[s], st);
    }
    const bool diag = (k0 == q0);
    f32x16 sp, m;
#pragma unroll
    for (int i = 0; i < 16; ++i) {
      const float y = st[i] * c2;
      const float e = __builtin_amdgcn_exp2f(-fabsf(y));
      const float l = __builtin_amdgcn_logf(1.f + e);
      const bool valid = !diag || (crow(i, h) < r);
      sp[i] = valid ? (fmaxf(y, 0.f) + l) : 0.f;
      st[i] = y; m[i] = R;
    }
    m = MFMA32(tf[0], pack8(sp, 0), m);
    m = MFMA32(tf[1], pack8(sp, 1), m);
    f32x16 a;
#pragma unroll
    for (int i = 0; i < 16; ++i) {
      const bool valid = !diag || (crow(i, h) < r);
      const float v = __builtin_amdgcn_exp2f(st[i] - sp[i] - m[i]);
      a[i] = valid ? v : 0.f;
    }
    R = __shfl(m[0] + sp[0], r);
    vtile_store(vr, wl, lane);
    wave_lds_fence();
    pv_accum(o, a, wl, lane);
    if (__all(R > 150.5f)) break;
  }
#pragma unroll
  for (int i = 0; i < 16; ++i) {
    const float ss = half_sum(o[0][i] * o[0][i] + o[1][i] * o[1][i] + o[2][i] * o[2][i] + o[3][i] * o[3][i]);
    const float rr = rsqrtf(ss * (1.f / 128.f) + 1e-6f);
    bf16_t* orow = mixed + (size_t)(b * S + q0 + crow(i, h)) * D + hd * HD + r;
#pragma unroll
    for (int cidx = 0; cidx < 4; ++cidx) orow[32 * cidx] = (bf16_t)(pk2(o[cidx][i] * rr * sbw[hd * HD + 32 * cidx + r], 0.f) & 0xffffu);
  }
}

__device__ __forceinline__ void state_task(const Ctx& c, int task, LAS unsigned char* wl) {
  const bf16_t* proj = (const bf16_t*)(c.ws + WS_PROJ);
  bf16_t* prevT = (bf16_t*)(c.ws + WS_PREV);
  const int lane = mk_lane_id(), r = lane & 31, h = lane >> 5;
  const int vblk = task & 3, dblk = (task >> 2) & 3, bh = task >> 4, b = bh >> 3, hd = bh & 7;
  const bf16_t* kbase = proj + (size_t)b * S * INW + 4096 + hd * HD + 32 * dblk;
  const bf16_t* vbase = proj + (size_t)b * S * INW + 5120 + hd * HD + 32 * vblk;
  const float log2g = __builtin_amdgcn_logf(1.f - exp2f(-5.f - (float)hd));
  const float cd = exp2f(log2g * 64.f);
  f32x16 acc;
#pragma unroll
  for (int i = 0; i < 16; ++i) acc[i] = 0.f;
  const int i16 = lane & 15, q = i16 >> 2, p = i16 & 3, blk = (lane >> 4) & 1;
  LAS unsigned char* kt = wl;
  LAS unsigned char* vt = wl + 4096;
  const int toff = (8 * h + q) * 64 + (16 * blk + 4 * p) * 2;
  constexpr int SD = 2;
  u32x4 kq[SD][4], vv[SD][4];
#define ST_ISSUE(SL, N) do { const int n_ = (N) < S / 64 ? (N) : S / 64 - 1; _Pragma("unroll") for (int it_ = 0; it_ < 4; ++it_) { \
      const int idx_ = it_ * 64 + lane, row_ = idx_ >> 2, ch_ = idx_ & 3; \
      kq[SL][it_] = *(const u32x4*)(kbase + (size_t)(n_ * 64 + row_) * INW + 8 * ch_); \
      vv[SL][it_] = *(const u32x4*)(vbase + (size_t)(n_ * 64 + row_) * INW + 8 * ch_); } } while (0)
#pragma unroll
  for (int sl = 0; sl < SD; ++sl) ST_ISSUE(sl, sl);
#pragma unroll 1
  for (int n0 = 0; n0 < S / 64; n0 += SD) {
#pragma unroll
    for (int sl = 0; sl < SD; ++sl) {
      const int n = n0 + sl;
      bf16_t* pp = prevT + ((size_t)(bh * 32 + n) * 128 + 32 * vblk + r) * 128 + 32 * dblk + 4 * h;
#pragma unroll
      for (int g = 0; g < 4; ++g) {
        uint2 w; w.x = pk2(acc[4 * g], acc[4 * g + 1]); w.y = pk2(acc[4 * g + 2], acc[4 * g + 3]);
        *(uint2*)(pp + 8 * g) = w;
      }
#pragma unroll
      for (int it = 0; it < 4; ++it) {
        const int idx = it * 64 + lane, row = idx >> 2, ch = idx & 3;
        *(LAS u32x4*)(kt + row * 64 + ch * 16) = kq[sl][it];
        *(LAS u32x4*)(vt + row * 64 + ch * 16) = vv[sl][it];
      }
      ST_ISSUE(sl, n + SD);
      wave_lds_fence();
#pragma unroll
      for (int i = 0; i < 16; ++i) acc[i] *= cd;
#pragma unroll
      for (int s = 0; s < 4; ++s) {
        const s16x4 klo = tr16(kt + toff + (16 * s) * 64), khi = tr16(kt + toff + (16 * s + 4) * 64);
        const s16x4 vlo = tr16(vt + toff + (16 * s) * 64), vhi = tr16(vt + toff + (16 * s + 4) * 64);
        const u32x4 kraw = __builtin_bit_cast(u32x4, cat8(klo, khi));
        u32x4 ks;
#pragma unroll
        for (int jj = 0; jj < 4; ++jj) {
          const float z0 = SCALE * __builtin_amdgcn_exp2f(log2g * (float)(63 - (16 * s + 8 * h + 2 * jj)));
          const float z1 = SCALE * __builtin_amdgcn_exp2f(log2g * (float)(63 - (16 * s + 8 * h + 2 * jj + 1)));
          ks[jj] = pk2(bflo(kraw[jj]) * z0, bfhi(kraw[jj]) * z1);
        }
        acc = MFMA32(__builtin_bit_cast(bf16x8, ks), cat8(vlo, vhi), acc);
      }
    }
  }
#undef ST_ISSUE
}

__device__ __forceinline__ void retout_task(const Ctx& c, int task, LAS unsigned char* wl) {
  const bf16_t* proj = (const bf16_t*)(c.ws + WS_PROJ);
  const bf16_t* prevT = (const bf16_t*)(c.ws + WS_PREV);
  bf16_t* mixed = (bf16_t*)(c.ws + WS_MIXED);
  const float* rnw = c.in[3];
  const int lane = mk_lane_id(), r = lane & 31, h = lane >> 5;
  const int half = task & 1, n = (task >> 1) & 31, bh = task >> 6, b = bh >> 3, hd = bh & 7;
  const bf16_t* base = proj + (size_t)b * S * INW + hd * HD;
  const float log2g = __builtin_amdgcn_logf(1.f - exp2f(-5.f - (float)hd));
  const int qpos0 = n * 64 + 32 * half;
  bf16x8 qf[8];
#pragma unroll
  for (int s = 0; s < 8; ++s) qf[s] = *(const bf16x8*)(base + 3072 + (size_t)(qpos0 + r) * INW + 16 * s + 8 * h);
  f32x16 o[4];
#pragma unroll
  for (int cidx = 0; cidx < 4; ++cidx)
#pragma unroll
    for (int i = 0; i < 16; ++i) o[cidx][i] = 0.f;
  if (n > 0) {
    const bf16_t* pb = prevT + ((size_t)(bh * 32 + n) * 128 + r) * 128 + 8 * h;
#pragma unroll
    for (int cidx = 0; cidx < 4; ++cidx)
#pragma unroll
      for (int s = 0; s < 8; ++s) {
        const bf16x8 pf = *(const bf16x8*)(pb + (size_t)(32 * cidx) * 128 + 16 * s);
        o[cidx] = MFMA32(qf[s], pf, o[cidx]);
      }
#pragma unroll
    for (int i = 0; i < 16; ++i) {
      const float xi = __builtin_amdgcn_exp2f(log2g * (float)(32 * half + crow(i, h) + 1));
#pragma unroll
      for (int cidx = 0; cidx < 4; ++cidx) o[cidx][i] *= xi;
    }
  }
#pragma unroll 1
  for (int tile = 0; tile < 2; ++tile) {
    const int kpos0 = n * 64 + 32 * tile;
    u32x4 vr[8];
    vtile_load(vr, base + 5120 + (size_t)kpos0 * INW, lane);
    f32x16 st;
#pragma unroll
    for (int i = 0; i < 16; ++i) st[i] = 0.f;
#pragma unroll
    for (int s = 0; s < 8; ++s) {
      const bf16x8 kf = *(const bf16x8*)(base + 4096 + (size_t)(kpos0 + r) * INW + 16 * s + 8 * h);
      st = MFMA32(kf, qf[s], st);
    }
#pragma unroll
    for (int i = 0; i < 16; ++i) {
      const float dist = fabsf((float)((32 * half + r) - (32 * tile + crow(i, h))));
      st[i] *= SCALE * __builtin_amdgcn_exp2f(log2g * dist);
    }
    vtile_store(vr, wl, lane);
    wave_lds_fence();
    pv_accum(o, st, wl, lane);
  }
#pragma unroll
  for (int i = 0; i < 16; ++i) {
    const float mu = half_sum((o[0][i] + o[1][i]) + (o[2][i] + o[3][i])) * (1.f / 128.f);
    float d[4], qq = 0.f;
#pragma unroll
    for (int cidx = 0; cidx < 4; ++cidx) { d[cidx] = o[cidx][i] - mu; qq += d[cidx] * d[cidx]; }
    const float rr = rsqrtf(half_sum(qq) * (1.f / 128.f) + 1e-6f);
    const size_t tok = (size_t)(b * S + qpos0 + crow(i, h));
    const bf16_t* grow = proj + tok * INW + 6144 + hd * HD + r;
    bf16_t* orow = mixed + tok * D + 1024 + hd * HD + r;
#pragma unroll
    for (int cidx = 0; cidx < 4; ++cidx) {
      const float g = __uint_as_float((unsigned)grow[32 * cidx] << 16);
      const float sg = g / (1.f + __expf(-g));
      orow[32 * cidx] = (bf16_t)(pk2(d[cidx] * rr * rnw[hd * HD + 32 * cidx + r] * sg, 0.f) & 0xffffu);
    }
  }
}
constexpr int Q_STATE = NB * 8 * 16, Q_SB = NB * 8 * (S / 32), Q_QUANT = 2 * 16384 / 64, Q_TOTAL = Q_STATE + Q_SB + Q_QUANT;
__device__ __forceinline__ unsigned queue_pop(unsigned* ctr) {
  unsigned it = 0;
  if (mk_lane_id() == 0) it = __hip_atomic_fetch_add(ctr, 1u, __ATOMIC_RELAXED, __HIP_MEMORY_SCOPE_AGENT);
  return (unsigned)__builtin_amdgcn_readfirstlane((int)it);
}
__device__ __forceinline__ void p3_attn_a(const Ctx& c) {
  LAS unsigned char* wl = c.lds + c.wave * WAVE_LDS;
  const int gw = blockIdx.x * 8 + c.wave, NW = c.G * 8;
  for (int t = gw; t < Q_SB; t += NW) sb_task(c, t, wl);
  if (c.wave < 2) for (int t = blockIdx.x * 2 + c.wave; t < Q_STATE; t += c.G * 2) state_task(c, t, wl);
}
__device__ __forceinline__ void p4_attn_b(const Ctx& c) {
  LAS unsigned char* wl = c.lds + c.wave * WAVE_LDS;
  const int gw = blockIdx.x * 8 + c.wave, NW = c.G * 8;
  for (int t = gw; t < NB * 8 * 64; t += NW) retout_task(c, t, wl);
}

__device__ __forceinline__ void p5_ln1(const Ctx& c) {
  float* y1 = (float*)(c.ws + WS_Y1);
  bf16_t* x1b = (bf16_t*)(c.ws + WS_X1B);
  const float* w = c.in[5];
  const float* bb = c.in[6];
  const int lane = mk_lane_id(), gw = blockIdx.x * 8 + c.wave, NW = c.G * 8;
  for (int row = gw; row < T; row += NW) {
    float* p = y1 + (size_t)row * D;
    f32x4 v[8];
    float s = 0.f;
#pragma unroll
    for (int i = 0; i < 8; ++i) { v[i] = *(const f32x4*)(p + (i * 64 + lane) * 4); s += (v[i][0] + v[i][1]) + (v[i][2] + v[i][3]); }
    const float mu = wave_sum(s) * (1.f / D);
    float q = 0.f;
#pragma unroll
    for (int i = 0; i < 8; ++i) { const f32x4 d = v[i] - mu; q += (d[0] * d[0] + d[1] * d[1]) + (d[2] * d[2] + d[3] * d[3]); }
    const float rr = rsqrtf(wave_sum(q) * (1.f / D) + 1e-5f);
#pragma unroll
    for (int i = 0; i < 8; ++i) {
      const int col = (i * 64 + lane) * 4;
      const f32x4 wv = *(const f32x4*)(w + col), bv = *(const f32x4*)(bb + col);
      const f32x4 o = (v[i] - mu) * rr * wv + bv;
      *(f32x4*)(p + col) = o;
      uint2 pkd; pkd.x = pk2(o[0], o[1]); pkd.y = pk2(o[2], o[3]);
      *(uint2*)(x1b + (size_t)row * D + col) = pkd;
      v[i] = o;
    }
    float mx = 0.f;
#pragma unroll
    for (int i = 0; i < 8; ++i) mx = fmaxf(mx, fmaxf(fmaxf(fabsf(v[i][0]), fabsf(v[i][1])), fmaxf(fabsf(v[i][2]), fabsf(v[i][3]))));
    mx = fmaxf(wave_max(mx), 1e-30f);
    const float inv = 127.f / mx;
    unsigned* xq = (unsigned*)(c.ws + WS_X1Q + (size_t)row * D);
#pragma unroll
    for (int i = 0; i < 8; ++i) {
      unsigned w = 0;
#pragma unroll
      for (int k = 0; k < 4; ++k) { const int q = (int)rintf(v[i][k] * inv); w |= ((unsigned)q & 255u) << (8 * k); }
      xq[i * 64 + lane] = w;
    }
    if (lane == 0) ((float*)(c.ws + WS_SX))[row] = mx * (1.f / 127.f);
  }
}

__device__ __forceinline__ void p7_route_naive(const Ctx& c) {
  const bf16_t* qp = (const bf16_t*)(c.ws + WS_QP);
  const float* sk = c.in[8];
  int* eidx = (int*)(c.ws + WS_EIDX);
  float* egate = (float*)(c.ws + WS_EGATE);
  const int lane = mk_lane_id(), gw = blockIdx.x * 8 + c.wave, NW = c.G * 8;
  const float NEG = -3.0e38f;
  LAS int* ke = (LAS int*)c.lds;
  LAS float* kg = (LAS float*)(c.lds + 512);
  int* sorted_e = (int*)(c.ws + WS_SE);
  float* sorted_g = (float*)(c.ws + WS_SG);
  for (int th = gw; th < T * 8; th += NW) {
    const int t = th >> 3, h = th & 7;
    float st0 = 0.f, st1 = 0.f; int it0 = 0, it1 = 0;
#pragma unroll 1
    for (int cc = 0; cc < 2; ++cc) {
      const bf16_t* q = qp + (size_t)t * D + h * 256 + cc * 128;
      const float* k0 = sk + ((size_t)((h * 2 + cc) * NKEYS + lane)) * 128;
      const float* k1 = k0 + 64 * 128;
      float v0 = 0.f, v1 = 0.f;
      for (int d = 0; d < 128; d += 4) {
        const uint2 qq = *(const uint2*)(q + d);
        const float q0 = bflo(qq.x), q1 = bfhi(qq.x), q2 = bflo(qq.y), q3 = bfhi(qq.y);
        const float4 a = *(const float4*)(k0 + d);
        const float4 bq = *(const float4*)(k1 + d);
        v0 += q0 * a.x + q1 * a.y + q2 * a.z + q3 * a.w;
        v1 += q0 * bq.x + q1 * bq.y + q2 * bq.z + q3 * bq.w;
      }
      float mys = 0.f; int myi = 0;
      for (int it = 0; it < 16; ++it) {
        const float m = wave_max(fmaxf(v0, v1));
        int cand = 9999;
        if (v1 == m) cand = lane + 64;
        if (v0 == m) cand = lane;
        const int sel = wave_min_i(cand);
        if (sel == lane) v0 = NEG;
        if (sel == lane + 64) v1 = NEG;
        if (lane == it) { mys = m; myi = sel; }
      }
      if (cc == 0) { st0 = mys; it0 = myi; } else { st1 = mys; it1 = myi; }
    }
    float cv[4];
#pragma unroll
    for (int j = 0; j < 4; ++j) cv[j] = __shfl(st0, lane >> 2) + __shfl(st1, (lane & 3) * 4 + j);
    float mybest = 0.f; int mypos = 0;
    for (int it = 0; it < 16; ++it) {
      const float lm = fmaxf(fmaxf(cv[0], cv[1]), fmaxf(cv[2], cv[3]));
      const float m = wave_max(lm);
      int cand = 9999;
#pragma unroll
      for (int j = 3; j >= 0; --j) if (cv[j] == m) cand = lane * 4 + j;
      const int sel = wave_min_i(cand);
#pragma unroll
      for (int j = 0; j < 4; ++j) if (sel == lane * 4 + j) cv[j] = NEG;
      if (lane == it) { mybest = m; mypos = sel; }
    }
    const float mx = __shfl(mybest, 0);
    const float e = (lane < 16) ? expf(mybest - mx) : 0.f;
    const float den = wave_sum(e);
    const int ia = __shfl(it0, mypos >> 4), ib = __shfl(it1, mypos & 15);
    if (lane < 16) {
      eidx[(size_t)th * 16 + lane] = ia * NKEYS + ib;
      egate[(size_t)th * 16 + lane] = e / den;
      ke[h * 16 + lane] = ia * NKEYS + ib;
      kg[h * 16 + lane] = e / den;
    }
    __syncthreads();
    if ((c.wave * 64 + mk_lane_id()) < 128) {
      const int me = ke[(c.wave * 64 + mk_lane_id())];
      int rank = 0;
      for (int j = 0; j < 128; ++j) { const int o = ke[j]; rank += (o < me || (o == me && j < (c.wave * 64 + mk_lane_id()))) ? 1 : 0; }
      sorted_e[(size_t)t * 128 + rank] = me;
      sorted_g[(size_t)t * 128 + rank] = kg[(c.wave * 64 + mk_lane_id())];
    }
    __syncthreads();
  }
}

__device__ __forceinline__ void p8_peer_naive(const Ctx& c) {
  const float* x1 = (const float*)(c.ws + WS_Y1);
  const int* eidx = (const int*)(c.ws + WS_EIDX);
  const float* egate = (const float*)(c.ws + WS_EGATE);
  const float* eu = c.in[9];
  const float* ev = c.in[10];
  const float* w = c.in[11];
  const float* bb = c.in[12];
  LAS float* xs = (LAS float*)c.lds;
  LAS float* hh = xs + D;
  LAS int* ei = (LAS int*)(hh + 128);
  LAS float* red = (LAS float*)(ei + 128);
  const int tid = (c.wave * 64 + mk_lane_id()), lane = mk_lane_id(), wv = c.wave;
  for (int t = blockIdx.x; t < T; t += c.G) {
    *(f32x4*)(xs + tid * 4) = *(const f32x4*)(x1 + (size_t)t * D + tid * 4);
    if (tid < 128) ei[tid] = eidx[(size_t)t * 128 + tid];
    __syncthreads();
    for (int a = wv * 16; a < wv * 16 + 16; ++a) {
      const float* u = eu + (size_t)ei[a] * D;
      float s = 0.f;
#pragma unroll
      for (int i = 0; i < 8; ++i) {
        const f32x4 uv = *(const f32x4*)(u + (i * 64 + lane) * 4);
        const f32x4 xv = *(const LAS f32x4*)(xs + (i * 64 + lane) * 4);
        s += uv[0] * xv[0] + uv[1] * xv[1] + uv[2] * xv[2] + uv[3] * xv[3];
      }
      s = wave_sum(s);
      const float act = 0.5f * s * (1.f + erff(s * 0.7071067811865476f));
      if (lane == 0) hh[a] = egate[(size_t)t * 128 + a] * act;
    }
    __syncthreads();
    f32x4 acc = {0.f, 0.f, 0.f, 0.f};
    for (int a = 0; a < 128; ++a) {
      const f32x4 v = *(const f32x4*)(ev + (size_t)ei[a] * D + tid * 4);
      acc += v * hh[a];
    }
    const f32x4 y = *(const LAS f32x4*)(xs + tid * 4) * ALPHA + acc;
    float s = wave_sum((y[0] + y[1]) + (y[2] + y[3]));
    if (lane == 0) red[wv] = s;
    __syncthreads();
    float mu = 0.f;
#pragma unroll
    for (int i = 0; i < 8; ++i) mu += red[i];
    mu *= (1.f / D);
    const f32x4 d = y - mu;
    float q = wave_sum((d[0] * d[0] + d[1] * d[1]) + (d[2] * d[2] + d[3] * d[3]));
    if (lane == 0) red[8 + wv] = q;
    __syncthreads();
    float var = 0.f;
#pragma unroll
    for (int i = 0; i < 8; ++i) var += red[8 + i];
    const float rr = rsqrtf(var * (1.f / D) + 1e-5f);
    const f32x4 wv4 = *(const f32x4*)(w + tid * 4), bv = *(const f32x4*)(bb + tid * 4);
    *(f32x4*)(c.out + (size_t)t * D + tid * 4) = d * rr * wv4 + bv;
    __syncthreads();
  }
}

__device__ __forceinline__ unsigned fkey(float f) { const unsigned u = __float_as_uint(f); return (u & 0x80000000u) ? ~u : (u | 0x80000000u); }
__device__ __forceinline__ float funkey(unsigned k) { return __uint_as_float((k & 0x80000000u) ? (k & 0x7fffffffu) : ~k); }
template <int N> __device__ __forceinline__ void sort_desc(unsigned (&a)[N]) {
#pragma unroll
  for (int k = 2; k <= N; k <<= 1)
#pragma unroll
    for (int j = k >> 1; j > 0; j >>= 1)
#pragma unroll
      for (int i = 0; i < N; ++i) {
        const int l = i ^ j;
        if (l > i) {
          const unsigned x = a[i], y = a[l], mx = x > y ? x : y, mn = x > y ? y : x;
          if ((i & k) == 0) { a[i] = mx; a[l] = mn; } else { a[i] = mn; a[l] = mx; }
        }
      }
}
__device__ __forceinline__ void merge16(unsigned (&a)[16], const unsigned (&b)[16]) {
#pragma unroll
  for (int i = 0; i < 16; ++i) { const unsigned y = b[15 - i]; a[i] = a[i] > y ? a[i] : y; }
#pragma unroll
  for (int j = 8; j > 0; j >>= 1)
#pragma unroll
    for (int i = 0; i < 16; ++i) {
      const int l = i ^ j;
      if (l > i) { const unsigned x = a[i], y = a[l]; a[i] = x > y ? x : y; a[l] = x > y ? y : x; }
    }
}
__device__ __forceinline__ void top16_of_64(const unsigned (&v)[64], unsigned (&out)[16]) {
  unsigned g[4][16];
#pragma unroll
  for (int q = 0; q < 4; ++q) {
#pragma unroll
    for (int i = 0; i < 16; ++i) g[q][i] = v[16 * q + i];
    sort_desc<16>(g[q]);
  }
  merge16(g[0], g[1]); merge16(g[2], g[3]); merge16(g[0], g[2]);
#pragma unroll
  for (int i = 0; i < 16; ++i) out[i] = g[0][i];
}
constexpr int ROUTE_KE_OFF = 81920;
constexpr int ROUTE_KG_OFF = ROUTE_KE_OFF + 16384;
struct StairTab { int a[64], b[64]; };
__host__ __device__ constexpr StairTab make_stair() {
  StairTab t{}; int n = 0;
  for (int a = 0; a < 16; ++a) for (int b = 0; b < 16; ++b) if ((a + 1) * (b + 1) <= 16) { t.a[n] = a; t.b[n] = b; ++n; }
  for (; n < 64; ++n) { t.a[n] = -1; t.b[n] = -1; }
  return t;
}
__device__ __forceinline__ void p8_route(const Ctx& c) {
  const bf16_t* qp = (const bf16_t*)(c.ws + WS_QP);
  const bf16_t* skb = (const bf16_t*)(c.ws + WS_SKB);
  int* sorted_e = (int*)(c.ws + WS_SE);
  float* sorted_g = (float*)(c.ws + WS_SG);
  const int lane = mk_lane_id(), r = lane & 31, hh = lane >> 5, head = c.wave;
  LAS unsigned char* wl = c.lds + c.wave * WAVE_LDS;
  LAS int* ke = (LAS int*)(c.lds + ROUTE_KE_OFF);
  LAS float* kg = (LAS float*)(c.lds + ROUTE_KG_OFF);
  constexpr StairTab ST = make_stair();
  for (int tg = blockIdx.x; tg < T / 32; tg += c.G) {
    const int t0 = tg * 32;
    unsigned top[2][16];
#pragma unroll
    for (int cc = 0; cc < 2; ++cc) {
      bf16x8 qf[8];
#pragma unroll
      for (int s = 0; s < 8; ++s) qf[s] = *(const bf16x8*)(qp + (size_t)(t0 + r) * D + head * 256 + cc * 128 + 16 * s + 8 * hh);
      unsigned mine[16];
#pragma unroll
      for (int kt = 0; kt < 4; ++kt) {
        f32x16 sc;
#pragma unroll
        for (int i = 0; i < 16; ++i) sc[i] = 0.f;
        const bf16_t* krow_p = skb + ((size_t)((head * 2 + cc) * NKEYS + 32 * kt + r)) * 128 + 8 * hh;
#pragma unroll
        for (int s = 0; s < 8; ++s) sc = MFMA32(*(const bf16x8*)(krow_p + 16 * s), qf[s], sc);
        unsigned v[16];
#pragma unroll
        for (int i = 0; i < 16; ++i) {
          const int kidx = 32 * kt + (i & 3) + 8 * (i >> 2) + 4 * hh;
          v[i] = (fkey(sc[i]) & ~127u) | (unsigned)(127 - kidx);
        }
        sort_desc<16>(v);
        if (kt == 0) {
#pragma unroll
          for (int i = 0; i < 16; ++i) mine[i] = v[i];
        } else merge16(mine, v);
        __builtin_amdgcn_sched_barrier(0);
      }
      unsigned other[16];
#pragma unroll
      for (int i = 0; i < 16; ++i) other[i] = (unsigned)__shfl_xor((int)mine[i], 32);
      merge16(mine, other);
#pragma unroll
      for (int i = 0; i < 16; ++i) top[cc][i] = mine[i];
    }
    float f0[16], f1[16];
#pragma unroll
    for (int i = 0; i < 16; ++i) { f0[i] = funkey(top[0][i] & ~127u); f1[i] = funkey(top[1][i] & ~127u); }
    unsigned best[16];
#pragma unroll
    for (int q = 0; q < 4; ++q) {
      unsigned cv[16];
#pragma unroll
      for (int i = 0; i < 16; ++i) {
        const int n = 16 * q + i;
        if (ST.a[n] >= 0) cv[i] = (fkey(f0[ST.a[n]] + f1[ST.b[n]]) & ~255u) | (unsigned)(255 - (ST.a[n] * 16 + ST.b[n]));
        else cv[i] = 0u;
      }
      sort_desc<16>(cv);
      if (q == 0) {
#pragma unroll
        for (int i = 0; i < 16; ++i) best[i] = cv[i];
      } else merge16(best, cv);
      __builtin_amdgcn_sched_barrier(0);
    }
    LAS unsigned* tb = (LAS unsigned*)(wl + lane * 32);
#pragma unroll
    for (int w4 = 0; w4 < 4; ++w4) {
      unsigned p0 = 0, p1 = 0;
#pragma unroll
      for (int k = 0; k < 4; ++k) { p0 |= (127u - (top[0][4 * w4 + k] & 127u)) << (8 * k); p1 |= (127u - (top[1][4 * w4 + k] & 127u)) << (8 * k); }
      tb[w4] = p0; tb[4 + w4] = p1;
    }
    wave_lds_fence();
    const float mx = funkey(best[0] & ~255u);
    float ex[16], den = 0.f;
#pragma unroll
    for (int i = 0; i < 16; ++i) { ex[i] = __expf(funkey(best[i] & ~255u) - mx); den += ex[i]; }
    const float inv = 1.f / den;
#pragma unroll
    for (int i = 0; i < 8; ++i) {
      const unsigned bk = hh ? best[8 + i] : best[i];
      const float gt = (hh ? ex[8 + i] : ex[i]) * inv;
      const int pos = 255 - (int)(bk & 255u);
      const int ia = ((LAS unsigned char*)tb)[pos >> 4], ib = ((LAS unsigned char*)tb)[16 + (pos & 15)];
      ke[r * 128 + head * 16 + 8 * hh + i] = ia * NKEYS + ib;
      kg[r * 128 + head * 16 + 8 * hh + i] = gt;
    }
    __syncthreads();
    {
      const int tt = (c.wave * 64 + mk_lane_id()) >> 4, e8 = ((c.wave * 64 + mk_lane_id()) & 15) * 8;
      int me[8], rank[8];
#pragma unroll
      for (int j = 0; j < 8; ++j) { me[j] = ke[tt * 128 + e8 + j]; rank[j] = 0; }
      for (int o = 0; o < 128; ++o) {
        const int ov = ke[tt * 128 + o];
#pragma unroll
        for (int j = 0; j < 8; ++j) rank[j] += (ov < me[j] || (ov == me[j] && o < e8 + j)) ? 1 : 0;
      }
#if defined(MK_NOSORT)
#pragma unroll
      for (int j = 0; j < 8; ++j) rank[j] = e8 + j;
#endif
#pragma unroll
      for (int j = 0; j < 8; ++j) {
        sorted_e[(size_t)(t0 + tt) * 128 + rank[j]] = me[j];
        sorted_g[(size_t)(t0 + tt) * 128 + rank[j]] = kg[tt * 128 + e8 + j];
      }
    }
    __syncthreads();
  }
}

typedef __bf16 bf16x2v __attribute__((ext_vector_type(2)));
__device__ __forceinline__ float dot2bf(unsigned a, unsigned b, float acc) {
  return __builtin_amdgcn_fdot2_f32_bf16(__builtin_bit_cast(bf16x2v, a), __builtin_bit_cast(bf16x2v, b), acc, false);
}
__device__ __forceinline__ int rdlane_i(int v, int l) { return __builtin_amdgcn_readlane(v, l); }
__device__ __forceinline__ float rdlane_f(float v, int l) { return __int_as_float(__builtin_amdgcn_readlane(__float_as_int(v), l)); }
template <int CTRL> __device__ __forceinline__ int dpp_mov_i(int v) { return __builtin_amdgcn_update_dpp(0, v, CTRL, 0xf, 0xf, true); }
__device__ __forceinline__ int wave_sum_i_dpp(int v) {
  v += dpp_mov_i<0xB1>(v);
  v += dpp_mov_i<0x4E>(v);
  v += dpp_mov_i<0x141>(v);
  v += dpp_mov_i<0x140>(v);
  return __builtin_amdgcn_readlane(v, 0) + __builtin_amdgcn_readlane(v, 16) + __builtin_amdgcn_readlane(v, 32) + __builtin_amdgcn_readlane(v, 48);
}
__device__ __forceinline__ float gelu_as(float v) {
  const float av = fabsf(v), t = __builtin_amdgcn_rcpf(av * 0.2316418882f + 1.0f);
  float q = t * 0.5307027145f + (-0.7265760135f); q = q * t + 0.7107068705f; q = q * t + (-0.142248368f); q = q * t + 0.127414796f; q = q * t;
  const float e = __builtin_amdgcn_exp2f((v * v) * (-0.72134752044f));
  const float m = v * (q * e);
  return v < 0.f ? m : v - m;
}
constexpr int PEER_D1 = 8, PEER_D2 = 2;
__device__ __forceinline__ void p9_peer(const Ctx& c) {
  const unsigned char* x1q = (const unsigned char*)(c.ws + WS_X1Q);
  const float* sx = (const float*)(c.ws + WS_SX);
  const float* x1 = (const float*)(c.ws + WS_Y1);
  const int* sorted_e = (const int*)(c.ws + WS_SE);
  const float* sorted_g = (const float*)(c.ws + WS_SG);
  const unsigned char* uq = (const unsigned char*)(c.ws + WS_UQ);
  const unsigned char* vq = (const unsigned char*)(c.ws + WS_VQ);
  const float* su = (const float*)(c.ws + WS_SU);
  const float* sv = (const float*)(c.ws + WS_SV);
  const float* lw = c.in[11];
  const float* lb = c.in[12];
  const int lane = mk_lane_id(), gw = blockIdx.x * 8 + c.wave, NW = c.G * 8;
  LAS int* le = (LAS int*)(c.lds + c.wave * WAVE_LDS);
  LAS float* lsc = (LAS float*)(le + 512);
  LAS float* lg = lsc + 512;
  LAS float* lh = lg + 512;
  LAS int* lpi = (LAS int*)(lh + 512);
  for (int tb = gw * 4; tb < T; tb += NW * 4) {
    int lq = lane;
    asm volatile("" : "+v"(lq));
    u32x4 xr[4][2];
#pragma unroll
    for (int tk = 0; tk < 4; ++tk) {
      const size_t t = (size_t)(tb + tk);
      const float sxt = sx[t];
#pragma unroll
      for (int hh = 0; hh < 2; ++hh) {
        const int e = sorted_e[t * 128 + 64 * hh + lq];
        le[tk * 128 + 64 * hh + lq] = e;
        lsc[tk * 128 + 64 * hh + lq] = su[e] * sxt;
        lg[tk * 128 + 64 * hh + lq] = sorted_g[t * 128 + 64 * hh + lq] * sv[e];
      }
#pragma unroll
      for (int i = 0; i < 2; ++i) xr[tk][i] = *(const u32x4*)(x1q + t * D + 1024 * i + 16 * lq);
    }
    wave_lds_fence();
#pragma unroll 1
    for (int hf = 0; hf < 2; ++hf) {
      u32x4 rows[PEER_D1][4];
#define PEER_ISSUE1(SL, P) do { _Pragma("unroll") for (int tk_ = 0; tk_ < 4; ++tk_) \
        rows[SL][tk_] = *(const u32x4*)(uq + (size_t)__builtin_amdgcn_readfirstlane(le[tk_ * 128 + (P)]) * D + 1024 * hf + 16 * lane); } while (0)
#define PEER_CONSUME1(SL, P) do { _Pragma("unroll") for (int tk_ = 0; tk_ < 4; ++tk_) { int ia_ = 0, ib_ = 0; \
        const u32x4 xh_ = hf ? xr[tk_][1] : xr[tk_][0]; \
        ia_ = __builtin_amdgcn_sdot4((int)rows[SL][tk_][0], (int)xh_[0], ia_, false); ib_ = __builtin_amdgcn_sdot4((int)rows[SL][tk_][1], (int)xh_[1], ib_, false); \
        ia_ = __builtin_amdgcn_sdot4((int)rows[SL][tk_][2], (int)xh_[2], ia_, false); ib_ = __builtin_amdgcn_sdot4((int)rows[SL][tk_][3], (int)xh_[3], ib_, false); \
        const int part_ = wave_sum_i_dpp(ia_ + ib_); \
        if (hf == 0) { if (lane == 0) lpi[tk_ * 128 + (P)] = part_; } \
        else { const float sacc_ = (float)(part_ + lpi[tk_ * 128 + (P)]) * lsc[tk_ * 128 + (P)]; \
               if (lane == 0) lh[tk_ * 128 + (P)] = gelu_as(sacc_) * lg[tk_ * 128 + (P)]; } } } while (0)
#pragma unroll
      for (int sl = 0; sl < PEER_D1; ++sl) PEER_ISSUE1(sl, sl);
#pragma unroll 1
      for (int p0 = 0; p0 < 128 - PEER_D1; p0 += PEER_D1) {
#pragma unroll
        for (int sl = 0; sl < PEER_D1; ++sl) { PEER_CONSUME1(sl, p0 + sl); PEER_ISSUE1(sl, p0 + sl + PEER_D1); }
      }
#pragma unroll
      for (int sl = 0; sl < PEER_D1; ++sl) PEER_CONSUME1(sl, 128 - PEER_D1 + sl);
#undef PEER_ISSUE1
#undef PEER_CONSUME1
      wave_lds_fence();
    }
    wave_lds_fence();
    int lcol = 16 * lane;
    asm volatile("" : "+v"(lcol));
#pragma unroll 1
    for (int hf = 0; hf < 2; ++hf) {
      float acc[4][16], hsum[4];
#pragma unroll
      for (int tk = 0; tk < 4; ++tk) {
        hsum[tk] = 0.f;
#pragma unroll
        for (int j = 0; j < 4; ++j) {
          const f32x4 xv = *(const f32x4*)(x1 + (size_t)(tb + tk) * D + 1024 * hf + lcol + 4 * j);
#pragma unroll
          for (int k = 0; k < 4; ++k) acc[tk][4 * j + k] = ALPHA * xv[k];
        }
      }
      u32x4 rows[PEER_D2][4]; float hw[PEER_D2][4];
#define PEER_ISSUE2(SL, P) do { _Pragma("unroll") for (int tk_ = 0; tk_ < 4; ++tk_) { \
        rows[SL][tk_] = *(const u32x4*)(vq + (size_t)__builtin_amdgcn_readfirstlane(le[tk_ * 128 + (P)]) * D + 1024 * hf + 16 * lane); \
        hw[SL][tk_] = lh[tk_ * 128 + (P)]; } } while (0)
#define PEER_CONSUME2(SL) do { _Pragma("unroll") for (int tk_ = 0; tk_ < 4; ++tk_) { const float hv_ = hw[SL][tk_]; hsum[tk_] += hv_; \
        _Pragma("unroll") for (int j_ = 0; j_ < 4; ++j_) { const unsigned w_ = rows[SL][tk_][j_]; \
          acc[tk_][4 * j_ + 0] += hv_ * (float)(w_ & 255u); acc[tk_][4 * j_ + 1] += hv_ * (float)((w_ >> 8) & 255u); \
          acc[tk_][4 * j_ + 2] += hv_ * (float)((w_ >> 16) & 255u); acc[tk_][4 * j_ + 3] += hv_ * (float)(w_ >> 24); } } } while (0)
#pragma unroll
      for (int sl = 0; sl < PEER_D2; ++sl) PEER_ISSUE2(sl, sl);
#pragma unroll 1
      for (int p0 = 0; p0 < 128 - PEER_D2; p0 += PEER_D2) {
#pragma unroll
        for (int sl = 0; sl < PEER_D2; ++sl) { PEER_CONSUME2(sl); PEER_ISSUE2(sl, p0 + sl + PEER_D2); }
      }
#pragma unroll
      for (int sl = 0; sl < PEER_D2; ++sl) PEER_CONSUME2(sl);
#undef PEER_ISSUE2
#undef PEER_CONSUME2
#pragma unroll
      for (int tk = 0; tk < 4; ++tk)
#pragma unroll
        for (int j = 0; j < 4; ++j) {
          f32x4 o;
#pragma unroll
          for (int k = 0; k < 4; ++k) o[k] = acc[tk][4 * j + k] - 128.f * hsum[tk];
          *(f32x4*)(c.out + (size_t)(tb + tk) * D + 1024 * hf + lcol + 4 * j) = o;
        }
    }
    asm volatile("" : "+v"(lcol));
#pragma unroll 1
    for (int tk = 0; tk < 4; ++tk) {
      float* orow = c.out + (size_t)(tb + tk) * D + lcol;
      f32x4 y[8];
      float ssum = 0.f;
#pragma unroll
      for (int i = 0; i < 8; ++i) { y[i] = *(const f32x4*)(orow + 1024 * (i >> 2) + 4 * (i & 3)); ssum += (y[i][0] + y[i][1]) + (y[i][2] + y[i][3]); }
      const float mu = wave_sum(ssum) * (1.f / D);
      float q = 0.f;
#pragma unroll
      for (int i = 0; i < 8; ++i) { y[i] = y[i] - mu; q += (y[i][0] * y[i][0] + y[i][1] * y[i][1]) + (y[i][2] * y[i][2] + y[i][3] * y[i][3]); }
      const float rr = rsqrtf(wave_sum(q) * (1.f / D) + 1e-5f);
#pragma unroll
      for (int i = 0; i < 8; ++i) {
        const int col = 1024 * (i >> 2) + 4 * (i & 3);
        const f32x4 wv = *(const f32x4*)(lw + lcol + col), bv = *(const f32x4*)(lb + lcol + col);
        *(f32x4*)(orow + col) = y[i] * rr * wv + bv;
      }
    }
    wave_lds_fence();
  }
}

#ifndef MK_N_LAUNCHES
#define MK_N_LAUNCHES 1
#endif
constexpr int NPHASE = 9;
#ifndef MK_PROBE_PHASE
#define MK_PROBE_PHASE -1
#define MK_PROBE_REPS 1
#endif
struct Args { const float* in[13]; float* out; unsigned char* ws; int ph_lo, ph_hi; };

__global__ void __launch_bounds__(NTHR, 2) k_main(Args a) {
  extern __shared__ __attribute__((aligned(16))) unsigned char lds_raw[];
  Ctx c;
#pragma unroll
  for (int i = 0; i < 13; ++i) c.in[i] = a.in[i];
  c.out = a.out; c.ws = a.ws; c.lds = (LAS unsigned char*)lds_raw;
  c.wave = __builtin_amdgcn_readfirstlane((int)(threadIdx.x >> 6)); c.G = gridDim.x;
  volatile LAS unsigned* misc = (volatile LAS unsigned*)(c.lds + pg8::STAGE_BYTES);
  if (c.wave == 0 && mk_lane_id() < 16) misc[mk_lane_id()] = 0u;
  __syncthreads();
  const int lo = a.ph_lo, hi = a.ph_hi;
  XcdBarrier bar; bar.wave = (unsigned)c.wave; bar.bar = (unsigned*)(c.ws + WS_CTL); bar.x = 0; bar.st = misc;
  if (hi - lo > 1) bar = xcd_barrier_post((unsigned*)(c.ws + WS_CTL), misc, (unsigned)c.wave);
  bf16_t* xb = (bf16_t*)(c.ws + WS_XB);
#define IN(k) (lo <= (k) && (k) < hi)
#ifndef MK_ONLY
#define MK_ONLY -1
#endif
#define PHASE(k, ...) do { if (IN(k) && (MK_ONLY < 0 || MK_ONLY == (k))) { \
    _Pragma("unroll 1") for (int it_ = 0; it_ < (((k) == MK_PROBE_PHASE) ? MK_PROBE_REPS : 1); ++it_) { if (it_ > 0) xcd_barrier(bar); __VA_ARGS__; } \
    if (IN((k) + 1)) xcd_barrier(bar); } } while (0)
  PHASE(0, p0_prologue(c));
  PHASE(1, {
    pg8::Gemm g{xb, (const bf16_t*)(c.ws + WS_WIN), T, INW, D};
    pg8::StaticOrder so; so.init(T, INW, c.G, (int)blockIdx.x);
    pg8::EpiProjRot E{(bf16_t*)(c.ws + WS_PROJ), INW, 3072, 5120, (const float*)(c.ws + WS_ROT), (const float*)(c.ws + WS_ROT) + S * 64, S - 1};
    pg8::gemm_phase<pg8::EpiProjRot, pg8::StaticOrder, false>(c.lds, g, so, E, nullptr, c.wave); });
  PHASE(2, p3_attn_a(c));
  PHASE(3, p4_attn_b(c));
  PHASE(4, {
    pg8::Gemm g{(const bf16_t*)(c.ws + WS_MIXED), (const bf16_t*)(c.ws + WS_WOUT), T, D, D};
    pg8::StaticOrder so; so.init(T, D, c.G, (int)blockIdx.x);
    pg8::EpiResF32 E{(float*)(c.ws + WS_Y1), D, c.in[0], ALPHA};
    pg8::gemm_phase<pg8::EpiResF32, pg8::StaticOrder, false>(c.lds, g, so, E, nullptr, c.wave); });
  PHASE(5, { p5_ln1(c); for (int rr0 = (blockIdx.x * 8 + c.wave) * 16; rr0 < 2 * 16384; rr0 += c.G * 8 * 16) quant_rows(c, rr0, 16); });
  PHASE(6, {
    pg8::Gemm g{(const bf16_t*)(c.ws + WS_X1B), (const bf16_t*)(c.ws + WS_WPQ), T, D, D};
    pg8::StaticOrder so; so.init(T, D, c.G, (int)blockIdx.x);
    pg8::EpiBf16Plain E{(bf16_t*)(c.ws + WS_QP), D};
    pg8::gemm_phase<pg8::EpiBf16Plain, pg8::StaticOrder, false>(c.lds, g, so, E, nullptr, c.wave); });
  PHASE(7, p8_route(c));
  PHASE(8, p9_peer(c));
#undef PHASE
#undef IN
}
}

extern "C" void kernel_launch(void* const* d_in, const int* in_sizes, int n_in, void* d_out, int out_size, void* d_ws, size_t ws_size,
                              hipStream_t stream) {
  using namespace mk;
  static int grid = 0;
  if (grid == 0) {
    if (n_in != 13 || ws_size < WS_END) { grid = -1; return; }
    int dev = 0, cus = 0, per_cu = 0;
    if (hipGetDevice(&dev) != hipSuccess || hipDeviceGetAttribute(&cus, hipDeviceAttributeMultiprocessorCount, dev) != hipSuccess) { grid = -1; return; }
    if (hipFuncSetAttribute((const void*)k_main, hipFuncAttributeMaxDynamicSharedMemorySize, LDS_BYTES) != hipSuccess) { grid = -1; return; }
    if (hipOccupancyMaxActiveBlocksPerMultiprocessor(&per_cu, (const void*)k_main, NTHR, LDS_BYTES) != hipSuccess || per_cu < 1) { (void)hipGetLastError(); per_cu = 1; }
    grid = cus;
  }
  if (grid < 0) return;
  (void)hipMemsetAsync((char*)d_ws + WS_CTL, 0, CTL_BYTES, stream);
  Args a{};
  for (int i = 0; i < 13; ++i) a.in[i] = (const float*)d_in[i];
  a.out = (float*)d_out; a.ws = (unsigned char*)d_ws;
#if MK_N_LAUNCHES == 1
  a.ph_lo = 0; a.ph_hi = NPHASE;
  hipLaunchKernelGGL(k_main, dim3(grid), dim3(NTHR), LDS_BYTES, stream, a);
#else
  for (int p = 0; p < NPHASE; ++p) { a.ph_lo = p; a.ph_hi = p + 1; hipLaunchKernelGGL(k_main, dim3(grid), dim3(NTHR), LDS_BYTES, stream, a); }
#endif
}
```

```cpp
#include <hip/hip_runtime.h>
#include <stdint.h>
#include <math.h>
__device__ __forceinline__ int mk_lane_id() { return (int)__builtin_amdgcn_mbcnt_hi(~0u, __builtin_amdgcn_mbcnt_lo(~0u, 0u)); }
#define MK_N_LAUNCHES 1
namespace pg8 {
#define PG8_LAS __attribute__((address_space(3)))
typedef unsigned short bf16_t;
typedef short bf16x8 __attribute__((ext_vector_type(8)));
typedef float f32x4 __attribute__((ext_vector_type(4)));
typedef unsigned u32x4 __attribute__((ext_vector_type(4)));
constexpr int BM = 256, BK = 64, HALF = 128, HTB = HALF * BK * 2  , STAGE_BYTES = 8 * HTB, NXCD = 8, WGM = 8;

__host__ __device__ __forceinline__ int lds_byte(int r, int c) { const int st = (r >> 4) * 2 + (c >> 5), rr = r & 15, cc = c & 31, ob = rr * 64 + cc * 2; return st * 1024 + (ob ^ (((ob >> 9) & 1) << 5)); }
__host__ __device__ __forceinline__ void stage_rc(int b, int& R, int& C) { const int st = b / 1024, sb = b % 1024, swz = sb ^ (((sb >> 9) & 1) << 5); R = (st >> 1) * 16 + swz / 64; C = (st & 1) * 32 + (swz % 64) / 2; }
__host__ __device__ __forceinline__ int perm32(int rho) { const int n = rho >> 4, i = rho & 15; return 8 * (i >> 2) + 4 * n + (i & 3); }

struct Unit { int pm, pn; };
struct Gemm { const bf16_t* A; const bf16_t* Bt; int M, N, K; };

struct StaticOrder {
    int nM, nN, nwg, G, c;
    __host__ __device__ void init(int M, int N, int G_, int c_) { nM = M / BM; nN = N / BM; nwg = nM * nN; G = G_; c = c_; }
    __host__ __device__ bool next(int i, Unit& u) const {
        const long L = (long)i * G + c; if (L >= nwg) return false;
        int wgid = (int)L; { const int q = nwg / NXCD, r = nwg % NXCD, xcd = wgid % NXCD, off = wgid / NXCD; wgid = (xcd < r ? xcd * (q + 1) : r * (q + 1) + (xcd - r) * q) + off; }
        const int nig = WGM * nN, gid = wgid / nig, fm = gid * WGM, gsz = (nM - fm) < WGM ? (nM - fm) : WGM;
        u.pm = fm + ((wgid % nig) % gsz); u.pn = (wgid % nig) / gsz; return true;
    }
    __device__ __forceinline__ void a_ready(const Unit&) const {}
    __device__ __forceinline__ void done(const Unit&) const {}
};
typedef __bf16 bf16x2_t __attribute__((ext_vector_type(2)));
typedef float f32x2_t __attribute__((ext_vector_type(2)));
__device__ __forceinline__ unsigned pk2(float lo, float hi) { f32x2_t v = {lo, hi}; bf16x2_t r = __builtin_convertvector(v, bf16x2_t); return __builtin_bit_cast(unsigned, r); }
struct EpiBf16Plain {
    static constexpr bool PERM = true, AFTER_DRAIN = false;
    bf16_t* O; int ldc;
    __device__ __forceinline__ void operator()(const f32x4 (&acc)[2][2][4][2], const Unit& u, int wr, int wc, int fr, int fq) const {
        const int row0 = u.pm * BM + wr * 64 + fr, col0 = u.pn * BM + wc * 32 + 8 * fq;
#pragma unroll
        for (int ai = 0; ai < 2; ++ai)
#pragma unroll
            for (int m = 0; m < 4; ++m) { bf16_t* rowp = O + (size_t)(row0 + ai * HALF + m * 16) * ldc + col0;
#pragma unroll
                for (int bj = 0; bj < 2; ++bj) { const f32x4 v0 = acc[ai][bj][m][0], v1 = acc[ai][bj][m][1];
                    u32x4 w; w.x = pk2(v0[0], v0[1]); w.y = pk2(v0[2], v0[3]); w.z = pk2(v1[0], v1[1]); w.w = pk2(v1[2], v1[3]);
                    *(u32x4*)(rowp + bj * HALF) = w; } }
    }
};
struct EpiResF32 {
    static constexpr bool PERM = false, AFTER_DRAIN = false;
    float* C; int ldc; const float* base; float alpha;
    __device__ __forceinline__ void operator()(const f32x4 (&acc)[2][2][4][2], const Unit& u, int wr, int wc, int fr, int fq) const {
        const int row0 = u.pm * BM + wr * 64 + fr, col0 = u.pn * BM + wc * 32 + 4 * fq;
#pragma unroll
        for (int ai = 0; ai < 2; ++ai)
#pragma unroll
            for (int m = 0; m < 4; ++m) { const size_t ro = (size_t)(row0 + ai * HALF + m * 16) * ldc + col0;
#pragma unroll
                for (int bj = 0; bj < 2; ++bj)
#pragma unroll
                    for (int n = 0; n < 2; ++n) { const f32x4 b = *(const f32x4*)(base + ro + bj * HALF + n * 16);
                        *(f32x4*)(C + ro + bj * HALF + n * 16) = acc[ai][bj][m][n] + b * alpha; } }
    }
};
struct EpiProjRot {
    static constexpr bool PERM = true, AFTER_DRAIN = false;
    bf16_t* O; int ldc; int rot_lo, rot_hi; const float* cs; const float* sn; int seq_mask;
    __device__ __forceinline__ void operator()(const f32x4 (&acc)[2][2][4][2], const Unit& u, int wr, int wc, int fr, int fq) const {
        const int row0 = u.pm * BM + wr * 64 + fr, colt = u.pn * BM, col0 = colt + wc * 32 + 8 * fq;
        const bool rot = (colt >= rot_lo) && (colt < rot_hi);
#pragma unroll
        for (int ai = 0; ai < 2; ++ai)
#pragma unroll
            for (int m = 0; m < 4; ++m) { const int row = row0 + ai * HALF + m * 16; bf16_t* rowp = O + (size_t)row * ldc;
#pragma unroll
                for (int bj = 0; bj < 2; ++bj) { const f32x4 v0 = acc[ai][bj][m][0], v1 = acc[ai][bj][m][1];
                    if (!rot) { u32x4 w; w.x = pk2(v0[0], v0[1]); w.y = pk2(v0[2], v0[3]); w.z = pk2(v1[0], v1[1]); w.w = pk2(v1[2], v1[3]);
                        *(u32x4*)(rowp + col0 + bj * HALF) = w; }
                    else { const int d0 = 16 * wc + 4 * fq;
                        const f32x4 c4 = *(const f32x4*)(cs + (size_t)(row & seq_mask) * 64 + d0), s4 = *(const f32x4*)(sn + (size_t)(row & seq_mask) * 64 + d0);
                        const f32x4 lo = v0 * c4 - v1 * s4, hi = v1 * c4 + v0 * s4;
                        uint2 wl, wh; wl.x = pk2(lo[0], lo[1]); wl.y = pk2(lo[2], lo[3]); wh.x = pk2(hi[0], hi[1]); wh.y = pk2(hi[2], hi[3]);
                        bf16_t* hp = rowp + colt + bj * HALF + d0;
                        *(uint2*)hp = wl; *(uint2*)(hp + 64) = wh; } } }
    }
};

template <class Epi, class Sched, bool STAMP = false>
__device__ __forceinline__ void gemm_phase(PG8_LAS unsigned char* lds, const Gemm g, const Sched& S, const Epi& E, unsigned long long* stamps, const int wid) {
    const int lane = mk_lane_id(), tid = wid * 64 + lane, wr = wid >> 2, wc = wid & 3, fr = lane & 15, fq = lane >> 4;
    const int K = g.K, nt = K / BK;
    int ts_lo = 0, ts_hi = 0, nts = 0; const unsigned long long rt_entry = STAMP ? (unsigned long long)wall_clock64() : 0ull;
#define PG8_STAMP() do { if (STAMP && wid == 0 && nts < 64) { const unsigned long long _c = (unsigned long long)clock64(); \
        ts_lo = (lane == nts) ? (int)(unsigned)_c : ts_lo; ts_hi = (lane == nts) ? (int)(unsigned)(_c >> 32) : ts_hi; ++nts; } } while (0)
    PG8_STAMP();
    unsigned voffA[2], voffB[2];
#pragma unroll
    for (int i = 0; i < 2; ++i) { int R, C; stage_rc(tid * 16 + i * 8192, R, C); const int Rb = Epi::PERM ? ((R & ~31) + perm32(R & 31)) : R;
        voffA[i] = (unsigned)(R * K + C) * 2u; voffB[i] = (unsigned)(Rb * K + C) * 2u; }
    const size_t kstep = (size_t)(BK * 2);
    const size_t hstep = (size_t)HALF * K * 2;
    const size_t tstep = 2 * hstep;
    const unsigned ldsw = (unsigned)wid * 1024u;
    const int aoff = lds_byte(wr * 64 + fr, fq * 8), boff = lds_byte(wc * 32 + fr, fq * 8);
#define PG8_SA(b, h) (((b) * 2 + (h)) * HTB)
#define PG8_SB(b, h) ((4 + (b) * 2 + (h)) * HTB)
#define PG8_STAGE(bufoff, gbase, voff) do { _Pragma("unroll") for (int _i = 0; _i < 2; ++_i) \
        __builtin_amdgcn_global_load_lds((const unsigned*)((const char*)(gbase) + (voff)[_i]), (PG8_LAS unsigned*)(lds + (bufoff) + ldsw + _i * 8192), 16, 0, 0); } while (0)
#define PG8_LDA(dst, b, h) do { _Pragma("unroll") for (int m = 0; m < 4; ++m) _Pragma("unroll") for (int k = 0; k < 2; ++k) dst[m][k] = *(const PG8_LAS bf16x8*)(lds + PG8_SA(b, h) + aoff + m * 2048 + k * 1024); } while (0)
#define PG8_LDB(dst, b, h) do { _Pragma("unroll") for (int n = 0; n < 2; ++n) _Pragma("unroll") for (int k = 0; k < 2; ++k) dst[n][k] = *(const PG8_LAS bf16x8*)(lds + PG8_SB(b, h) + boff + n * 2048 + k * 1024); } while (0)
#define PG8_MMA(ai, bj, At, Bt) do { __builtin_amdgcn_s_setprio(1); _Pragma("unroll") for (int m = 0; m < 4; ++m) _Pragma("unroll") for (int n = 0; n < 2; ++n) _Pragma("unroll") for (int k = 0; k < 2; ++k) \
        acc[ai][bj][m][n] = __builtin_amdgcn_mfma_f32_16x16x32_bf16(Bt[n][k], At[m][k], acc[ai][bj][m][n], 0, 0, 0); __builtin_amdgcn_s_setprio(0); } while (0)
#define PG8_WAIT_V(n) asm volatile("s_waitcnt vmcnt(" #n ")" ::: "memory")
#define PG8_WAIT_L(n) asm volatile("s_waitcnt lgkmcnt(" #n ")" ::: "memory")
#define PG8_BAR __builtin_amdgcn_s_barrier()
#define PG8_SCHED __builtin_amdgcn_sched_barrier(0)
    Unit cur, nxt; int ui = 0;
    if (!S.next(0, cur)) return;
    f32x4 acc[2][2][4][2];
#pragma unroll
    for (int a = 0; a < 2; ++a)
#pragma unroll
        for (int b = 0; b < 2; ++b)
#pragma unroll
            for (int m = 0; m < 4; ++m)
#pragma unroll
                for (int n = 0; n < 2; ++n) acc[a][b][m][n] = (f32x4){0.f, 0.f, 0.f, 0.f};
    bf16x8 At[4][2], B0[2][2], B1[2][2];
    const char* cA = (const char*)g.A + (size_t)cur.pm * tstep; const char* cB = (const char*)g.Bt + (size_t)cur.pn * tstep;
    S.a_ready(cur);
    PG8_STAGE(PG8_SB(0, 0), cB, voffB); PG8_STAGE(PG8_SA(0, 0), cA, voffA); PG8_STAGE(PG8_SB(0, 1), cB + hstep, voffB); PG8_STAGE(PG8_SA(0, 1), cA + hstep, voffA);
    if (wr == 1) PG8_BAR;
    PG8_WAIT_V(4); PG8_BAR;
    PG8_STAGE(PG8_SB(1, 0), cB + kstep, voffB); PG8_STAGE(PG8_SA(1, 0), cA + kstep, voffA); PG8_STAGE(PG8_SB(1, 1), cB + hstep + kstep, voffB);
    PG8_WAIT_V(6); PG8_BAR;
    PG8_STAMP();
    for (;;) {
        const bool has_next = S.next(ui + 1, nxt);
        const char* nA = has_next ? (const char*)g.A + (size_t)nxt.pm * tstep : cA; const char* nB = has_next ? (const char*)g.Bt + (size_t)nxt.pn * tstep : cB;
        for (int t = 0; t < nt; t += 2) {
            const bool last = (t == nt - 2);
            const char* a1 = cA + (size_t)(t + 1) * kstep;
            const char* a2 = last ? nA : cA + (size_t)(t + 2) * kstep; const char* b2 = last ? nB : cB + (size_t)(t + 2) * kstep;
            const char* a3 = a2 + kstep; const char* b3 = b2 + kstep;
            if (last && has_next) S.a_ready(nxt);
            PG8_LDB(B0, 0, 0); PG8_SCHED; PG8_LDA(At, 0, 0); PG8_STAGE(PG8_SA(1, 1), a1 + hstep, voffA);
            PG8_WAIT_L(8); PG8_BAR; PG8_WAIT_L(0); PG8_MMA(0, 0, At, B0); PG8_BAR; PG8_SCHED;
            PG8_LDB(B1, 0, 1); PG8_STAGE(PG8_SB(0, 0), b2, voffB);
            PG8_BAR; PG8_WAIT_L(0); PG8_MMA(0, 1, At, B1); PG8_BAR;
            PG8_LDA(At, 0, 1); PG8_STAGE(PG8_SA(0, 0), a2, voffA);
            PG8_BAR; PG8_WAIT_L(0); PG8_MMA(1, 0, At, B0); PG8_BAR; PG8_SCHED;
            PG8_STAGE(PG8_SB(0, 1), b2 + hstep, voffB);
            PG8_WAIT_V(6); PG8_BAR; PG8_MMA(1, 1, At, B1); PG8_BAR;
            PG8_LDB(B0, 1, 0); PG8_SCHED; PG8_LDA(At, 1, 0); PG8_STAGE(PG8_SA(0, 1), a2 + hstep, voffA);
            PG8_WAIT_L(8); PG8_BAR; PG8_WAIT_L(0); PG8_MMA(0, 0, At, B0); PG8_BAR; PG8_SCHED;
            PG8_LDB(B1, 1, 1); PG8_STAGE(PG8_SB(1, 0), b3, voffB);
            PG8_BAR; PG8_WAIT_L(0); PG8_MMA(0, 1, At, B1); PG8_BAR;
            PG8_LDA(At, 1, 1); PG8_STAGE(PG8_SA(1, 0), a3, voffA);
            PG8_BAR; PG8_WAIT_L(0); PG8_MMA(1, 0, At, B0); PG8_BAR; PG8_SCHED;
            PG8_STAGE(PG8_SB(1, 1), b3 + hstep, voffB);
            PG8_WAIT_V(6); PG8_BAR; PG8_MMA(1, 1, At, B1); PG8_BAR;
        }
        PG8_STAMP();
        if constexpr (!Epi::AFTER_DRAIN) { E(acc, cur, wr, wc, fr, fq); S.done(cur); }
        PG8_STAMP();
        if (!has_next) break;
#pragma unroll
        for (int a = 0; a < 2; ++a)
#pragma unroll
            for (int b = 0; b < 2; ++b)
#pragma unroll
                for (int m = 0; m < 4; ++m)
#pragma unroll
                    for (int n = 0; n < 2; ++n) acc[a][b][m][n] = (f32x4){0.f, 0.f, 0.f, 0.f};
        cur = nxt; cA = nA; cB = nB; ++ui;
    }
    PG8_WAIT_V(0);
    if (wr == 0) PG8_BAR;
    PG8_BAR;
    if constexpr (Epi::AFTER_DRAIN) { E.fused(acc, cur, wr, wc, fr, fq, lds, wid, lane); S.done(cur); }
    PG8_STAMP();
    if (STAMP && wid == 0) { stamps[lane] = lane < nts ? (((unsigned long long)(unsigned)ts_hi << 32) | (unsigned)ts_lo) : 0ull;
        if (lane == 62) stamps[62] = rt_entry; if (lane == 63) stamps[63] = (unsigned long long)wall_clock64(); }
#undef PG8_STAMP
#undef PG8_SA
#undef PG8_SB
#undef PG8_STAGE
#undef PG8_LDA
#undef PG8_LDB
#undef PG8_MMA
#undef PG8_WAIT_V
#undef PG8_WAIT_L
#undef PG8_BAR
#undef PG8_SCHED
}
}
#define XB_TMO      128
#define XB_XCNT(j)  (256  + 64 * (j))
#define XB_XSUB(j)  (1280 + 64 * (j))
#define XB_XGEN(j)  (2304 + 64 * (j))
#define XB_TOP      3328
#define XB_TOPGEN   3392
#define XCD_BAR_WORDS 3456
#define XB_SPIN_CAP (1u << 18)
#define LAS __attribute__((address_space(3)))

__device__ __forceinline__ unsigned xb_ld(unsigned* p)              { return __hip_atomic_load(p, __ATOMIC_RELAXED, __HIP_MEMORY_SCOPE_AGENT); }
__device__ __forceinline__ unsigned xb_add(unsigned* p, unsigned v) { return __hip_atomic_fetch_add(p, v, __ATOMIC_RELAXED, __HIP_MEMORY_SCOPE_AGENT); }
__device__ __forceinline__ unsigned xb_xcc_id() { return (unsigned)__builtin_amdgcn_s_getreg((3 << 11) | 20) & 0xFu; }
#define XB_SPIN(cond, bar) do { unsigned _sp = 0; while (cond) { __builtin_amdgcn_s_sleep(1); \
    if ((++_sp & 255u) == 0u) { if (xb_ld(&(bar)[XB_TMO])) break; if (_sp > XB_SPIN_CAP) { atomicAdd(&(bar)[XB_TMO], 1u); break; } } } } while (0)

struct XcdBarrier {
    unsigned wave;
    unsigned* bar; unsigned x;
    volatile LAS unsigned* st;
};

__device__ __forceinline__ XcdBarrier xcd_barrier_post(unsigned* bar, volatile LAS unsigned* st, unsigned wave) {
    XcdBarrier b; b.wave = wave; b.bar = bar; b.x = xb_xcc_id(); b.st = st;
    if (wave == 0u && mk_lane_id() == 0) (void)xb_add(&bar[XB_XCNT(b.x)], 1u);
    return b;
}
__device__ __forceinline__ void xcd_barrier_complete(unsigned* bar, unsigned x, unsigned& nloc, unsigned& nx) {
    const unsigned G = gridDim.x * gridDim.y * gridDim.z;
    unsigned sum, cnt, mine, sp = 0u;
    for (;;) {
        sum = 0u; cnt = 0u; mine = 0u;
#pragma unroll
        for (unsigned j = 0; j < 16; ++j) { const unsigned c = xb_ld(&bar[XB_XCNT(j)]); sum += c; cnt += (c > 0u) ? 1u : 0u; mine = (j == x) ? c : mine; }
        if (sum == G) break;
        __builtin_amdgcn_s_sleep(1);
        if ((++sp & 255u) == 0u) { if (xb_ld(&bar[XB_TMO])) break; if (sp > XB_SPIN_CAP) { atomicAdd(&bar[XB_TMO], 1u); break; } }
    }
    nloc = mine > 0u ? mine : 1u; nx = cnt > 0u ? cnt : 1u;
}

__device__ __forceinline__ void xcd_barrier(const XcdBarrier& b) {
    asm volatile("s_waitcnt vmcnt(0)" ::: "memory");
    __syncthreads();
    if (b.wave == 0u && mk_lane_id() == 0) {
        unsigned* bar = b.bar;
        __builtin_amdgcn_s_waitcnt(0);
        unsigned nloc = b.st[0], nx = b.st[1];
        if (nloc == 0u) { xcd_barrier_complete(bar, b.x, nloc, nx); b.st[0] = nloc; b.st[1] = nx; }
        const unsigned old = xb_add(&bar[XB_XSUB(b.x)], 1u);
        const unsigned gen = old / nloc;
        if (old + 1u == (gen + 1u) * nloc) {
            __builtin_amdgcn_fence(__ATOMIC_RELEASE, "agent");
            asm volatile("s_waitcnt vmcnt(0)" ::: "memory");
            const unsigned og = xb_add(&bar[XB_TOP], 1u);
            const unsigned tg = og / nx;
            if (og + 1u == (tg + 1u) * nx) xb_add(&bar[XB_TOPGEN], 1u);
            else XB_SPIN(xb_ld(&bar[XB_TOPGEN]) == tg, bar);
            __builtin_amdgcn_fence(__ATOMIC_ACQUIRE, "agent");
            xb_add(&bar[XB_XGEN(b.x)], 1u);
            asm volatile("s_waitcnt vmcnt(0)" ::: "memory");
        } else {
            XB_SPIN(xb_ld(&bar[XB_XGEN(b.x)]) == gen, bar);
            __builtin_amdgcn_fence(__ATOMIC_ACQUIRE, "agent");
            asm volatile("s_waitcnt vmcnt(0)" ::: "memory");
        }
    }
    __syncthreads();
}
namespace mk {
typedef unsigned short bf16_t;
typedef float f32x4 __attribute__((ext_vector_type(4)));
using pg8::pk2;
constexpr int D = 2048, NB = 4, S = 2048, T = NB * S, HD = 128, INW = 7168;
constexpr int NKEYS = 128;
constexpr float ALPHA = 1.189207115002721f;
constexpr int NTHR = 512;
constexpr size_t MiB = (size_t)1 << 20;
constexpr size_t WS_CTL = 0;
constexpr size_t CTL_BYTES = 64 * 1024;
constexpr size_t WS_XB = 1 * MiB;
constexpr size_t WS_WIN = 33 * MiB;
constexpr size_t WS_WOUT = 61 * MiB;
constexpr size_t WS_WPQ = 69 * MiB;
constexpr size_t WS_SKB = 77 * MiB;
constexpr size_t WS_ROT = 78 * MiB;
constexpr size_t WS_PROJ = 80 * MiB;
constexpr size_t WS_MIXED = 192 * MiB;
constexpr size_t WS_Y1 = 224 * MiB;
constexpr size_t WS_X1B = 288 * MiB;
constexpr size_t WS_QP = 320 * MiB;
constexpr size_t WS_EIDX = 352 * MiB;
constexpr size_t WS_EGATE = 356 * MiB;
constexpr size_t WS_PREV = 360 * MiB;
constexpr size_t WS_SE = 392 * MiB;
constexpr size_t WS_SG = 396 * MiB;
constexpr size_t WS_UQ = 417 * MiB;
constexpr size_t WS_VQ = 449 * MiB;
constexpr size_t WS_SU = 400 * MiB;
constexpr size_t WS_SV = 400 * MiB + 65536;
constexpr size_t WS_SX = 400 * MiB + 131072;
constexpr size_t WS_X1Q = 401 * MiB;
constexpr size_t WS_END = 481 * MiB;
constexpr size_t CTL_QUEUE = 32768;
constexpr int LDS_MISC = 2048;
constexpr int LDS_BYTES = pg8::STAGE_BYTES + LDS_MISC;

__device__ __forceinline__ float bflo(unsigned u) { return __uint_as_float(u << 16); }
__device__ __forceinline__ float bfhi(unsigned u) { return __uint_as_float(u & 0xffff0000u); }
__device__ __forceinline__ float wave_sum(float v) {
#pragma unroll
  for (int o = 32; o > 0; o >>= 1) v += __shfl_xor(v, o);
  return v;
}
__device__ __forceinline__ float wave_max(float v) {
#pragma unroll
  for (int o = 32; o > 0; o >>= 1) v = fmaxf(v, __shfl_xor(v, o));
  return v;
}
__device__ __forceinline__ int wave_min_i(int v) {
#pragma unroll
  for (int o = 32; o > 0; o >>= 1) v = min(v, __shfl_xor(v, o));
  return v;
}

struct Ctx {
  const float* in[13];
  float* out;
  unsigned char* ws;
  LAS unsigned char* lds;
  int wave, G;
};

__device__ __forceinline__ void transpose_bf16(const Ctx& c, const float* __restrict__ w, bf16_t* __restrict__ wt, int K, int N, int rot_lo = 0, int rot_hi = 0) {
  LAS float* tile = (LAS float*)c.lds;
  const int ntk = K / 64, ntiles = ntk * (N / 64);
  for (int tile_i = blockIdx.x; tile_i < ntiles; tile_i += c.G) {
    const int k0 = (tile_i % ntk) * 64, n0 = (tile_i / ntk) * 64;
    {
      const int r = (c.wave * 64 + mk_lane_id()) >> 3, c8 = ((c.wave * 64 + mk_lane_id()) & 7) * 8;
      const float4 a = *(const float4*)(w + (size_t)(k0 + r) * N + n0 + c8);
      const float4 b = *(const float4*)(w + (size_t)(k0 + r) * N + n0 + c8 + 4);
      LAS float* p = tile + r * 65 + c8;
      p[0] = a.x; p[1] = a.y; p[2] = a.z; p[3] = a.w; p[4] = b.x; p[5] = b.y; p[6] = b.z; p[7] = b.w;
    }
    __syncthreads();
    {
      const int n = (c.wave * 64 + mk_lane_id()) >> 3, k8 = ((c.wave * 64 + mk_lane_id()) & 7) * 8;
      float v[8];
#pragma unroll
      for (int j = 0; j < 8; ++j) v[j] = tile[(k8 + j) * 65 + n];
      uint4 o; o.x = pk2(v[0], v[1]); o.y = pk2(v[2], v[3]); o.z = pk2(v[4], v[5]); o.w = pk2(v[6], v[7]);
      int nrow = n0 + n;
      if (nrow >= rot_lo && nrow < rot_hi) { const int d = nrow & 127; nrow = (nrow & ~127) + 8 * ((d & 63) >> 2) + (d & 3) + 4 * (d >> 6); }
      *(uint4*)(wt + (size_t)nrow * K + k0 + k8) = o;
    }
    __syncthreads();
  }
}
__device__ __forceinline__ void p0_prologue(const Ctx& c) {
  const size_t gtid = (size_t)blockIdx.x * NTHR + (c.wave * 64 + mk_lane_id()), gstride = (size_t)c.G * NTHR;
  {
    const float4* x4 = (const float4*)c.in[0];
    uint4* xb4 = (uint4*)(c.ws + WS_XB);
    for (size_t i = gtid; i < (size_t)T * D / 8; i += gstride) {
      const float4 a = x4[2 * i], b = x4[2 * i + 1];
      uint4 o; o.x = pk2(a.x, a.y); o.y = pk2(a.z, a.w); o.z = pk2(b.x, b.y); o.w = pk2(b.z, b.w);
      xb4[i] = o;
    }
  }
  transpose_bf16(c, c.in[1], (bf16_t*)(c.ws + WS_WIN), D, INW, 3072, 5120);
  transpose_bf16(c, c.in[4], (bf16_t*)(c.ws + WS_WOUT), D, D);
  transpose_bf16(c, c.in[7], (bf16_t*)(c.ws + WS_WPQ), D, D);
  {
    const float4* s4 = (const float4*)c.in[8];
    uint4* d4 = (uint4*)(c.ws + WS_SKB);
    for (size_t i = gtid; i < (size_t)8 * 2 * 128 * 128 / 8; i += gstride) {
      const float4 a = s4[2 * i], b = s4[2 * i + 1];
      uint4 o; o.x = pk2(a.x, a.y); o.y = pk2(a.z, a.w); o.z = pk2(b.x, b.y); o.w = pk2(b.z, b.w);
      d4[i] = o;
    }
  }
  {
    float* cs = (float*)(c.ws + WS_ROT);
    float* sn = cs + S * 64;
    for (size_t i = gtid; i < (size_t)S * 64; i += gstride) {
      const int s = (int)(i >> 6), f = (int)(i & 63);
      const float inv_freq = (float)pow(10000.0, -(2.0 * f) / 128.0);
      const float ang = (float)s * inv_freq;
      cs[i] = (float)cos((double)ang);
      sn[i] = (float)sin((double)ang);
    }
  }
}

__device__ __forceinline__ void p2_rotate(const Ctx& c) {
  bf16_t* proj = (bf16_t*)(c.ws + WS_PROJ);
  const float* cs = (const float*)(c.ws + WS_ROT);
  const float* sn = cs + S * 64;
  const size_t gtid = (size_t)blockIdx.x * NTHR + (c.wave * 64 + mk_lane_id()), gstride = (size_t)c.G * NTHR;
  for (size_t it = gtid; it < (size_t)T * 128; it += gstride) {
    const int row = (int)(it >> 7), rem = (int)(it & 127);
    const int which = rem >> 6, h = (rem >> 3) & 7, i0 = (rem & 7) * 8;
    const int s = row & (S - 1);
    bf16_t* p = proj + (size_t)row * INW + 3072 + which * 1024 + h * HD + i0;
    const uint4 lo = *(const uint4*)p, hi = *(const uint4*)(p + 64);
    const float4 c0 = *(const float4*)(cs + s * 64 + i0), c1 = *(const float4*)(cs + s * 64 + i0 + 4);
    const float4 s0 = *(const float4*)(sn + s * 64 + i0), s1 = *(const float4*)(sn + s * 64 + i0 + 4);
    const float cv[8] = {c0.x, c0.y, c0.z, c0.w, c1.x, c1.y, c1.z, c1.w};
    const float sv[8] = {s0.x, s0.y, s0.z, s0.w, s1.x, s1.y, s1.z, s1.w};
    const unsigned lw[4] = {lo.x, lo.y, lo.z, lo.w}, hw[4] = {hi.x, hi.y, hi.z, hi.w};
    unsigned ol[4], oh[4];
#pragma unroll
    for (int j = 0; j < 4; ++j) {
      const float l0 = bflo(lw[j]), l1 = bfhi(lw[j]), h0 = bflo(hw[j]), h1 = bfhi(hw[j]);
      const float nl0 = l0 * cv[2 * j] - h0 * sv[2 * j], nl1 = l1 * cv[2 * j + 1] - h1 * sv[2 * j + 1];
      const float nh0 = h0 * cv[2 * j] + l0 * sv[2 * j], nh1 = h1 * cv[2 * j + 1] + l1 * sv[2 * j + 1];
      ol[j] = pk2(nl0, nl1); oh[j] = pk2(nh0, nh1);
    }
    uint4 a; a.x = ol[0]; a.y = ol[1]; a.z = ol[2]; a.w = ol[3];
    uint4 b; b.x = oh[0]; b.y = oh[1]; b.z = oh[2]; b.w = oh[3];
    *(uint4*)p = a; *(uint4*)(p + 64) = b;
  }
}

__device__ __forceinline__ void quant_rows(const Ctx& c, int rr0, int nrows) {
  const int lane = mk_lane_id();
  const int rend = rr0 + nrows;
  f32x4 va[8], vb[8];
#define QR_LOAD(V, RR) do { const int rr_ = (RR) < rend ? (RR) : rend - 1; const float* src_ = ((rr_ >> 14) ? c.in[10] : c.in[9]) + (size_t)(rr_ & 16383) * D; \
    _Pragma("unroll") for (int i_ = 0; i_ < 8; ++i_) V[i_] = *(const f32x4*)(src_ + (i_ * 64 + lane) * 4); } while (0)
#define QR_DO(V, RR) do { if ((RR) < rend) { const int which_ = (RR) >> 14, row_ = (RR) & 16383; float mx_ = 0.f; \
    _Pragma("unroll") for (int i_ = 0; i_ < 8; ++i_) mx_ = fmaxf(mx_, fmaxf(fmaxf(fabsf(V[i_][0]), fabsf(V[i_][1])), fmaxf(fabsf(V[i_][2]), fabsf(V[i_][3])))); \
    mx_ = fmaxf(wave_max(mx_), 1e-30f); const float inv_ = 127.f / mx_; const int off_ = which_ ? 128 : 0; \
    unsigned* dst_ = (unsigned*)(c.ws + (which_ ? WS_VQ : WS_UQ) + (size_t)row_ * D); \
    _Pragma("unroll") for (int i_ = 0; i_ < 8; ++i_) { unsigned w_ = 0; \
      _Pragma("unroll") for (int k_ = 0; k_ < 4; ++k_) { const int q_ = (int)rintf(V[i_][k_] * inv_) + off_; w_ |= ((unsigned)q_ & 255u) << (8 * k_); } \
      dst_[i_ * 64 + lane] = w_; } \
    if (lane == 0) ((float*)(c.ws + (which_ ? WS_SV : WS_SU)))[row_] = mx_ * (1.f / 127.f); } } while (0)
  QR_LOAD(va, rr0); QR_LOAD(vb, rr0 + 1);
  for (int rr = rr0; rr < rend; rr += 2) {
    QR_DO(va, rr); QR_LOAD(va, rr + 2);
    QR_DO(vb, rr + 1); QR_LOAD(vb, rr + 3);
  }
#undef QR_LOAD
#undef QR_DO
}

__device__ __forceinline__ void p3_attn_naive(const Ctx& c) {
  const bf16_t* proj = (const bf16_t*)(c.ws + WS_PROJ);
  bf16_t* mixed = (bf16_t*)(c.ws + WS_MIXED);
  const float* sbw = c.in[2];
  const float* rnw = c.in[3];
  const int lane = mk_lane_id(), gw = blockIdx.x * 8 + c.wave, NW = c.G * 8;
  const float scale = 0.08838834764831845f;
  for (int r = gw; r < NB * 8 * S; r += NW) {
    const int bh = r >> 11, t = r & (S - 1), b = bh >> 3, h = bh & 7;
    const bf16_t* base = proj + (size_t)b * S * INW + h * HD + lane * 2;
    const unsigned qw = *(const unsigned*)(base + (size_t)t * INW);
    const float qx = bflo(qw), qy = bfhi(qw);
    float ox = 0.f, oy = 0.f, run = 0.f;
    for (int s = t - 1; s >= 0; --s) {
      const unsigned kw = *(const unsigned*)(base + (size_t)s * INW + 1024);
      const unsigned vw = *(const unsigned*)(base + (size_t)s * INW + 2048);
      const float z = wave_sum(qx * bflo(kw) + qy * bfhi(kw)) * scale;
      const float l1p = log1pf(expf(-fabsf(z)));
      const float sp = fmaxf(z, 0.f) + l1p;
      const float ls = fminf(z, 0.f) - l1p;
      const float a = expf(ls - run);
      ox += a * bflo(vw); oy += a * bfhi(vw);
      run += sp;
      if (run > 104.f) break;
    }
    const float ms = wave_sum(ox * ox + oy * oy) * (1.f / 128.f);
    const float rr = rsqrtf(ms + 1e-6f);
    const float2 wv = *(const float2*)(sbw + h * HD + lane * 2);
    *(unsigned*)(mixed + (size_t)(b * S + t) * D + h * HD + lane * 2) = pk2(ox * rr * wv.x, oy * rr * wv.y);
  }
  for (int r = gw; r < NB * 8 * S; r += NW) {
    const int bh = r >> 11, tt = r & (S - 1), b = bh >> 3, h = bh & 7;
    const int t = (bh & 1) ? (S - 1 - tt) : tt;
    const bf16_t* base = proj + (size_t)b * S * INW + h * HD + lane * 2;
    const unsigned qw = *(const unsigned*)(base + (size_t)t * INW + 3072);
    const float qx = bflo(qw), qy = bfhi(qw);
    const float log_g = log1pf(-exp2f(-5.f - (float)h));
    const int s_end = ((t >> 6) + 1) << 6;
    float ox = 0.f, oy = 0.f;
    for (int s = 0; s < s_end; ++s) {
      const unsigned kw = *(const unsigned*)(base + (size_t)s * INW + 4096);
      const unsigned vw = *(const unsigned*)(base + (size_t)s * INW + 5120);
      const float dist = fabsf((float)(t - s));
      const float z = wave_sum(qx * bflo(kw) + qy * bfhi(kw)) * scale * expf(log_g * dist);
      ox += z * bflo(vw); oy += z * bfhi(vw);
    }
    const float mu = wave_sum(ox + oy) * (1.f / 128.f);
    const float dx = ox - mu, dy = oy - mu;
    const float var = wave_sum(dx * dx + dy * dy) * (1.f / 128.f);
    const float rr = rsqrtf(var + 1e-6f);
    const float2 wv = *(const float2*)(rnw + h * HD + lane * 2);
    const unsigned gwd = *(const unsigned*)(base + (size_t)t * INW + 6144);
    const float gx = bflo(gwd), gy = bfhi(gwd);
    const float sx = gx / (1.f + expf(-gx)), sy = gy / (1.f + expf(-gy));
    *(unsigned*)(mixed + (size_t)(b * S + t) * D + 1024 + h * HD + lane * 2) = pk2(dx * rr * wv.x * sx, dy * rr * wv.y * sy);
  }
}

typedef short bf16x8 __attribute__((ext_vector_type(8)));
typedef short s16x4 __attribute__((ext_vector_type(4)));
typedef float f32x16 __attribute__((ext_vector_type(16)));
typedef unsigned u32x4 __attribute__((ext_vector_type(4)));
#define MFMA32(a, b, c) __builtin_amdgcn_mfma_f32_32x32x16_bf16((a), (b), (c), 0, 0, 0)
constexpr int WAVE_LDS = 10240;
constexpr int VRS = 320;
constexpr float SCALE = 0.08838834764831845f;
constexpr float LOG2E = 1.4426950408889634f;
__device__ __forceinline__ int crow(int reg, int h) { return (reg & 3) + 8 * (reg >> 2) + 4 * h; }
__device__ __forceinline__ int krow(int s, int h, int j) { return 16 * s + 8 * (j >> 2) + 4 * h + (j & 3); }
__device__ __forceinline__ bf16x8 pack8(const f32x16& x, const int s) {
  u32x4 p;
  p[0] = pk2(x[8 * s + 0], x[8 * s + 1]); p[1] = pk2(x[8 * s + 2], x[8 * s + 3]);
  p[2] = pk2(x[8 * s + 4], x[8 * s + 5]); p[3] = pk2(x[8 * s + 6], x[8 * s + 7]);
  return __builtin_bit_cast(bf16x8, p);
}
__device__ __forceinline__ s16x4 tr16(LAS unsigned char* p) { return __builtin_amdgcn_ds_read_tr16_b64_v4i16((LAS s16x4*)p); }
__device__ __forceinline__ bf16x8 cat8(s16x4 lo, s16x4 hi) { return __builtin_shufflevector(lo, hi, 0, 1, 2, 3, 4, 5, 6, 7); }
__device__ __forceinline__ void wave_lds_fence() { asm volatile("s_waitcnt lgkmcnt(0)" ::: "memory"); }
__device__ __forceinline__ float half_sum(float v) {
#pragma unroll
  for (int o = 16; o > 0; o >>= 1) v += __shfl_xor(v, o);
  return v;
}
__device__ __forceinline__ void vtile_load(u32x4 (&vr)[8], const bf16_t* vbase, int lane) {
#pragma unroll
  for (int it = 0; it < 8; ++it) vr[it] = *(const u32x4*)(vbase + (size_t)(4 * it + (lane >> 4)) * INW + (lane & 15) * 8);
}
__device__ __forceinline__ void vtile_store(const u32x4 (&vr)[8], LAS unsigned char* wl, int lane) {
#pragma unroll
  for (int it = 0; it < 8; ++it) *(LAS u32x4*)(wl + (4 * it + (lane >> 4)) * VRS + (lane & 15) * 16) = vr[it];
}
__device__ __forceinline__ void pv_accum(f32x16 (&o)[4], const f32x16& a, LAS unsigned char* wl, int lane) {
  const int h = lane >> 5, i16 = lane & 15, q = i16 >> 2, p = i16 & 3, blk = (lane >> 4) & 1;
  const bf16x8 pa0 = pack8(a, 0), pa1 = pack8(a, 1);
  LAS unsigned char* b0 = wl + (4 * h + q) * VRS + (16 * blk + 4 * p) * 2;
#pragma unroll
  for (int cidx = 0; cidx < 4; ++cidx) {
#pragma unroll
    for (int s = 0; s < 2; ++s) {
      const s16x4 lo = tr16(b0 + (16 * s) * VRS + cidx * 64);
      const s16x4 hi = tr16(b0 + (16 * s + 8) * VRS + cidx * 64);
      o[cidx] = MFMA32(s == 0 ? pa0 : pa1, cat8(lo, hi), o[cidx]);
    }
  }
}

__device__ __forceinline__ void sb_task(const Ctx& c, int task, LAS unsigned char* wl) {
  const bf16_t* proj = (const bf16_t*)(c.ws + WS_PROJ);
  bf16_t* mixed = (bf16_t*)(c.ws + WS_MIXED);
  const float* sbw = c.in[2];
  const int lane = mk_lane_id(), r = lane & 31, h = lane >> 5;
  const int qb = task & 63, bh = task >> 6, b = bh >> 3, hd = bh & 7, q0 = qb * 32;
  const bf16_t* base = proj + (size_t)b * S * INW + hd * HD;
  bf16x8 qf[8];
#pragma unroll
  for (int s = 0; s < 8; ++s) qf[s] = *(const bf16x8*)(base + (size_t)(q0 + r) * INW + 16 * s + 8 * h);
  bf16x8 tf[2];
#pragma unroll
  for (int s = 0; s < 2; ++s)
#pragma unroll
    for (int jj = 0; jj < 8; ++jj) tf[s][jj] = (krow(s, h, jj) > r) ? (short)0x3F80 : (short)0;
  f32x16 o[4];
#pragma unroll
  for (int cidx = 0; cidx < 4; ++cidx)
#pragma unroll
    for (int i = 0; i < 16; ++i) o[cidx][i] = 0.f;
  float R = 0.f;
  const float c2 = SCALE * LOG2E;
  for (int k0 = q0; k0 >= 0; k0 -= 32) {
    u32x4 vr[8];
    vtile_load(vr, base + 2048 + (size_t)k0 * INW, lane);
    f32x16 st;
#pragma unroll
    for (int i = 0; i < 16; ++i) st[i] = 0.f;
#pragma unroll
    for (int s = 0; s < 8; ++s) {
      const bf16x8 kf = *(const bf16x8*)(base + 1024 + (size_t)(k0 + r) * INW + 16 * s + 8 * h);
      st = MFMA32(kf, qf[s], st);
    }
    const bool diag = (k0 == q0);
    f32x16 sp, m;
#pragma unroll
    for (int i = 0; i < 16; ++i) {
      const float y = st[i] * c2;
      const float e = __builtin_amdgcn_exp2f(-fabsf(y));
      const float l = __builtin_amdgcn_logf(1.f + e);
      const bool valid = !diag || (crow(i, h) < r);
      sp[i] = valid ? (fmaxf(y, 0.f) + l) : 0.f;
      st[i] = y; m[i] = R;
    }
    m = MFMA32(tf[0], pack8(sp, 0), m);
    m = MFMA32(tf[1], pack8(sp, 1), m);
    f32x16 a;
#pragma unroll
    for (int i = 0; i < 16; ++i) {
      const bool valid = !diag || (crow(i, h) < r);
      const float v = __builtin_amdgcn_exp2f(st[i] - sp[i] - m[i]);
      a[i] = valid ? v : 0.f;
    }
    R = __shfl(m[0] + sp[0], r);
    vtile_store(vr, wl, lane);
    wave_lds_fence();
    pv_accum(o, a, wl, lane);
    if (__all(R > 150.5f)) break;
  }
#pragma unroll
  for (int i = 0; i < 16; ++i) {
    const float ss = half_sum(o[0][i] * o[0][i] + o[1][i] * o[1][i] + o[2][i] * o[2][i] + o[3][i] * o[3][i]);
    const float rr = rsqrtf(ss * (1.f / 128.f) + 1e-6f);
    bf16_t* orow = mixed + (size_t)(b * S + q0 + crow(i, h)) * D + hd * HD + r;
#pragma unroll
    for (int cidx = 0; cidx < 4; ++cidx) orow[32 * cidx] = (bf16_t)(pk2(o[cidx][i] * rr * sbw[hd * HD + 32 * cidx + r], 0.f) & 0xffffu);
  }
}

__device__ __forceinline__ void state_task(const Ctx& c, int task, LAS unsigned char* wl) {
  const bf16_t* proj = (const bf16_t*)(c.ws + WS_PROJ);
  bf16_t* prevT = (bf16_t*)(c.ws + WS_PREV);
  const int lane = mk_lane_id(), r = lane & 31, h = lane >> 5;
  const int vblk = task & 3, dblk = (task >> 2) & 3, bh = task >> 4, b = bh >> 3, hd = bh & 7;
  const bf16_t* kbase = proj + (size_t)b * S * INW + 4096 + hd * HD + 32 * dblk;
  const bf16_t* vbase = proj + (size_t)b * S * INW + 5120 + hd * HD + 32 * vblk;
  const float log2g = __builtin_amdgcn_logf(1.f - exp2f(-5.f - (float)hd));
  const float cd = exp2f(log2g * 64.f);
  f32x16 acc;
#pragma unroll
  for (int i = 0; i < 16; ++i) acc[i] = 0.f;
  const int i16 = lane & 15, q = i16 >> 2, p = i16 & 3, blk = (lane >> 4) & 1;
  LAS unsigned char* kt = wl;
  LAS unsigned char* vt = wl + 4096;
  const int toff = (8 * h + q) * 64 + (16 * blk + 4 * p) * 2;
  constexpr int SD = 2;
  u32x4 kq[SD][4], vv[SD][4];
#define ST_ISSUE(SL, N) do { const int n_ = (N) < S / 64 ? (N) : S / 64 - 1; _Pragma("unroll") for (int it_ = 0; it_ < 4; ++it_) { \
      const int idx_ = it_ * 64 + lane, row_ = idx_ >> 2, ch_ = idx_ & 3; \
      kq[SL][it_] = *(const u32x4*)(kbase + (size_t)(n_ * 64 + row_) * INW + 8 * ch_); \
      vv[SL][it_] = *(const u32x4*)(vbase + (size_t)(n_ * 64 + row_) * INW + 8 * ch_); } } while (0)
#pragma unroll
  for (int sl = 0; sl < SD; ++sl) ST_ISSUE(sl, sl);
#pragma unroll 1
  for (int n0 = 0; n0 < S / 64; n0 += SD) {
#pragma unroll
    for (int sl = 0; sl < SD; ++sl) {
      const int n = n0 + sl;
      bf16_t* pp = prevT + ((size_t)(bh * 32 + n) * 128 + 32 * vblk + r) * 128 + 32 * dblk + 4 * h;
#pragma unroll
      for (int g = 0; g < 4; ++g) {
        uint2 w; w.x = pk2(acc[4 * g], acc[4 * g + 1]); w.y = pk2(acc[4 * g + 2], acc[4 * g + 3]);
        *(uint2*)(pp + 8 * g) = w;
      }
#pragma unroll
      for (int it = 0; it < 4; ++it) {
        const int idx = it * 64 + lane, row = idx >> 2, ch = idx & 3;
        *(LAS u32x4*)(kt + row * 64 + ch * 16) = kq[sl][it];
        *(LAS u32x4*)(vt + row * 64 + ch * 16) = vv[sl][it];
      }
      ST_ISSUE(sl, n + SD);
      wave_lds_fence();
#pragma unroll
      for (int i = 0; i < 16; ++i) acc[i] *= cd;
#pragma unroll
      for (int s = 0; s < 4; ++s) {
        const s16x4 klo = tr16(kt + toff + (16 * s) * 64), khi = tr16(kt + toff + (16 * s + 4) * 64);
        const s16x4 vlo = tr16(vt + toff + (16 * s) * 64), vhi = tr16(vt + toff + (16 * s + 4) * 64);
        const u32x4 kraw = __builtin_bit_cast(u32x4, cat8(klo, khi));
        u32x4 ks;
#pragma unroll
        for (int jj = 0; jj < 4; ++jj) {
          const float z0 = SCALE * __builtin_amdgcn_exp2f(log2g * (float)(63 - (16 * s + 8 * h + 2 * jj)));
          const float z1 = SCALE * __builtin_amdgcn_exp2f(log2g * (float)(63 - (16 * s + 8 * h + 2 * jj + 1)));
          ks[jj] = pk2(bflo(kraw[jj]) * z0, bfhi(kraw[jj]) * z1);
        }
        acc = MFMA32(__builtin_bit_cast(bf16x8, ks), cat8(vlo, vhi), acc);
      }
    }
  }
#undef ST_ISSUE
}

__device__ __forceinline__ void retout_task(const Ctx& c, int task, LAS unsigned char* wl) {
  const bf16_t* proj = (const bf16_t*)(c.ws + WS_PROJ);
  const bf16_t* prevT = (const bf16_t*)(c.ws + WS_PREV);
  bf16_t* mixed = (bf16_t*)(c.ws + WS_MIXED);
  const float* rnw = c.in[3];
  const int lane = mk_lane_id(), r = lane & 31, h = lane >> 5;
  const int half = task & 1, n = (task >> 1) & 31, bh = task >> 6, b = bh >> 3, hd = bh & 7;
  const bf16_t* base = proj + (size_t)b * S * INW + hd * HD;
  const float log2g = __builtin_amdgcn_logf(1.f - exp2f(-5.f - (float)hd));
  const int qpos0 = n * 64 + 32 * half;
  bf16x8 qf[8];
#pragma unroll
  for (int s = 0; s < 8; ++s) qf[s] = *(const bf16x8*)(base + 3072 + (size_t)(qpos0 + r) * INW + 16 * s + 8 * h);
  f32x16 o[4];
#pragma unroll
  for (int cidx = 0; cidx < 4; ++cidx)
#pragma unroll
    for (int i = 0; i < 16; ++i) o[cidx][i] = 0.f;
  if (n > 0) {
    const bf16_t* pb = prevT + ((size_t)(bh * 32 + n) * 128 + r) * 128 + 8 * h;
#pragma unroll
    for (int cidx = 0; cidx < 4; ++cidx)
#pragma unroll
      for (int s = 0; s < 8; ++s) {
        const bf16x8 pf = *(const bf16x8*)(pb + (size_t)(32 * cidx) * 128 + 16 * s);
        o[cidx] = MFMA32(qf[s], pf, o[cidx]);
      }
#pragma unroll
    for (int i = 0; i < 16; ++i) {
      const float xi = __builtin_amdgcn_exp2f(log2g * (float)(32 * half + crow(i, h) + 1));
#pragma unroll
      for (int cidx = 0; cidx < 4; ++cidx) o[cidx][i] *= xi;
    }
  }
#pragma unroll 1
  for (int tile = 0; tile < 2; ++tile) {
    const int kpos0 = n * 64 + 32 * tile;
    u32x4 vr[8];
    vtile_load(vr, base + 5120 + (size_t)kpos0 * INW, lane);
    f32x16 st;
#pragma unroll
    for (int i = 0; i < 16; ++i) st[i] = 0.f;
#pragma unroll
    for (int s = 0; s < 8; ++s) {
      const bf16x8 kf = *(const bf16x8*)(base + 4096 + (size_t)(kpos0 + r) * INW + 16 * s + 8 * h);
      st = MFMA32(kf, qf[s], st);
    }
#pragma unroll
    for (int i = 0; i < 16; ++i) {
      const float dist = fabsf((float)((32 * half + r) - (32 * tile + crow(i, h))));
      st[i] *= SCALE * __builtin_amdgcn_exp2f(log2g * dist);
    }
    vtile_store(vr, wl, lane);
    wave_lds_fence();
    pv_accum(o, st, wl, lane);
  }
#pragma unroll
  for (int i = 0; i < 16; ++i) {
    const float mu = half_sum((o[0][i] + o[1][i]) + (o[2][i] + o[3][i])) * (1.f / 128.f);
    float d[4], qq = 0.f;
#pragma unroll
    for (int cidx = 0; cidx < 4; ++cidx) { d[cidx] = o[cidx][i] - mu; qq += d[cidx] * d[cidx]; }
    const float rr = rsqrtf(half_sum(qq) * (1.f / 128.f) + 1e-6f);
    const size_t tok = (size_t)(b * S + qpos0 + crow(i, h));
    const bf16_t* grow = proj + tok * INW + 6144 + hd * HD + r;
    bf16_t* orow = mixed + tok * D + 1024 + hd * HD + r;
#pragma unroll
    for (int cidx = 0; cidx < 4; ++cidx) {
      const float g = __uint_as_float((unsigned)grow[32 * cidx] << 16);
      const float sg = g / (1.f + __expf(-g));
      orow[32 * cidx] = (bf16_t)(pk2(d[cidx] * rr * rnw[hd * HD + 32 * cidx + r] * sg, 0.f) & 0xffffu);
    }
  }
}
constexpr int Q_STATE = NB * 8 * 16, Q_SB = NB * 8 * (S / 32), Q_QUANT = 2 * 16384 / 64, Q_TOTAL = Q_STATE + Q_SB + Q_QUANT;
__device__ __forceinline__ unsigned queue_pop(unsigned* ctr) {
  unsigned it = 0;
  if (mk_lane_id() == 0) it = __hip_atomic_fetch_add(ctr, 1u, __ATOMIC_RELAXED, __HIP_MEMORY_SCOPE_AGENT);
  return (unsigned)__builtin_amdgcn_readfirstlane((int)it);
}
__device__ __forceinline__ void p3_attn_a(const Ctx& c) {
  LAS unsigned char* wl = c.lds + c.wave * WAVE_LDS;
  const int gw = blockIdx.x * 8 + c.wave, NW = c.G * 8;
  for (int t = gw; t < Q_SB; t += NW) sb_task(c, t, wl);
  if (c.wave < 2) for (int t = blockIdx.x * 2 + c.wave; t < Q_STATE; t += c.G * 2) state_task(c, t, wl);
}
__device__ __forceinline__ void p4_attn_b(const Ctx& c) {
  LAS unsigned char* wl = c.lds + c.wave * WAVE_LDS;
  const int gw = blockIdx.x * 8 + c.wave, NW = c.G * 8;
  for (int t = gw; t < NB * 8 * 64; t += NW) retout_task(c, t, wl);
}

__device__ __forceinline__ void p5_ln1(const Ctx& c) {
  float* y1 = (float*)(c.ws + WS_Y1);
  bf16_t* x1b = (bf16_t*)(c.ws + WS_X1B);
  const float* w = c.in[5];
  const float* bb = c.in[6];
  const int lane = mk_lane_id(), gw = blockIdx.x * 8 + c.wave, NW = c.G * 8;
  for (int row = gw; row < T; row += NW) {
    float* p = y1 + (size_t)row * D;
    f32x4 v[8];
    float s = 0.f;
#pragma unroll
    for (int i = 0; i < 8; ++i) { v[i] = *(const f32x4*)(p + (i * 64 + lane) * 4); s += (v[i][0] + v[i][1]) + (v[i][2] + v[i][3]); }
    const float mu = wave_sum(s) * (1.f / D);
    float q = 0.f;
#pragma unroll
    for (int i = 0; i < 8; ++i) { const f32x4 d = v[i] - mu; q += (d[0] * d[0] + d[1] * d[1]) + (d[2] * d[2] + d[3] * d[3]); }
    const float rr = rsqrtf(wave_sum(q) * (1.f / D) + 1e-5f);
#pragma unroll
    for (int i = 0; i < 8; ++i) {
      const int col = (i * 64 + lane) * 4;
      const f32x4 wv = *(const f32x4*)(w + col), bv = *(const f32x4*)(bb + col);
      const f32x4 o = (v[i] - mu) * rr * wv + bv;
      *(f32x4*)(p + col) = o;
      uint2 pkd; pkd.x = pk2(o[0], o[1]); pkd.y = pk2(o[2], o[3]);
      *(uint2*)(x1b + (size_t)row * D + col) = pkd;
      v[i] = o;
    }
    float mx = 0.f;
#pragma unroll
    for (int i = 0; i < 8; ++i) mx = fmaxf(mx, fmaxf(fmaxf(fabsf(v[i][0]), fabsf(v[i][1])), fmaxf(fabsf(v[i][2]), fabsf(v[i][3]))));
    mx = fmaxf(wave_max(mx), 1e-30f);
    const float inv = 127.f / mx;
    unsigned* xq = (unsigned*)(c.ws + WS_X1Q + (size_t)row * D);
#pragma unroll
    for (int i = 0; i < 8; ++i) {
      unsigned w = 0;
#pragma unroll
      for (int k = 0; k < 4; ++k) { const int q = (int)rintf(v[i][k] * inv); w |= ((unsigned)q & 255u) << (8 * k); }
      xq[i * 64 + lane] = w;
    }
    if (lane == 0) ((float*)(c.ws + WS_SX))[row] = mx * (1.f / 127.f);
  }
}

__device__ __forceinline__ void p7_route_naive(const Ctx& c) {
  const bf16_t* qp = (const bf16_t*)(c.ws + WS_QP);
  const float* sk = c.in[8];
  int* eidx = (int*)(c.ws + WS_EIDX);
  float* egate = (float*)(c.ws + WS_EGATE);
  const int lane = mk_lane_id(), gw = blockIdx.x * 8 + c.wave, NW = c.G * 8;
  const float NEG = -3.0e38f;
  LAS int* ke = (LAS int*)c.lds;
  LAS float* kg = (LAS float*)(c.lds + 512);
  int* sorted_e = (int*)(c.ws + WS_SE);
  float* sorted_g = (float*)(c.ws + WS_SG);
  for (int th = gw; th < T * 8; th += NW) {
    const int t = th >> 3, h = th & 7;
    float st0 = 0.f, st1 = 0.f; int it0 = 0, it1 = 0;
#pragma unroll 1
    for (int cc = 0; cc < 2; ++cc) {
      const bf16_t* q = qp + (size_t)t * D + h * 256 + cc * 128;
      const float* k0 = sk + ((size_t)((h * 2 + cc) * NKEYS + lane)) * 128;
      const float* k1 = k0 + 64 * 128;
      float v0 = 0.f, v1 = 0.f;
      for (int d = 0; d < 128; d += 4) {
        const uint2 qq = *(const uint2*)(q + d);
        const float q0 = bflo(qq.x), q1 = bfhi(qq.x), q2 = bflo(qq.y), q3 = bfhi(qq.y);
        const float4 a = *(const float4*)(k0 + d);
        const float4 bq = *(const float4*)(k1 + d);
        v0 += q0 * a.x + q1 * a.y + q2 * a.z + q3 * a.w;
        v1 += q0 * bq.x + q1 * bq.y + q2 * bq.z + q3 * bq.w;
      }
      float mys = 0.f; int myi = 0;
      for (int it = 0; it < 16; ++it) {
        const float m = wave_max(fmaxf(v0, v1));
        int cand = 9999;
        if (v1 == m) cand = lane + 64;
        if (v0 == m) cand = lane;
        const int sel = wave_min_i(cand);
        if (sel == lane) v0 = NEG;
        if (sel == lane + 64) v1 = NEG;
        if (lane == it) { mys = m; myi = sel; }
      }
      if (cc == 0) { st0 = mys; it0 = myi; } else { st1 = mys; it1 = myi; }
    }
    float cv[4];
#pragma unroll
    for (int j = 0; j < 4; ++j) cv[j] = __shfl(st0, lane >> 2) + __shfl(st1, (lane & 3) * 4 + j);
    float mybest = 0.f; int mypos = 0;
    for (int it = 0; it < 16; ++it) {
      const float lm = fmaxf(fmaxf(cv[0], cv[1]), fmaxf(cv[2], cv[3]));
      const float m = wave_max(lm);
      int cand = 9999;
#pragma unroll
      for (int j = 3; j >= 0; --j) if (cv[j] == m) cand = lane * 4 + j;
      const int sel = wave_min_i(cand);
#pragma unroll
      for (int j = 0; j < 4; ++j) if (sel == lane * 4 + j) cv[j] = NEG;
      if (lane == it) { mybest = m; mypos = sel; }
    }
    const float mx = __shfl(mybest, 0);
    const float e = (lane < 16) ? expf(mybest - mx) : 0.f;
    const float den = wave_sum(e);
    const int ia = __shfl(it0, mypos >> 4), ib = __shfl(it1, mypos & 15);
    if (lane < 16) {
      eidx[(size_t)th * 16 + lane] = ia * NKEYS + ib;
      egate[(size_t)th * 16 + lane] = e / den;
      ke[h * 16 + lane] = ia * NKEYS + ib;
      kg[h * 16 + lane] = e / den;
    }
    __syncthreads();
    if ((c.wave * 64 + mk_lane_id()) < 128) {
      const int me = ke[(c.wave * 64 + mk_lane_id())];
      int rank = 0;
      for (int j = 0; j < 128; ++j) { const int o = ke[j]; rank += (o < me || (o == me && j < (c.wave * 64 + mk_lane_id()))) ? 1 : 0; }
      sorted_e[(size_t)t * 128 + rank] = me;
      sorted_g[(size_t)t * 128 + rank] = kg[(c.wave * 64 + mk_lane_id())];
    }
    __syncthreads();
  }
}

__device__ __forceinline__ void p8_peer_naive(const Ctx& c) {
  const float* x1 = (const float*)(c.ws + WS_Y1);
  const int* eidx = (const int*)(c.ws + WS_EIDX);
  const float* egate = (const float*)(c.ws + WS_EGATE);
  const float* eu = c.in[9];
  const float* ev = c.in[10];
  const float* w = c.in[11];
  const float* bb = c.in[12];
  LAS float* xs = (LAS float*)c.lds;
  LAS float* hh = xs + D;
  LAS int* ei = (LAS int*)(hh + 128);
  LAS float* red = (LAS float*)(ei + 128);
  const int tid = (c.wave * 64 + mk_lane_id()), lane = mk_lane_id(), wv = c.wave;
  for (int t = blockIdx.x; t < T; t += c.G) {
    *(f32x4*)(xs + tid * 4) = *(const f32x4*)(x1 + (size_t)t * D + tid * 4);
    if (tid < 128) ei[tid] = eidx[(size_t)t * 128 + tid];
    __syncthreads();
    for (int a = wv * 16; a < wv * 16 + 16; ++a) {
      const float* u = eu + (size_t)ei[a] * D;
      float s = 0.f;
#pragma unroll
      for (int i = 0; i < 8; ++i) {
        const f32x4 uv = *(const f32x4*)(u + (i * 64 + lane) * 4);
        const f32x4 xv = *(const LAS f32x4*)(xs + (i * 64 + lane) * 4);
        s += uv[0] * xv[0] + uv[1] * xv[1] + uv[2] * xv[2] + uv[3] * xv[3];
      }
      s = wave_sum(s);
      const float act = 0.5f * s * (1.f + erff(s * 0.7071067811865476f));
      if (lane == 0) hh[a] = egate[(size_t)t * 128 + a] * act;
    }
    __syncthreads();
    f32x4 acc = {0.f, 0.f, 0.f, 0.f};
    for (int a = 0; a < 128; ++a) {
      const f32x4 v = *(const f32x4*)(ev + (size_t)ei[a] * D + tid * 4);
      acc += v * hh[a];
    }
    const f32x4 y = *(const LAS f32x4*)(xs + tid * 4) * ALPHA + acc;
    float s = wave_sum((y[0] + y[1]) + (y[2] + y[3]));
    if (lane == 0) red[wv] = s;
    __syncthreads();
    float mu = 0.f;
#pragma unroll
    for (int i = 0; i < 8; ++i) mu += red[i];
    mu *= (1.f / D);
    const f32x4 d = y - mu;
    float q = wave_sum((d[0] * d[0] + d[1] * d[1]) + (d[2] * d[2] + d[3] * d[3]));
    if (lane == 0) red[8 + wv] = q;
    __syncthreads();
    float var = 0.f;
#pragma unroll
    for (int i = 0; i < 8; ++i) var += red[8 + i];
    const float rr = rsqrtf(var * (1.f / D) + 1e-5f);
    const f32x4 wv4 = *(const f32x4*)(w + tid * 4), bv = *(const f32x4*)(bb + tid * 4);
    *(f32x4*)(c.out + (size_t)t * D + tid * 4) = d * rr * wv4 + bv;
    __syncthreads();
  }
}

__device__ __forceinline__ unsigned fkey(float f) { const unsigned u = __float_as_uint(f); return (u & 0x80000000u) ? ~u : (u | 0x80000000u); }
__device__ __forceinline__ float funkey(unsigned k) { return __uint_as_float((k & 0x80000000u) ? (k & 0x7fffffffu) : ~k); }
template <int N> __device__ __forceinline__ void sort_desc(unsigned (&a)[N]) {
#pragma unroll
  for (int k = 2; k <= N; k <<= 1)
#pragma unroll
    for (int j = k >> 1; j > 0; j >>= 1)
#pragma unroll
      for (int i = 0; i < N; ++i) {
        const int l = i ^ j;
        if (l > i) {
          const unsigned x = a[i], y = a[l], mx = x > y ? x : y, mn = x > y ? y : x;
          if ((i & k) == 0) { a[i] = mx; a[l] = mn; } else { a[i] = mn; a[l] = mx; }
        }
      }
}
__device__ __forceinline__ void merge16(unsigned (&a)[16], const unsigned (&b)[16]) {
#pragma unroll
  for (int i = 0; i < 16; ++i) { const unsigned y = b[15 - i]; a[i] = a[i] > y ? a[i] : y; }
#pragma unroll
  for (int j = 8; j > 0; j >>= 1)
#pragma unroll
    for (int i = 0; i < 16; ++i) {
      const int l = i ^ j;
      if (l > i) { const unsigned x = a[i], y = a[l]; a[i] = x > y ? x : y; a[l] = x > y ? y : x; }
    }
}
__device__ __forceinline__ void top16_of_64(const unsigned (&v)[64], unsigned (&out)[16]) {
  unsigned g[4][16];
#pragma unroll
  for (int q = 0; q < 4; ++q) {
#pragma unroll
    for (int i = 0; i < 16; ++i) g[q][i] = v[16 * q + i];
    sort_desc<16>(g[q]);
  }
  merge16(g[0], g[1]); merge16(g[2], g[3]); merge16(g[0], g[2]);
#pragma unroll
  for (int i = 0; i < 16; ++i) out[i] = g[0][i];
}
constexpr int ROUTE_KE_OFF = 81920;
constexpr int ROUTE_KG_OFF = ROUTE_KE_OFF + 16384;
struct StairTab { int a[64], b[64]; };
__host__ __device__ constexpr StairTab make_stair() {
  StairTab t{}; int n = 0;
  for (int a = 0; a < 16; ++a) for (int b = 0; b < 16; ++b) if ((a + 1) * (b + 1) <= 16) { t.a[n] = a; t.b[n] = b; ++n; }
  for (; n < 64; ++n) { t.a[n] = -1; t.b[n] = -1; }
  return t;
}
__device__ __forceinline__ void p8_route(const Ctx& c) {
  const bf16_t* qp = (const bf16_t*)(c.ws + WS_QP);
  const bf16_t* skb = (const bf16_t*)(c.ws + WS_SKB);
  int* sorted_e = (int*)(c.ws + WS_SE);
  float* sorted_g = (float*)(c.ws + WS_SG);
  const int lane = mk_lane_id(), r = lane & 31, hh = lane >> 5, head = c.wave;
  LAS unsigned char* wl = c.lds + c.wave * WAVE_LDS;
  LAS int* ke = (LAS int*)(c.lds + ROUTE_KE_OFF);
  LAS float* kg = (LAS float*)(c.lds + ROUTE_KG_OFF);
  constexpr StairTab ST = make_stair();
  for (int tg = blockIdx.x; tg < T / 32; tg += c.G) {
    const int t0 = tg * 32;
    unsigned top[2][16];
#pragma unroll
    for (int cc = 0; cc < 2; ++cc) {
      bf16x8 qf[8];
#pragma unroll
      for (int s = 0; s < 8; ++s) qf[s] = *(const bf16x8*)(qp + (size_t)(t0 + r) * D + head * 256 + cc * 128 + 16 * s + 8 * hh);
      unsigned mine[16];
#pragma unroll
      for (int kt = 0; kt < 4; ++kt) {
        f32x16 sc;
#pragma unroll
        for (int i = 0; i < 16; ++i) sc[i] = 0.f;
        const bf16_t* krow_p = skb + ((size_t)((head * 2 + cc) * NKEYS + 32 * kt + r)) * 128 + 8 * hh;
#pragma unroll
        for (int s = 0; s < 8; ++s) sc = MFMA32(*(const bf16x8*)(krow_p + 16 * s), qf[s], sc);
        unsigned v[16];
#pragma unroll
        for (int i = 0; i < 16; ++i) {
          const int kidx = 32 * kt + (i & 3) + 8 * (i >> 2) + 4 * hh;
          v[i] = (fkey(sc[i]) & ~127u) | (unsigned)(127 - kidx);
        }
        sort_desc<16>(v);
        if (kt == 0) {
#pragma unroll
          for (int i = 0; i < 16; ++i) mine[i] = v[i];
        } else merge16(mine, v);
        __builtin_amdgcn_sched_barrier(0);
      }
      unsigned other[16];
#pragma unroll
      for (int i = 0; i < 16; ++i) other[i] = (unsigned)__shfl_xor((int)mine[i], 32);
      merge16(mine, other);
#pragma unroll
      for (int i = 0; i < 16; ++i) top[cc][i] = mine[i];
    }
    float f0[16], f1[16];
#pragma unroll
    for (int i = 0; i < 16; ++i) { f0[i] = funkey(top[0][i] & ~127u); f1[i] = funkey(top[1][i] & ~127u); }
    unsigned best[16];
#pragma unroll
    for (int q = 0; q < 4; ++q) {
      unsigned cv[16];
#pragma unroll
      for (int i = 0; i < 16; ++i) {
        const int n = 16 * q + i;
        if (ST.a[n] >= 0) cv[i] = (fkey(f0[ST.a[n]] + f1[ST.b[n]]) & ~255u) | (unsigned)(255 - (ST.a[n] * 16 + ST.b[n]));
        else cv[i] = 0u;
      }
      sort_desc<16>(cv);
      if (q == 0) {
#pragma unroll
        for (int i = 0; i < 16; ++i) best[i] = cv[i];
      } else merge16(best, cv);
      __builtin_amdgcn_sched_barrier(0);
    }
    LAS unsigned* tb = (LAS unsigned*)(wl + lane * 32);
#pragma unroll
    for (int w4 = 0; w4 < 4; ++w4) {
      unsigned p0 = 0, p1 = 0;
#pragma unroll
      for (int k = 0; k < 4; ++k) { p0 |= (127u - (top[0][4 * w4 + k] & 127u)) << (8 * k); p1 |= (127u - (top[1][4 * w4 + k] & 127u)) << (8 * k); }
      tb[w4] = p0; tb[4 + w4] = p1;
    }
    wave_lds_fence();
    const float mx = funkey(best[0] & ~255u);
    float ex[16], den = 0.f;
#pragma unroll
    for (int i = 0; i < 16; ++i) { ex[i] = __expf(funkey(best[i] & ~255u) - mx); den += ex[i]; }
    const float inv = 1.f / den;
#pragma unroll
    for (int i = 0; i < 8; ++i) {
      const unsigned bk = hh ? best[8 + i] : best[i];
      const float gt = (hh ? ex[8 + i] : ex[i]) * inv;
      const int pos = 255 - (int)(bk & 255u);
      const int ia = ((LAS unsigned char*)tb)[pos >> 4], ib = ((LAS unsigned char*)tb)[16 + (pos & 15)];
      ke[r * 128 + head * 16 + 8 * hh + i] = ia * NKEYS + ib;
      kg[r * 128 + head * 16 + 8 * hh + i] = gt;
    }
    __syncthreads();
    {
      const int tt = (c.wave * 64 + mk_lane_id()) >> 4, e8 = ((c.wave * 64 + mk_lane_id()) & 15) * 8;
      int me[8], rank[8];
#pragma unroll
      for (int j = 0; j < 8; ++j) { me[j] = ke[tt * 128 + e8 + j]; rank[j] = 0; }
      for (int o = 0; o < 128; ++o) {
        const int ov = ke[tt * 128 + o];
#pragma unroll
        for (int j = 0; j < 8; ++j) rank[j] += (ov < me[j] || (ov == me[j] && o < e8 + j)) ? 1 : 0;
      }
#if defined(MK_NOSORT)
#pragma unroll
      for (int j = 0; j < 8; ++j) rank[j] = e8 + j;
#endif
#pragma unroll
      for (int j = 0; j < 8; ++j) {
        sorted_e[(size_t)(t0 + tt) * 128 + rank[j]] = me[j];
        sorted_g[(size_t)(t0 + tt) * 128 + rank[j]] = kg[tt * 128 + e8 + j];
      }
    }
    __syncthreads();
  }
}

typedef __bf16 bf16x2v __attribute__((ext_vector_type(2)));
__device__ __forceinline__ float dot2bf(unsigned a, unsigned b, float acc) {
  return __builtin_amdgcn_fdot2_f32_bf16(__builtin_bit_cast(bf16x2v, a), __builtin_bit_cast(bf16x2v, b), acc, false);
}
__device__ __forceinline__ int rdlane_i(int v, int l) { return __builtin_amdgcn_readlane(v, l); }
__device__ __forceinline__ float rdlane_f(float v, int l) { return __int_as_float(__builtin_amdgcn_readlane(__float_as_int(v), l)); }
template <int CTRL> __device__ __forceinline__ int dpp_mov_i(int v) { return __builtin_amdgcn_update_dpp(0, v, CTRL, 0xf, 0xf, true); }
__device__ __forceinline__ int wave_sum_i_dpp(int v) {
  v += dpp_mov_i<0xB1>(v);
  v += dpp_mov_i<0x4E>(v);
  v += dpp_mov_i<0x141>(v);
  v += dpp_mov_i<0x140>(v);
  return __builtin_amdgcn_readlane(v, 0) + __builtin_amdgcn_readlane(v, 16) + __builtin_amdgcn_readlane(v, 32) + __builtin_amdgcn_readlane(v, 48);
}
__device__ __forceinline__ float gelu_as(float v) {
  const float av = fabsf(v), t = __builtin_amdgcn_rcpf(av * 0.2316418882f + 1.0f);
  float q = t * 0.5307027145f + (-0.7265760135f); q = q * t + 0.7107068705f; q = q * t + (-0.142248368f); q = q * t + 0.127414796f; q = q * t;
  const float e = __builtin_amdgcn_exp2f((v * v) * (-0.72134752044f));
  const float m = v * (q * e);
  return v < 0.f ? m : v - m;
}
constexpr int PEER_D1 = 8, PEER_D2 = 2;
__device__ __forceinline__ void p9_peer(const Ctx& c) {
  const unsigned char* x1q = (const unsigned char*)(c.ws + WS_X1Q);
  const float* sx = (const float*)(c.ws + WS_SX);
  const float* x1 = (const float*)(c.ws + WS_Y1);
  const int* sorted_e = (const int*)(c.ws + WS_SE);
  const float* sorted_g = (const float*)(c.ws + WS_SG);
  const unsigned char* uq = (const unsigned char*)(c.ws + WS_UQ);
  const unsigned char* vq = (const unsigned char*)(c.ws + WS_VQ);
  const float* su = (const float*)(c.ws + WS_SU);
  const float* sv = (const float*)(c.ws + WS_SV);
  const float* lw = c.in[11];
  const float* lb = c.in[12];
  const int lane = mk_lane_id(), gw = blockIdx.x * 8 + c.wave, NW = c.G * 8;
  LAS int* le = (LAS int*)(c.lds + c.wave * WAVE_LDS);
  LAS float* lsc = (LAS float*)(le + 512);
  LAS float* lg = lsc + 512;
  LAS float* lh = lg + 512;
  LAS int* lpi = (LAS int*)(lh + 512);
  for (int tb = gw * 4; tb < T; tb += NW * 4) {
    int lq = lane;
    asm volatile("" : "+v"(lq));
    u32x4 xr[4][2];
#pragma unroll
    for (int tk = 0; tk < 4; ++tk) {
      const size_t t = (size_t)(tb + tk);
      const float sxt = sx[t];
#pragma unroll
      for (int hh = 0; hh < 2; ++hh) {
        const int e = sorted_e[t * 128 + 64 * hh + lq];
        le[tk * 128 + 64 * hh + lq] = e;
        lsc[tk * 128 + 64 * hh + lq] = su[e] * sxt;
        lg[tk * 128 + 64 * hh + lq] = sorted_g[t * 128 + 64 * hh + lq] * sv[e];
      }
#pragma unroll
      for (int i = 0; i < 2; ++i) xr[tk][i] = *(const u32x4*)(x1q + t * D + 1024 * i + 16 * lq);
    }
    wave_lds_fence();
#pragma unroll 1
    for (int hf = 0; hf < 2; ++hf) {
      u32x4 rows[PEER_D1][4];
#define PEER_ISSUE1(SL, P) do { _Pragma("unroll") for (int tk_ = 0; tk_ < 4; ++tk_) \
        rows[SL][tk_] = *(const u32x4*)(uq + (size_t)__builtin_amdgcn_readfirstlane(le[tk_ * 128 + (P)]) * D + 1024 * hf + 16 * lane); } while (0)
#define PEER_CONSUME1(SL, P) do { _Pragma("unroll") for (int tk_ = 0; tk_ < 4; ++tk_) { int ia_ = 0, ib_ = 0; \
        const u32x4 xh_ = hf ? xr[tk_][1] : xr[tk_][0]; \
        ia_ = __builtin_amdgcn_sdot4((int)rows[SL][tk_][0], (int)xh_[0], ia_, false); ib_ = __builtin_amdgcn_sdot4((int)rows[SL][tk_][1], (int)xh_[1], ib_, false); \
        ia_ = __builtin_amdgcn_sdot4((int)rows[SL][tk_][2], (int)xh_[2], ia_, false); ib_ = __builtin_amdgcn_sdot4((int)rows[SL][tk_][3], (int)xh_[3], ib_, false); \
        const int part_ = wave_sum_i_dpp(ia_ + ib_); \
        if (hf == 0) { if (lane == 0) lpi[tk_ * 128 + (P)] = part_; } \
        else { const float sacc_ = (float)(part_ + lpi[tk_ * 128 + (P)]) * lsc[tk_ * 128 + (P)]; \
               if (lane == 0) lh[tk_ * 128 + (P)] = gelu_as(sacc_) * lg[tk_ * 128 + (P)]; } } } while (0)
#pragma unroll
      for (int sl = 0; sl < PEER_D1; ++sl) PEER_ISSUE1(sl, sl);
#pragma unroll 1
      for (int p0 = 0; p0 < 128 - PEER_D1; p0 += PEER_D1) {
#pragma unroll
        for (int sl = 0; sl < PEER_D1; ++sl) { PEER_CONSUME1(sl, p0 + sl); PEER_ISSUE1(sl, p0 + sl + PEER_D1); }
      }
#pragma unroll
      for (int sl = 0; sl < PEER_D1; ++sl) PEER_CONSUME1(sl, 128 - PEER_D1 + sl);
#undef PEER_ISSUE1
#undef PEER_CONSUME1
      wave_lds_fence();
    }
    wave_lds_fence();
    int lcol = 16 * lane;
    asm volatile("" : "+v"(lcol));
#pragma unroll 1
    for (int hf = 0; hf < 2; ++hf) {
      float acc[4][16], hsum[4];
#pragma unroll
      for (int tk = 0; tk < 4; ++tk) {
        hsum[tk] = 0.f;
#pragma unroll
        for (int j = 0; j < 4; ++j) {
          const f32x4 xv = *(const f32x4*)(x1 + (size_t)(tb + tk) * D + 1024 * hf + lcol + 4 * j);
#pragma unroll
          for (int k = 0; k < 4; ++k) acc[tk][4 * j + k] = ALPHA * xv[k];
        }
      }
      u32x4 rows[PEER_D2][4]; float hw[PEER_D2][4];
#define PEER_ISSUE2(SL, P) do { _Pragma("unroll") for (int tk_ = 0; tk_ < 4; ++tk_) { \
        rows[SL][tk_] = *(const u32x4*)(vq + (size_t)__builtin_amdgcn_readfirstlane(le[tk_ * 128 + (P)]) * D + 1024 * hf + 16 * lane); \
        hw[SL][tk_] = lh[tk_ * 128 + (P)]; } } while (0)
#define PEER_CONSUME2(SL) do { _Pragma("unroll") for (int tk_ = 0; tk_ < 4; ++tk_) { const float hv_ = hw[SL][tk_]; hsum[tk_] += hv_; \
        _Pragma("unroll") for (int j_ = 0; j_ < 4; ++j_) { const unsigned w_ = rows[SL][tk_][j_]; \
          acc[tk_][4 * j_ + 0] += hv_ * (float)(w_ & 255u); acc[tk_][4 * j_ + 1] += hv_ * (float)((w_ >> 8) & 255u); \
          acc[tk_][4 * j_ + 2] += hv_ * (float)((w_ >> 16) & 255u); acc[tk_][4 * j_ + 3] += hv_ * (float)(w_ >> 24); } } } while (0)
#pragma unroll
      for (int sl = 0; sl < PEER_D2; ++sl) PEER_ISSUE2(sl, sl);
#pragma unroll 1
      for (int p0 = 0; p0 < 128 - PEER_D2; p0 += PEER_D2) {
#pragma unroll
        for (int sl = 0; sl < PEER_D2; ++sl) { PEER_CONSUME2(sl); PEER_ISSUE2(sl, p0 + sl + PEER_D2); }
      }
#pragma unroll
      for (int sl = 0; sl < PEER_D2; ++sl) PEER_CONSUME2(sl);
#undef PEER_ISSUE2
#undef PEER_CONSUME2
#pragma unroll
      for (int tk = 0; tk < 4; ++tk)
#pragma unroll
        for (int j = 0; j < 4; ++j) {
          f32x4 o;
#pragma unroll
          for (int k = 0; k < 4; ++k) o[k] = acc[tk][4 * j + k] - 128.f * hsum[tk];
          *(f32x4*)(c.out + (size_t)(tb + tk) * D + 1024 * hf + lcol + 4 * j) = o;
        }
    }
    asm volatile("" : "+v"(lcol));
#pragma unroll 1
    for (int tk = 0; tk < 4; ++tk) {
      float* orow = c.out + (size_t)(tb + tk) * D + lcol;
      f32x4 y[8];
      float ssum = 0.f;
#pragma unroll
      for (int i = 0; i < 8; ++i) { y[i] = *(const f32x4*)(orow + 1024 * (i >> 2) + 4 * (i & 3)); ssum += (y[i][0] + y[i][1]) + (y[i][2] + y[i][3]); }
      const float mu = wave_sum(ssum) * (1.f / D);
      float q = 0.f;
#pragma unroll
      for (int i = 0; i < 8; ++i) { y[i] = y[i] - mu; q += (y[i][0] * y[i][0] + y[i][1] * y[i][1]) + (y[i][2] * y[i][2] + y[i][3] * y[i][3]); }
      const float rr = rsqrtf(wave_sum(q) * (1.f / D) + 1e-5f);
#pragma unroll
      for (int i = 0; i < 8; ++i) {
        const int col = 1024 * (i >> 2) + 4 * (i & 3);
        const f32x4 wv = *(const f32x4*)(lw + lcol + col), bv = *(const f32x4*)(lb + lcol + col);
        *(f32x4*)(orow + col) = y[i] * rr * wv + bv;
      }
    }
    wave_lds_fence();
  }
}

#ifndef MK_N_LAUNCHES
#define MK_N_LAUNCHES 1
#endif
constexpr int NPHASE = 9;
#ifndef MK_PROBE_PHASE
#define MK_PROBE_PHASE -1
#define MK_PROBE_REPS 1
#endif
struct Args { const float* in[13]; float* out; unsigned char* ws; int ph_lo, ph_hi; };

__global__ void __launch_bounds__(NTHR, 2) k_main(Args a) {
  extern __shared__ __attribute__((aligned(16))) unsigned char lds_raw[];
  Ctx c;
#pragma unroll
  for (int i = 0; i < 13; ++i) c.in[i] = a.in[i];
  c.out = a.out; c.ws = a.ws; c.lds = (LAS unsigned char*)lds_raw;
  c.wave = __builtin_amdgcn_readfirstlane((int)(threadIdx.x >> 6)); c.G = gridDim.x;
  volatile LAS unsigned* misc = (volatile LAS unsigned*)(c.lds + pg8::STAGE_BYTES);
  if (c.wave == 0 && mk_lane_id() < 16) misc[mk_lane_id()] = 0u;
  __syncthreads();
  const int lo = a.ph_lo, hi = a.ph_hi;
  XcdBarrier bar; bar.wave = (unsigned)c.wave; bar.bar = (unsigned*)(c.ws + WS_CTL); bar.x = 0; bar.st = misc;
  if (hi - lo > 1) bar = xcd_barrier_post((unsigned*)(c.ws + WS_CTL), misc, (unsigned)c.wave);
  bf16_t* xb = (bf16_t*)(c.ws + WS_XB);
#define IN(k) (lo <= (k) && (k) < hi)
#ifndef MK_ONLY
#define MK_ONLY -1
#endif
#define PHASE(k, ...) do { if (IN(k) && (MK_ONLY < 0 || MK_ONLY == (k))) { \
    _Pragma("unroll 1") for (int it_ = 0; it_ < (((k) == MK_PROBE_PHASE) ? MK_PROBE_REPS : 1); ++it_) { if (it_ > 0) xcd_barrier(bar); __VA_ARGS__; } \
    if (IN((k) + 1)) xcd_barrier(bar); } } while (0)
  PHASE(0, p0_prologue(c));
  PHASE(1, {
    pg8::Gemm g{xb, (const bf16_t*)(c.ws + WS_WIN), T, INW, D};
    pg8::StaticOrder so; so.init(T, INW, c.G, (int)blockIdx.x);
    pg8::EpiProjRot E{(bf16_t*)(c.ws + WS_PROJ), INW, 3072, 5120, (const float*)(c.ws + WS_ROT), (const float*)(c.ws + WS_ROT) + S * 64, S - 1};
    pg8::gemm_phase<pg8::EpiProjRot, pg8::StaticOrder, false>(c.lds, g, so, E, nullptr, c.wave); });
  PHASE(2, p3_attn_a(c));
  PHASE(3, p4_attn_b(c));
  PHASE(4, {
    pg8::Gemm g{(const bf16_t*)(c.ws + WS_MIXED), (const bf16_t*)(c.ws + WS_WOUT), T, D, D};
    pg8::StaticOrder so; so.init(T, D, c.G, (int)blockIdx.x);
    pg8::EpiResF32 E{(float*)(c.ws + WS_Y1), D, c.in[0], ALPHA};
    pg8::gemm_phase<pg8::EpiResF32, pg8::StaticOrder, false>(c.lds, g, so, E, nullptr, c.wave); });
  PHASE(5, { p5_ln1(c); for (int rr0 = (blockIdx.x * 8 + c.wave) * 16; rr0 < 2 * 16384; rr0 += c.G * 8 * 16) quant_rows(c, rr0, 16); });
  PHASE(6, {
    pg8::Gemm g{(const bf16_t*)(c.ws + WS_X1B), (const bf16_t*)(c.ws + WS_WPQ), T, D, D};
    pg8::StaticOrder so; so.init(T, D, c.G, (int)blockIdx.x);
    pg8::EpiBf16Plain E{(bf16_t*)(c.ws + WS_QP), D};
    pg8::gemm_phase<pg8::EpiBf16Plain, pg8::StaticOrder, false>(c.lds, g, so, E, nullptr, c.wave); });
  PHASE(7, p8_route(c));
  PHASE(8, p9_peer(c));
#undef PHASE
#undef IN
}
}

extern "C" void kernel_launch(void* const* d_in, const int* in_sizes, int n_in, void* d_out, int out_size, void* d_ws, size_t ws_size,
                              hipStream_t stream) {
  using namespace mk;
  static int grid = 0;
  if (grid == 0) {
    if (n_in != 13 || ws_size < WS_END) { grid = -1; return; }
    int dev = 0, cus = 0, per_cu = 0;
    if (hipGetDevice(&dev) != hipSuccess || hipDeviceGetAttribute(&cus, hipDeviceAttributeMultiprocessorCount, dev) != hipSuccess) { grid = -1; return; }
    if (hipFuncSetAttribute((const void*)k_main, hipFuncAttributeMaxDynamicSharedMemorySize, LDS_BYTES) != hipSuccess) { grid = -1; return; }
    if (hipOccupancyMaxActiveBlocksPerMultiprocessor(&per_cu, (const void*)k_main, NTHR, LDS_BYTES) != hipSuccess || per_cu < 1) { (void)hipGetLastError(); per_cu = 1; }
    grid = cus;
  }
  if (grid < 0) return;
  (void)hipMemsetAsync((char*)d_ws + WS_CTL, 0, CTL_BYTES, stream);
  Args a{};
  for (int i = 0; i < 13; ++i) a.in[i] = (const float*)d_in[i];
  a.out = (float*)d_out; a.ws = (unsigned char*)d_ws;
#if MK_N_LAUNCHES == 1
  a.ph_lo = 0; a.ph_hi = NPHASE;
  hipLaunchKernelGGL(k_main, dim3(grid), dim3(NTHR), LDS_BYTES, stream, a);
#else
  for (int p = 0; p < NPHASE; ++p) { a.ph_lo = p; a.ph_hi = p + 1; hipLaunchKernelGGL(k_main, dim3(grid), dim3(NTHR), LDS_BYTES, stream, a); }
#endif
}
```

```cpp
#include <hip/hip_runtime.h>
#include <stdint.h>
#include <math.h>
__device__ __forceinline__ int mk_lane_id() { return (int)__builtin_amdgcn_mbcnt_hi(~0u, __builtin_amdgcn_mbcnt_lo(~0u, 0u)); }
#define MK_N_LAUNCHES 1
namespace pg8 {
#define PG8_LAS __attribute__((address_space(3)))
typedef unsigned short bf16_t;
typedef short bf16x8 __attribute__((ext_vector_type(8)));
typedef float f32x4 __attribute__((ext_vector_type(4)));
typedef unsigned u32x4 __attribute__((ext_vector_type(4)));
constexpr int BM = 256, BK = 64, HALF = 128, HTB = HALF * BK * 2  , STAGE_BYTES = 8 * HTB, NXCD = 8, WGM = 8;

__host__ __device__ __forceinline__ int lds_byte(int r, int c) { const int st = (r >> 4) * 2 + (c >> 5), rr = r & 15, cc = c & 31, ob = rr * 64 + cc * 2; return st * 1024 + (ob ^ (((ob >> 9) & 1) << 5)); }
__host__ __device__ __forceinline__ void stage_rc(int b, int& R, int& C) { const int st = b / 1024, sb = b % 1024, swz = sb ^ (((sb >> 9) & 1) << 5); R = (st >> 1) * 16 + swz / 64; C = (st & 1) * 32 + (swz % 64) / 2; }
__host__ __device__ __forceinline__ int perm32(int rho) { const int n = rho >> 4, i = rho & 15; return 8 * (i >> 2) + 4 * n + (i & 3); }

struct Unit { int pm, pn; };
struct Gemm { const bf16_t* A; const bf16_t* Bt; int M, N, K; };

struct StaticOrder {
    int nM, nN, nwg, G, c;
    __host__ __device__ void init(int M, int N, int G_, int c_) { nM = M / BM; nN = N / BM; nwg = nM * nN; G = G_; c = c_; }
    __host__ __device__ bool next(int i, Unit& u) const {
        const long L = (long)i * G + c; if (L >= nwg) return false;
        int wgid = (int)L; { const int q = nwg / NXCD, r = nwg % NXCD, xcd = wgid % NXCD, off = wgid / NXCD; wgid = (xcd < r ? xcd * (q + 1) : r * (q + 1) + (xcd - r) * q) + off; }
        const int nig = WGM * nN, gid = wgid / nig, fm = gid * WGM, gsz = (nM - fm) < WGM ? (nM - fm) : WGM;
        u.pm = fm + ((wgid % nig) % gsz); u.pn = (wgid % nig) / gsz; return true;
    }
    __device__ __forceinline__ void a_ready(const Unit&) const {}
    __device__ __forceinline__ void done(const Unit&) const {}
};
typedef __bf16 bf16x2_t __attribute__((ext_vector_type(2)));
typedef float f32x2_t __attribute__((ext_vector_type(2)));
__device__ __forceinline__ unsigned pk2(float lo, float hi) { f32x2_t v = {lo, hi}; bf16x2_t r = __builtin_convertvector(v, bf16x2_t); return __builtin_bit_cast(unsigned, r); }
struct EpiBf16Plain {
    static constexpr bool PERM = true, AFTER_DRAIN = false;
    bf16_t* O; int ldc;
    __device__ __forceinline__ void operator()(const f32x4 (&acc)[2][2][4][2], const Unit& u, int wr, int wc, int fr, int fq) const {
        const int row0 = u.pm * BM + wr * 64 + fr, col0 = u.pn * BM + wc * 32 + 8 * fq;
#pragma unroll
        for (int ai = 0; ai < 2; ++ai)
#pragma unroll
            for (int m = 0; m < 4; ++m) { bf16_t* rowp = O + (size_t)(row0 + ai * HALF + m * 16) * ldc + col0;
#pragma unroll
                for (int bj = 0; bj < 2; ++bj) { const f32x4 v0 = acc[ai][bj][m][0], v1 = acc[ai][bj][m][1];
                    u32x4 w; w.x = pk2(v0[0], v0[1]); w.y = pk2(v0[2], v0[3]); w.z = pk2(v1[0], v1[1]); w.w = pk2(v1[2], v1[3]);
                    *(u32x4*)(rowp + bj * HALF) = w; } }
    }
};
struct EpiResF32 {
    static constexpr bool PERM = false, AFTER_DRAIN = false;
    float* C; int ldc; const float* base; float alpha;
    __device__ __forceinline__ void operator()(const f32x4 (&acc)[2][2][4][2], const Unit& u, int wr, int wc, int fr, int fq) const {
        const int row0 = u.pm * BM + wr * 64 + fr, col0 = u.pn * BM + wc * 32 + 4 * fq;
#pragma unroll
        for (int ai = 0; ai < 2; ++ai)
#pragma unroll
            for (int m = 0; m < 4; ++m) { const size_t ro = (size_t)(row0 + ai * HALF + m * 16) * ldc + col0;
#pragma unroll
                for (int bj = 0; bj < 2; ++bj)
#pragma unroll
                    for (int n = 0; n < 2; ++n) { const f32x4 b = *(const f32x4*)(base + ro + bj * HALF + n * 16);
                        *(f32x4*)(C + ro + bj * HALF + n * 16) = acc[ai][bj][m][n] + b * alpha; } }
    }
};
struct EpiProjRot {
    static constexpr bool PERM = true, AFTER_DRAIN = false;
    bf16_t* O; int ldc; int rot_lo, rot_hi; const float* cs; const float* sn; int seq_mask;
    __device__ __forceinline__ void operator()(const f32x4 (&acc)[2][2][4][2], const Unit& u, int wr, int wc, int fr, int fq) const {
        const int row0 = u.pm * BM + wr * 64 + fr, colt = u.pn * BM, col0 = colt + wc * 32 + 8 * fq;
        const bool rot = (colt >= rot_lo) && (colt < rot_hi);
#pragma unroll
        for (int ai = 0; ai < 2; ++ai)
#pragma unroll
            for (int m = 0; m < 4; ++m) { const int row = row0 + ai * HALF + m * 16; bf16_t* rowp = O + (size_t)row * ldc;
#pragma unroll
                for (int bj = 0; bj < 2; ++bj) { const f32x4 v0 = acc[ai][bj][m][0], v1 = acc[ai][bj][m][1];
                    if (!rot) { u32x4 w; w.x = pk2(v0[0], v0[1]); w.y = pk2(v0[2], v0[3]); w.z = pk2(v1[0], v1[1]); w.w = pk2(v1[2], v1[3]);
                        *(u32x4*)(rowp + col0 + bj * HALF) = w; }
                    else { const int d0 = 16 * wc + 4 * fq;
                        const f32x4 c4 = *(const f32x4*)(cs + (size_t)(row & seq_mask) * 64 + d0), s4 = *(const f32x4*)(sn + (size_t)(row & seq_mask) * 64 + d0);
                        const f32x4 lo = v0 * c4 - v1 * s4, hi = v1 * c4 + v0 * s4;
                        uint2 wl, wh; wl.x = pk2(lo[0], lo[1]); wl.y = pk2(lo[2], lo[3]); wh.x = pk2(hi[0], hi[1]); wh.y = pk2(hi[2], hi[3]);
                        bf16_t* hp = rowp + colt + bj * HALF + d0;
                        *(uint2*)hp = wl; *(uint2*)(hp + 64) = wh; } } }
    }
};

template <class Epi, class Sched, bool STAMP = false>
__device__ __forceinline__ void gemm_phase(PG8_LAS unsigned char* lds, const Gemm g, const Sched& S, const Epi& E, unsigned long long* stamps, const int wid) {
    const int lane = mk_lane_id(), tid = wid * 64 + lane, wr = wid >> 2, wc = wid & 3, fr = lane & 15, fq = lane >> 4;
    const int K = g.K, nt = K / BK;
    int ts_lo = 0, ts_hi = 0, nts = 0; const unsigned long long rt_entry = STAMP ? (unsigned long long)wall_clock64() : 0ull;
#define PG8_STAMP() do { if (STAMP && wid == 0 && nts < 64) { const unsigned long long _c = (unsigned long long)clock64(); \
        ts_lo = (lane == nts) ? (int)(unsigned)_c : ts_lo; ts_hi = (lane == nts) ? (int)(unsigned)(_c >> 32) : ts_hi; ++nts; } } while (0)
    PG8_STAMP();
    unsigned voffA[2], voffB[2];
#pragma unroll
    for (int i = 0; i < 2; ++i) { int R, C; stage_rc(tid * 16 + i * 8192, R, C); const int Rb = Epi::PERM ? ((R & ~31) + perm32(R & 31)) : R;
        voffA[i] = (unsigned)(R * K + C) * 2u; voffB[i] = (unsigned)(Rb * K + C) * 2u; }
    const size_t kstep = (size_t)(BK * 2);
    const size_t hstep = (size_t)HALF * K * 2;
    const size_t tstep = 2 * hstep;
    const unsigned ldsw = (unsigned)wid * 1024u;
    const int aoff = lds_byte(wr * 64 + fr, fq * 8), boff = lds_byte(wc * 32 + fr, fq * 8);
#define PG8_SA(b, h) (((b) * 2 + (h)) * HTB)
#define PG8_SB(b, h) ((4 + (b) * 2 + (h)) * HTB)
#define PG8_STAGE(bufoff, gbase, voff) do { _Pragma("unroll") for (int _i = 0; _i < 2; ++_i) \
        __builtin_amdgcn_global_load_lds((const unsigned*)((const char*)(gbase) + (voff)[_i]), (PG8_LAS unsigned*)(lds + (bufoff) + ldsw + _i * 8192), 16, 0, 0); } while (0)
#define PG8_LDA(dst, b, h) do { _Pragma("unroll") for (int m = 0; m < 4; ++m) _Pragma("unroll") for (int k = 0; k < 2; ++k) dst[m][k] = *(const PG8_LAS bf16x8*)(lds + PG8_SA(b, h) + aoff + m * 2048 + k * 1024); } while (0)
#define PG8_LDB(dst, b, h) do { _Pragma("unroll") for (int n = 0; n < 2; ++n) _Pragma("unroll") for (int k = 0; k < 2; ++k) dst[n][k] = *(const PG8_LAS bf16x8*)(lds + PG8_SB(b, h) + boff + n * 2048 + k * 1024); } while (0)
#define PG8_MMA(ai, bj, At, Bt) do { __builtin_amdgcn_s_setprio(1); _Pragma("unroll") for (int m = 0; m < 4; ++m) _Pragma("unroll") for (int n = 0; n < 2; ++n) _Pragma("unroll") for (int k = 0; k < 2; ++k) \
        acc[ai][bj][m][n] = __builtin_amdgcn_mfma_f32_16x16x32_bf16(Bt[n][k], At[m][k], acc[ai][bj][m][n], 0, 0, 0); __builtin_amdgcn_s_setprio(0); } while (0)
#define PG8_WAIT_V(n) asm volatile("s_waitcnt vmcnt(" #n ")" ::: "memory")
#define PG8_WAIT_L(n) asm volatile("s_waitcnt lgkmcnt(" #n ")" ::: "memory")
#define PG8_BAR __builtin_amdgcn_s_barrier()
#define PG8_SCHED __builtin_amdgcn_sched_barrier(0)
    Unit cur, nxt; int ui = 0;
    if (!S.next(0, cur)) return;
    f32x4 acc[2][2][4][2];
#pragma unroll
    for (int a = 0; a < 2; ++a)
#pragma unroll
        for (int b = 0; b < 2; ++b)
#pragma unroll
            for (int m = 0; m < 4; ++m)
#pragma unroll
                for (int n = 0; n < 2; ++n) acc[a][b][m][n] = (f32x4){0.f, 0.f, 0.f, 0.f};
    bf16x8 At[4][2], B0[2][2], B1[2][2];
    const char* cA = (const char*)g.A + (size_t)cur.pm * tstep; const char* cB = (const char*)g.Bt + (size_t)cur.pn * tstep;
    S.a_ready(cur);
    PG8_STAGE(PG8_SB(0, 0), cB, voffB); PG8_STAGE(PG8_SA(0, 0), cA, voffA); PG8_STAGE(PG8_SB(0, 1), cB + hstep, voffB); PG8_STAGE(PG8_SA(0, 1), cA + hstep, voffA);
    if (wr == 1) PG8_BAR;
    PG8_WAIT_V(4); PG8_BAR;
    PG8_STAGE(PG8_SB(1, 0), cB + kstep, voffB); PG8_STAGE(PG8_SA(1, 0), cA + kstep, voffA); PG8_STAGE(PG8_SB(1, 1), cB + hstep + kstep, voffB);
    PG8_WAIT_V(6); PG8_BAR;
    PG8_STAMP();
    for (;;) {
        const bool has_next = S.next(ui + 1, nxt);
        const char* nA = has_next ? (const char*)g.A + (size_t)nxt.pm * tstep : cA; const char* nB = has_next ? (const char*)g.Bt + (size_t)nxt.pn * tstep : cB;
        for (int t = 0; t < nt; t += 2) {
            const bool last = (t == nt - 2);
            const char* a1 = cA + (size_t)(t + 1) * kstep;
            const char* a2 = last ? nA : cA + (size_t)(t + 2) * kstep; const char* b2 = last ? nB : cB + (size_t)(t + 2) * kstep;
            const char* a3 = a2 + kstep; const char* b3 = b2 + kstep;
            if (last && has_next) S.a_ready(nxt);
            PG8_LDB(B0, 0, 0); PG8_SCHED; PG8_LDA(At, 0, 0); PG8_STAGE(PG8_SA(1, 1), a1 + hstep, voffA);
            PG8_WAIT_L(8); PG8_BAR; PG8_WAIT_L(0); PG8_MMA(0, 0, At, B0); PG8_BAR; PG8_SCHED;
            PG8_LDB(B1, 0, 1); PG8_STAGE(PG8_SB(0, 0), b2, voffB);
            PG8_BAR; PG8_WAIT_L(0); PG8_MMA(0, 1, At, B1); PG8_BAR;
            PG8_LDA(At, 0, 1); PG8_STAGE(PG8_SA(0, 0), a2, voffA);
            PG8_BAR; PG8_WAIT_L(0); PG8_MMA(1, 0, At, B0); PG8_BAR; PG8_SCHED;
            PG8_STAGE(PG8_SB(0, 1), b2 + hstep, voffB);
            PG8_WAIT_V(6); PG8_BAR; PG8_MMA(1, 1, At, B1); PG8_BAR;
            PG8_LDB(B0, 1, 0); PG8_SCHED; PG8_LDA(At, 1, 0); PG8_STAGE(PG8_SA(0, 1), a2 + hstep, voffA);
            PG8_WAIT_L(8); PG8_BAR; PG8_WAIT_L(0); PG8_MMA(0, 0, At, B0); PG8_BAR; PG8_SCHED;
            PG8_LDB(B1, 1, 1); PG8_STAGE(PG8_SB(1, 0), b3, voffB);
            PG8_BAR; PG8_WAIT_L(0); PG8_MMA(0, 1, At, B1); PG8_BAR;
            PG8_LDA(At, 1, 1); PG8_STAGE(PG8_SA(1, 0), a3, voffA);
            PG8_BAR; PG8_WAIT_L(0); PG8_MMA(1, 0, At, B0); PG8_BAR; PG8_SCHED;
            PG8_STAGE(PG8_SB(1, 1), b3 + hstep, voffB);
            PG8_WAIT_V(6); PG8_BAR; PG8_MMA(1, 1, At, B1); PG8_BAR;
        }
        PG8_STAMP();
        if constexpr (!Epi::AFTER_DRAIN) { E(acc, cur, wr, wc, fr, fq); S.done(cur); }
        PG8_STAMP();
        if (!has_next) break;
#pragma unroll
        for (int a = 0; a < 2; ++a)
#pragma unroll
            for (int b = 0; b < 2; ++b)
#pragma unroll
                for (int m = 0; m < 4; ++m)
#pragma unroll
                    for (int n = 0; n < 2; ++n) acc[a][b][m][n] = (f32x4){0.f, 0.f, 0.f, 0.f};
        cur = nxt; cA = nA; cB = nB; ++ui;
    }
    PG8_WAIT_V(0);
    if (wr == 0) PG8_BAR;
    PG8_BAR;
    if constexpr (Epi::AFTER_DRAIN) { E.fused(acc, cur, wr, wc, fr, fq, lds, wid, lane); S.done(cur); }
    PG8_STAMP();
    if (STAMP && wid == 0) { stamps[lane] = lane < nts ? (((unsigned long long)(unsigned)ts_hi << 32) | (unsigned)ts_lo) : 0ull;
        if (lane == 62) stamps[62] = rt_entry; if (lane == 63) stamps[63] = (unsigned long long)wall_clock64(); }
#undef PG8_STAMP
#undef PG8_SA
#undef PG8_SB
#undef PG8_STAGE
#undef PG8_LDA
#undef PG8_LDB
#undef PG8_MMA
#undef PG8_WAIT_V
#undef PG8_WAIT_L
#undef PG8_BAR
#undef PG8_SCHED
}
}
#define XB_TMO      128
#define XB_XCNT(j)  (256  + 64 * (j))
#define XB_XSUB(j)  (1280 + 64 * (j))
#define XB_XGEN(j)  (2304 + 64 * (j))
#define XB_TOP      3328
#define XB_TOPGEN   3392
#define XCD_BAR_WORDS 3456
#define XB_SPIN_CAP (1u << 18)
#define LAS __attribute__((address_space(3)))

__device__ __forceinline__ unsigned xb_ld(unsigned* p)              { return __hip_atomic_load(p, __ATOMIC_RELAXED, __HIP_MEMORY_SCOPE_AGENT); }
__device__ __forceinline__ unsigned xb_add(unsigned* p, unsigned v) { return __hip_atomic_fetch_add(p, v, __ATOMIC_RELAXED, __HIP_MEMORY_SCOPE_AGENT); }
__device__ __forceinline__ unsigned xb_xcc_id() { return (unsigned)__builtin_amdgcn_s_getreg((3 << 11) | 20) & 0xFu; }
#define XB_SPIN(cond, bar) do { unsigned _sp = 0; while (cond) { __builtin_amdgcn_s_sleep(1); \
    if ((++_sp & 255u) == 0u) { if (xb_ld(&(bar)[XB_TMO])) break; if (_sp > XB_SPIN_CAP) { atomicAdd(&(bar)[XB_TMO], 1u); break; } } } } while (0)

struct XcdBarrier {
    unsigned wave;
    unsigned* bar; unsigned x;
    volatile LAS unsigned* st;
};

__device__ __forceinline__ XcdBarrier xcd_barrier_post(unsigned* bar, volatile LAS unsigned* st, unsigned wave) {
    XcdBarrier b; b.wave = wave; b.bar = bar; b.x = xb_xcc_id(); b.st = st;
    if (wave == 0u && mk_lane_id() == 0) (void)xb_add(&bar[XB_XCNT(b.x)], 1u);
    return b;
}
__device__ __forceinline__ void xcd_barrier_complete(unsigned* bar, unsigned x, unsigned& nloc, unsigned& nx) {
    const unsigned G = gridDim.x * gridDim.y * gridDim.z;
    unsigned sum, cnt, mine, sp = 0u;
    for (;;) {
        sum = 0u; cnt = 0u; mine = 0u;
#pragma unroll
        for (unsigned j = 0; j < 16; ++j) { const unsigned c = xb_ld(&bar[XB_XCNT(j)]); sum += c; cnt += (c > 0u) ? 1u : 0u; mine = (j == x) ? c : mine; }
        if (sum == G) break;
        __builtin_amdgcn_s_sleep(1);
        if ((++sp & 255u) == 0u) { if (xb_ld(&bar[XB_TMO])) break; if (sp > XB_SPIN_CAP) { atomicAdd(&bar[XB_TMO], 1u); break; } }
    }
    nloc = mine > 0u ? mine : 1u; nx = cnt > 0u ? cnt : 1u;
}

__device__ __forceinline__ void xcd_barrier(const XcdBarrier& b) {
    asm volatile("s_waitcnt vmcnt(0)" ::: "memory");
    __syncthreads();
    if (b.wave == 0u && mk_lane_id() == 0) {
        unsigned* bar = b.bar;
        __builtin_amdgcn_s_waitcnt(0);
        unsigned nloc = b.st[0], nx = b.st[1];
        if (nloc == 0u) { xcd_barrier_complete(bar, b.x, nloc, nx); b.st[0] = nloc; b.st[1] = nx; }
        const unsigned old = xb_add(&bar[XB_XSUB(b.x)], 1u);
        const unsigned gen = old / nloc;
        if (old + 1u == (gen + 1u) * nloc) {
            __builtin_amdgcn_fence(__ATOMIC_RELEASE, "agent");
            asm volatile("s_waitcnt vmcnt(0)" ::: "memory");
            const unsigned og = xb_add(&bar[XB_TOP], 1u);
            const unsigned tg = og / nx;
            if (og + 1u == (tg + 1u) * nx) xb_add(&bar[XB_TOPGEN], 1u);
            else XB_SPIN(xb_ld(&bar[XB_TOPGEN]) == tg, bar);
            __builtin_amdgcn_fence(__ATOMIC_ACQUIRE, "agent");
            xb_add(&bar[XB_XGEN(b.x)], 1u);
            asm volatile("s_waitcnt vmcnt(0)" ::: "memory");
        } else {
            XB_SPIN(xb_ld(&bar[XB_XGEN(b.x)]) == gen, bar);
            __builtin_amdgcn_fence(__ATOMIC_ACQUIRE, "agent");
            asm volatile("s_waitcnt vmcnt(0)" ::: "memory");
        }
    }
    __syncthreads();
}
namespace mk {
typedef unsigned short bf16_t;
typedef float f32x4 __attribute__((ext_vector_type(4)));
using pg8::pk2;
constexpr int D = 2048, NB = 4, S = 2048, T = NB * S, HD = 128, INW = 7168;
constexpr int NKEYS = 128;
constexpr float ALPHA = 1.189207115002721f;
constexpr int NTHR = 512;
constexpr size_t MiB = (size_t)1 << 20;
constexpr size_t WS_CTL = 0;
constexpr size_t CTL_BYTES = 64 * 1024;
constexpr size_t WS_XB = 1 * MiB;
constexpr size_t WS_WIN = 33 * MiB;
constexpr size_t WS_WOUT = 61 * MiB;
constexpr size_t WS_WPQ = 69 * MiB;
constexpr size_t WS_SKB = 77 * MiB;
constexpr size_t WS_ROT = 78 * MiB;
constexpr size_t WS_PROJ = 80 * MiB;
constexpr size_t WS_MIXED = 192 * MiB;
constexpr size_t WS_Y1 = 224 * MiB;
constexpr size_t WS_X1B = 288 * MiB;
constexpr size_t WS_QP = 320 * MiB;
constexpr size_t WS_EIDX = 352 * MiB;
constexpr size_t WS_EGATE = 356 * MiB;
constexpr size_t WS_PREV = 360 * MiB;
constexpr size_t WS_SE = 392 * MiB;
constexpr size_t WS_SG = 396 * MiB;
constexpr size_t WS_UQ = 417 * MiB;
constexpr size_t WS_VQ = 449 * MiB;
constexpr size_t WS_SU = 400 * MiB;
constexpr size_t WS_SV = 400 * MiB + 65536;
constexpr size_t WS_SX = 400 * MiB + 131072;
constexpr size_t WS_X1Q = 401 * MiB;
constexpr size_t WS_END = 481 * MiB;
constexpr size_t CTL_QUEUE = 32768;
constexpr int LDS_MISC = 2048;
constexpr int LDS_BYTES = pg8::STAGE_BYTES + LDS_MISC;

__device__ __forceinline__ float bflo(unsigned u) { return __uint_as_float(u << 16); }
__device__ __forceinline__ float bfhi(unsigned u) { return __uint_as_float(u & 0xffff0000u); }
__device__ __forceinline__ float wave_sum(float v) {
#pragma unroll
  for (int o = 32; o > 0; o >>= 1) v += __shfl_xor(v, o);
  return v;
}
__device__ __forceinline__ float wave_max(float v) {
#pragma unroll
  for (int o = 32; o > 0; o >>= 1) v = fmaxf(v, __shfl_xor(v, o));
  return v;
}
__device__ __forceinline__ int wave_min_i(int v) {
#pragma unroll
  for (int o = 32; o > 0; o >>= 1) v = min(v, __shfl_xor(v, o));
  return v;
}

struct Ctx {
  const float* in[13];
  float* out;
  unsigned char* ws;
  LAS unsigned char* lds;
  int wave, G;
};

__device__ __forceinline__ void transpose_bf16(const Ctx& c, const float* __restrict__ w, bf16_t* __restrict__ wt, int K, int N, int rot_lo = 0, int rot_hi = 0) {
  LAS float* tile = (LAS float*)c.lds;
  const int ntk = K / 64, ntiles = ntk * (N / 64);
  for (int tile_i = blockIdx.x; tile_i < ntiles; tile_i += c.G) {
    const int k0 = (tile_i % ntk) * 64, n0 = (tile_i / ntk) * 64;
    {
      const int r = (c.wave * 64 + mk_lane_id()) >> 3, c8 = ((c.wave * 64 + mk_lane_id()) & 7) * 8;
      const float4 a = *(const float4*)(w + (size_t)(k0 + r) * N + n0 + c8);
      const float4 b = *(const float4*)(w + (size_t)(k0 + r) * N + n0 + c8 + 4);
      LAS float* p = tile + r * 65 + c8;
      p[0] = a.x; p[1] = a.y; p[2] = a.z; p[3] = a.w; p[4] = b.x; p[5] = b.y; p[6] = b.z; p[7] = b.w;
    }
    __syncthreads();
    {
      const int n = (c.wave * 64 + mk_lane_id()) >> 3, k8 = ((c.wave * 64 + mk_lane_id()) & 7) * 8;
      float v[8];
#pragma unroll
      for (int j = 0; j < 8; ++j) v[j] = tile[(k8 + j) * 65 + n];
      uint4 o; o.x = pk2(v[0], v[1]); o.y = pk2(v[2], v[3]); o.z = pk2(v[4], v[5]); o.w = pk2(v[6], v[7]);
      int nrow = n0 + n;
      if (nrow >= rot_lo && nrow < rot_hi) { const int d = nrow & 127; nrow = (nrow & ~127) + 8 * ((d & 63) >> 2) + (d & 3) + 4 * (d >> 6); }
      *(uint4*)(wt + (size_t)nrow * K + k0 + k8) = o;
    }
    __syncthreads();
  }
}
__device__ __forceinline__ void p0_prologue(const Ctx& c) {
  const size_t gtid = (size_t)blockIdx.x * NTHR + (c.wave * 64 + mk_lane_id()), gstride = (size_t)c.G * NTHR;
  {
    const float4* x4 = (const float4*)c.in[0];
    uint4* xb4 = (uint4*)(c.ws + WS_XB);
    for (size_t i = gtid; i < (size_t)T * D / 8; i += gstride) {
      const float4 a = x4[2 * i], b = x4[2 * i + 1];
      uint4 o; o.x = pk2(a.x, a.y); o.y = pk2(a.z, a.w); o.z = pk2(b.x, b.y); o.w = pk2(b.z, b.w);
      xb4[i] = o;
    }
  }
  transpose_bf16(c, c.in[1], (bf16_t*)(c.ws + WS_WIN), D, INW, 3072, 5120);
  transpose_bf16(c, c.in[4], (bf16_t*)(c.ws + WS_WOUT), D, D);
  transpose_bf16(c, c.in[7], (bf16_t*)(c.ws + WS_WPQ), D, D);
  {
    const float4* s4 = (const float4*)c.in[8];
    uint4* d4 = (uint4*)(c.ws + WS_SKB);
    for (size_t i = gtid; i < (size_t)8 * 2 * 128 * 128 / 8; i += gstride) {
      const float4 a = s4[2 * i], b = s4[2 * i + 1];
      uint4 o; o.x = pk2(a.x, a.y); o.y = pk2(a.z, a.w); o.z = pk2(b.x, b.y); o.w = pk2(b.z, b.w);
      d4[i] = o;
    }
  }
  {
    float* cs = (float*)(c.ws + WS_ROT);
    float* sn = cs + S * 64;
    for (size_t i = gtid; i < (size_t)S * 64; i += gstride) {
      const int s = (int)(i >> 6), f = (int)(i & 63);
      const float inv_freq = (float)pow(10000.0, -(2.0 * f) / 128.0);
      const float ang = (float)s * inv_freq;
      cs[i] = (float)cos((double)ang);
      sn[i] = (float)sin((double)ang);
    }
  }
}

__device__ __forceinline__ void p2_rotate(const Ctx& c) {
  bf16_t* proj = (bf16_t*)(c.ws + WS_PROJ);
  const float* cs = (const float*)(c.ws + WS_ROT);
  const float* sn = cs + S * 64;
  const size_t gtid = (size_t)blockIdx.x * NTHR + (c.wave * 64 + mk_lane_id()), gstride = (size_t)c.G * NTHR;
  for (size_t it = gtid; it < (size_t)T * 128; it += gstride) {
    const int row = (int)(it >> 7), rem = (int)(it & 127);
    const int which = rem >> 6, h = (rem >> 3) & 7, i0 = (rem & 7) * 8;
    const int s = row & (S - 1);
    bf16_t* p = proj + (size_t)row * INW + 3072 + which * 1024 + h * HD + i0;
    const uint4 lo = *(const uint4*)p, hi = *(const uint4*)(p + 64);
    const float4 c0 = *(const float4*)(cs + s * 64 + i0), c1 = *(const float4*)(cs + s * 64 + i0 + 4);
    const float4 s0 = *(const float4*)(sn + s * 64 + i0), s1 = *(const float4*)(sn + s * 64 + i0 + 4);
    const float cv[8] = {c0.x, c0.y, c0.z, c0.w, c1.x, c1.y, c1.z, c1.w};
    const float sv[8] = {s0.x, s0.y, s0.z, s0.w, s1.x, s1.y, s1.z, s1.w};
    const unsigned lw[4] = {lo.x, lo.y, lo.z, lo.w}, hw[4] = {hi.x, hi.y, hi.z, hi.w};
    unsigned ol[4], oh[4];
#pragma unroll
    for (int j = 0; j < 4; ++j) {
      const float l0 = bflo(lw[j]), l1 = bfhi(lw[j]), h0 = bflo(hw[j]), h1 = bfhi(hw[j]);
      const float nl0 = l0 * cv[2 * j] - h0 * sv[2 * j], nl1 = l1 * cv[2 * j + 1] - h1 * sv[2 * j + 1];
      const float nh0 = h0 * cv[2 * j] + l0 * sv[2 * j], nh1 = h1 * cv[2 * j + 1] + l1 * sv[2 * j + 1];
      ol[j] = pk2(nl0, nl1); oh[j] = pk2(nh0, nh1);
    }
    uint4 a; a.x = ol[0]; a.y = ol[1]; a.z = ol[2]; a.w = ol[3];
    uint4 b; b.x = oh[0]; b.y = oh[1]; b.z = oh[2]; b.w = oh[3];
    *(uint4*)p = a; *(uint4*)(p + 64) = b;
  }
}

__device__ __forceinline__ void quant_rows(const Ctx& c, int rr0, int nrows) {
  const int lane = mk_lane_id();
  const int rend = rr0 + nrows;
  f32x4 va[8], vb[8];
#define QR_LOAD(V, RR) do { const int rr_ = (RR) < rend ? (RR) : rend - 1; const float* src_ = ((rr_ >> 14) ? c.in[10] : c.in[9]) + (size_t)(rr_ & 16383) * D; \
    _Pragma("unroll") for (int i_ = 0; i_ < 8; ++i_) V[i_] = *(const f32x4*)(src_ + (i_ * 64 + lane) * 4); } while (0)
#define QR_DO(V, RR) do { if ((RR) < rend) { const int which_ = (RR) >> 14, row_ = (RR) & 16383; float mx_ = 0.f; \
    _Pragma("unroll") for (int i_ = 0; i_ < 8; ++i_) mx_ = fmaxf(mx_, fmaxf(fmaxf(fabsf(V[i_][0]), fabsf(V[i_][1])), fmaxf(fabsf(V[i_][2]), fabsf(V[i_][3])))); \
    mx_ = fmaxf(wave_max(mx_), 1e-30f); const float inv_ = 127.f / mx_; const int off_ = which_ ? 128 : 0; \
    unsigned* dst_ = (unsigned*)(c.ws + (which_ ? WS_VQ : WS_UQ) + (size_t)row_ * D); \
    _Pragma("unroll") for (int i_ = 0; i_ < 8; ++i_) { unsigned w_ = 0; \
      _Pragma("unroll") for (int k_ = 0; k_ < 4; ++k_) { const int q_ = (int)rintf(V[i_][k_] * inv_) + off_; w_ |= ((unsigned)q_ & 255u) << (8 * k_); } \
      dst_[i_ * 64 + lane] = w_; } \
    if (lane == 0) ((float*)(c.ws + (which_ ? WS_SV : WS_SU)))[row_] = mx_ * (1.f / 127.f); } } while (0)
  QR_LOAD(va, rr0); QR_LOAD(vb, rr0 + 1);
  for (int rr = rr0; rr < rend; rr += 2) {
    QR_DO(va, rr); QR_LOAD(va, rr + 2);
    QR_DO(vb, rr + 1); QR_LOAD(vb, rr + 3);
  }
#undef QR_LOAD
#undef QR_DO
}

__device__ __forceinline__ void p3_attn_naive(const Ctx& c) {
  const bf16_t* proj = (const bf16_t*)(c.ws + WS_PROJ);
  bf16_t* mixed = (bf16_t*)(c.ws + WS_MIXED);
  const float* sbw = c.in[2];
  const float* rnw = c.in[3];
  const int lane = mk_lane_id(), gw = blockIdx.x * 8 + c.wave, NW = c.G * 8;
  const float scale = 0.08838834764831845f;
  for (int r = gw; r < NB * 8 * S; r += NW) {
    const int bh = r >> 11, t = r & (S - 1), b = bh >> 3, h = bh & 7;
    const bf16_t* base = proj + (size_t)b * S * INW + h * HD + lane * 2;
    const unsigned qw = *(const unsigned*)(base + (size_t)t * INW);
    const float qx = bflo(qw), qy = bfhi(qw);
    float ox = 0.f, oy = 0.f, run = 0.f;
    for (int s = t - 1; s >= 0; --s) {
      const unsigned kw = *(const unsigned*)(base + (size_t)s * INW + 1024);
      const unsigned vw = *(const unsigned*)(base + (size_t)s * INW + 2048);
      const float z = wave_sum(qx * bflo(kw) + qy * bfhi(kw)) * scale;
      const float l1p = log1pf(expf(-fabsf(z)));
      const float sp = fmaxf(z, 0.f) + l1p;
      const float ls = fminf(z, 0.f) - l1p;
      const float a = expf(ls - run);
      ox += a * bflo(vw); oy += a * bfhi(vw);
      run += sp;
      if (run > 104.f) break;
    }
    const float ms = wave_sum(ox * ox + oy * oy) * (1.f / 128.f);
    const float rr = rsqrtf(ms + 1e-6f);
    const float2 wv = *(const float2*)(sbw + h * HD + lane * 2);
    *(unsigned*)(mixed + (size_t)(b * S + t) * D + h * HD + lane * 2) = pk2(ox * rr * wv.x, oy * rr * wv.y);
  }
  for (int r = gw; r < NB * 8 * S; r += NW) {
    const int bh = r >> 11, tt = r & (S - 1), b = bh >> 3, h = bh & 7;
    const int t = (bh & 1) ? (S - 1 - tt) : tt;
    const bf16_t* base = proj + (size_t)b * S * INW + h * HD + lane * 2;
    const unsigned qw = *(const unsigned*)(base + (size_t)t * INW + 3072);
    const float qx = bflo(qw), qy = bfhi(qw);
    const float log_g = log1pf(-exp2f(-5.f - (float)h));
    const int s_end = ((t >> 6) + 1) << 6;
    float ox = 0.f, oy = 0.f;
    for (int s = 0; s < s_end; ++s) {
      const unsigned kw = *(const unsigned*)(base + (size_t)s * INW + 4096);
      const unsigned vw = *(const unsigned*)(base + (size_t)s * INW + 5120);
      const float dist = fabsf((float)(t - s));
      const float z = wave_sum(qx * bflo(kw) + qy * bfhi(kw)) * scale * expf(log_g * dist);
      ox += z * bflo(vw); oy += z * bfhi(vw);
    }
    const float mu = wave_sum(ox + oy) * (1.f / 128.f);
    const float dx = ox - mu, dy = oy - mu;
    const float var = wave_sum(dx * dx + dy * dy) * (1.f / 128.f);
    const float rr = rsqrtf(var + 1e-6f);
    const float2 wv = *(const float2*)(rnw + h * HD + lane * 2);
    const unsigned gwd = *(const unsigned*)(base + (size_t)t * INW + 6144);
    const float gx = bflo(gwd), gy = bfhi(gwd);
    const float sx = gx / (1.f + expf(-gx)), sy = gy / (1.f + expf(-gy));
    *(unsigned*)(mixed + (size_t)(b * S + t) * D + 1024 + h * HD + lane * 2) = pk2(dx * rr * wv.x * sx, dy * rr * wv.y * sy);
  }
}

typedef short bf16x8 __attribute__((ext_vector_type(8)));
typedef short s16x4 __attribute__((ext_vector_type(4)));
typedef float f32x16 __attribute__((ext_vector_type(16)));
typedef unsigned u32x4 __attribute__((ext_vector_type(4)));
#define MFMA32(a, b, c) __builtin_amdgcn_mfma_f32_32x32x16_bf16((a), (b), (c), 0, 0, 0)
constexpr int WAVE_LDS = 10240;
constexpr int VRS = 320;
constexpr float SCALE = 0.08838834764831845f;
constexpr float LOG2E = 1.4426950408889634f;
__device__ __forceinline__ int crow(int reg, int h) { return (reg & 3) + 8 * (reg >> 2) + 4 * h; }
__device__ __forceinline__ int krow(int s, int h, int j) { return 16 * s + 8 * (j >> 2) + 4 * h + (j & 3); }
__device__ __forceinline__ bf16x8 pack8(const f32x16& x, const int s) {
  u32x4 p;
  p[0] = pk2(x[8 * s + 0], x[8 * s + 1]); p[1] = pk2(x[8 * s + 2], x[8 * s + 3]);
  p[2] = pk2(x[8 * s + 4], x[8 * s + 5]); p[3] = pk2(x[8 * s + 6], x[8 * s + 7]);
  return __builtin_bit_cast(bf16x8, p);
}
__device__ __forceinline__ s16x4 tr16(LAS unsigned char* p) { return __builtin_amdgcn_ds_read_tr16_b64_v4i16((LAS s16x4*)p); }
__device__ __forceinline__ bf16x8 cat8(s16x4 lo, s16x4 hi) { return __builtin_shufflevector(lo, hi, 0, 1, 2, 3, 4, 5, 6, 7); }
__device__ __forceinline__ void wave_lds_fence() { asm volatile("s_waitcnt lgkmcnt(0)" ::: "memory"); }
__device__ __forceinline__ float half_sum(float v) {
#pragma unroll
  for (int o = 16; o > 0; o >>= 1) v += __shfl_xor(v, o);
  return v;
}
__device__ __forceinline__ void vtile_load(u32x4 (&vr)[8], const bf16_t* vbase, int lane) {
#pragma unroll
  for (int it = 0; it < 8; ++it) vr[it] = *(const u32x4*)(vbase + (size_t)(4 * it + (lane >> 4)) * INW + (lane & 15) * 8);
}
__device__ __forceinline__ void vtile_store(const u32x4 (&vr)[8], LAS unsigned char* wl, int lane) {
#pragma unroll
  for (int it = 0; it < 8; ++it) *(LAS u32x4*)(wl + (4 * it + (lane >> 4)) * VRS + (lane & 15) * 16) = vr[it];
}
__device__ __forceinline__ void pv_accum(f32x16 (&o)[4], const f32x16& a, LAS unsigned char* wl, int lane) {
  const int h = lane >> 5, i16 = lane & 15, q = i16 >> 2, p = i16 & 3, blk = (lane >> 4) & 1;
  const bf16x8 pa0 = pack8(a, 0), pa1 = pack8(a, 1);
  LAS unsigned char* b0 = wl + (4 * h + q) * VRS + (16 * blk + 4 * p) * 2;
#pragma unroll
  for (int cidx = 0; cidx < 4; ++cidx) {
#pragma unroll
    for (int s = 0; s < 2; ++s) {
      const s16x4 lo = tr16(b0 + (16 * s) * VRS + cidx * 64);
      const s16x4 hi = tr16(b0 + (16 * s + 8) * VRS + cidx * 64);
      o[cidx] = MFMA32(s == 0 ? pa0 : pa1, cat8(lo, hi), o[cidx]);
    }
  }
}

__device__ __forceinline__ void sb_task(const Ctx& c, int task, LAS unsigned char* wl) {
  const bf16_t* proj = (const bf16_t*)(c.ws + WS_PROJ);
  bf16_t* mixed = (bf16_t*)(c.ws + WS_MIXED);
  const float* sbw = c.in[2];
  const int lane = mk_lane_id(), r = lane & 31, h = lane >> 5;
  const int qb = task & 63, bh = task >> 6, b = bh >> 3, hd = bh & 7, q0 = qb * 32;
  const bf16_t* base = proj + (size_t)b * S * INW + hd * HD;
  bf16x8 qf[8];
#pragma unroll
  for (int s = 0; s < 8; ++s) qf[s] = *(const bf16x8*)(base + (size_t)(q0 + r) * INW + 16 * s + 8 * h);
  bf16x8 tf[2];
#pragma unroll
  for (int s = 0; s < 2; ++s)
#pragma unroll
    for (int jj = 0; jj < 8; ++jj) tf[s][jj] = (krow(s, h, jj) > r) ? (short)0x3F80 : (short)0;
  f32x16 o[4];
#pragma unroll
  for (int cidx = 0; cidx < 4; ++cidx)
#pragma unroll
    for (int i = 0; i < 16; ++i) o[cidx][i] = 0.f;
  float R = 0.f;
  const float c2 = SCALE * LOG2E;
  for (int k0 = q0; k0 >= 0; k0 -= 32) {
    u32x4 vr[8];
    vtile_load(vr, base + 2048 + (size_t)k0 * INW, lane);
    f32x16 st;
#pragma unroll
    for (int i = 0; i < 16; ++i) st[i] = 0.f;
#pragma unroll
    for (int s = 0; s < 8; ++s) {
      const bf16x8 kf = *(const bf16x8*)(base + 1024 + (size_t)(k0 + r) * INW + 16 * s + 8 * h);
      st = MFMA32(kf, qf[s], st);
    }
    const bool diag = (k0 == q0);
    f32x16 sp, m;
#pragma unroll
    for (int i = 0; i < 16; ++i) {
      const float y = st[i] * c2;
      const float e = __builtin_amdgcn_exp2f(-fabsf(y));
      const float l = __builtin_amdgcn_logf(1.f + e);
      const bool valid = !diag || (crow(i, h) < r);
      sp[i] = valid ? (fmaxf(y, 0.f) + l) : 0.f;
      st[i] = y; m[i] = R;
    }
    m = MFMA32(tf[0], pack8(sp, 0), m);
    m = MFMA32(tf[1], pack8(sp, 1), m);
    f32x16 a;
#pragma unroll
    for (int i = 0; i < 16; ++i) {
      const bool valid = !diag || (crow(i, h) < r);
      const float v = __builtin_amdgcn_exp2f(st[i] - sp[i] - m[i]);
      a[i] = valid ? v : 0.f;
    }
    R = __shfl(m[0] + sp[0], r);
    vtile_store(vr, wl, lane);
    wave_lds_fence();
    pv_accum(o, a, wl, lane);
    if (__all(R > 150.5f)) break;
  }
#pragma unroll
  for (int i = 0; i < 16; ++i) {
    const float ss = half_sum(o[0][i] * o[0][i] + o[1][i] * o[1][i] + o[2][i] * o[2][i] + o[3][i] * o[3][i]);
    const float rr = rsqrtf(ss * (1.f / 128.f) + 1e-6f);
    bf16_t* orow = mixed + (size_t)(b * S + q0 + crow(i, h)) * D + hd * HD + r;
#pragma unroll
    for (int cidx = 0; cidx < 4; ++cidx) orow[32 * cidx] = (bf16_t)(pk2(o[cidx][i] * rr * sbw[hd * HD + 32 * cidx + r], 0.f) & 0xffffu);
  }
}

__device__ __forceinline__ void state_task(const Ctx& c, int task, LAS unsigned char* wl) {
  const bf16_t* proj = (const bf16_t*)(c.ws + WS_PROJ);
  bf16_t* prevT = (bf16_t*)(c.ws + WS_PREV);
  const int lane = mk_lane_id(), r = lane & 31, h = lane >> 5;
  const int vblk = task & 3, dblk = (task >> 2) & 3, bh = task >> 4, b = bh >> 3, hd = bh & 7;
  const bf16_t* kbase = proj + (size_t)b * S * INW + 4096 + hd * HD + 32 * dblk;
  const bf16_t* vbase = proj + (size_t)b * S * INW + 5120 + hd * HD + 32 * vblk;
  const float log2g = __builtin_amdgcn_logf(1.f - exp2f(-5.f - (float)hd));
  const float cd = exp2f(log2g * 64.f);
  f32x16 acc;
#pragma unroll
  for (int i = 0; i < 16; ++i) acc[i] = 0.f;
  const int i16 = lane & 15, q = i16 >> 2, p = i16 & 3, blk = (lane >> 4) & 1;
  LAS unsigned char* kt = wl;
  LAS unsigned char* vt = wl + 4096;
  const int toff = (8 * h + q) * 64 + (16 * blk + 4 * p) * 2;
  constexpr int SD = 2;
  u32x4 kq[SD][4], vv[SD][4];
#define ST_ISSUE(SL, N) do { const int n_ = (N) < S / 64 ? (N) : S / 64 - 1; _Pragma("unroll") for (int it_ = 0; it_ < 4; ++it_) { \
      const int idx_ = it_ * 64 + lane, row_ = idx_ >> 2, ch_ = idx_ & 3; \
      kq[SL][it_] = *(const u32x4*)(kbase + (size_t)(n_ * 64 + row_) * INW + 8 * ch_); \
      vv[SL][it_] = *(const u32x4*)(vbase + (size_t)(n_ * 64 + row_) * INW + 8 * ch_); } } while (0)
#pragma unroll
  for (int sl = 0; sl < SD; ++sl) ST_ISSUE(sl, sl);
#pragma unroll 1
  for (int n0 = 0; n0 < S / 64; n0 += SD) {
#pragma unroll
    for (int sl = 0; sl < SD; ++sl) {
      const int n = n0 + sl;
      bf16_t* pp = prevT + ((size_t)(bh * 32 + n) * 128 + 32 * vblk + r) * 128 + 32 * dblk + 4 * h;
#pragma unroll
      for (int g = 0; g < 4; ++g) {
        uint2 w; w.x = pk2(acc[4 * g], acc[4 * g + 1]); w.y = pk2(acc[4 * g + 2], acc[4 * g + 3]);
        *(uint2*)(pp + 8 * g) = w;
      }
#pragma unroll
      for (int it = 0; it < 4; ++it) {
        const int idx = it * 64 + lane, row = idx >> 2, ch = idx & 3;
        *(LAS u32x4*)(kt + row * 64 + ch * 16) = kq[sl][it];
        *(LAS u32x4*)(vt + row * 64 + ch * 16) = vv[sl][it];
      }
      ST_ISSUE(sl, n + SD);
      wave_lds_fence();
#pragma unroll
      for (int i = 0; i < 16; ++i) acc[i] *= cd;
#pragma unroll
      for (int s = 0; s < 4; ++s) {
        const s16x4 klo = tr16(kt + toff + (16 * s) * 64), khi = tr16(kt + toff + (16 * s + 4) * 64);
        const s16x4 vlo = tr16(vt + toff + (16 * s) * 64), vhi = tr16(vt + toff + (16 * s + 4) * 64);
        const u32x4 kraw = __builtin_bit_cast(u32x4, cat8(klo, khi));
        u32x4 ks;
#pragma unroll
        for (int jj = 0; jj < 4; ++jj) {
          const float z0 = SCALE * __builtin_amdgcn_exp2f(log2g * (float)(63 - (16 * s + 8 * h + 2 * jj)));
          const float z1 = SCALE * __builtin_amdgcn_exp2f(log2g * (float)(63 - (16 * s + 8 * h + 2 * jj + 1)));
          ks[jj] = pk2(bflo(kraw[jj]) * z0, bfhi(kraw[jj]) * z1);
        }
        acc = MFMA32(__builtin_bit_cast(bf16x8, ks), cat8(vlo, vhi), acc);
      }
    }
  }
#undef ST_ISSUE
}

__device__ __forceinline__ void retout_task(const Ctx& c, int task, LAS unsigned char* wl) {
  const bf16_t* proj = (const bf16_t*)(c.ws + WS_PROJ);
  const bf16_t* prevT = (const bf16_t*)(c.ws + WS_PREV);
  bf16_t* mixed = (bf16_t*)(c.ws + WS_MIXED);
  const float* rnw = c.in[3];
  const int lane = mk_lane_id(), r = lane & 31, h = lane >> 5;
  const int half = task & 1, n = (task >> 1) & 31, bh = task >> 6, b = bh >> 3, hd = bh & 7;
  const bf16_t* base = proj + (size_t)b * S * INW + hd * HD;
  const float log2g = __builtin_amdgcn_logf(1.f - exp2f(-5.f - (float)hd));
  const int qpos0 = n * 64 + 32 * half;
  bf16x8 qf[8];
#pragma unroll
  for (int s = 0; s < 8; ++s) qf[s] = *(const bf16x8*)(base + 3072 + (size_t)(qpos0 + r) * INW + 16 * s + 8 * h);
  f32x16 o[4];
#pragma unroll
  for (int cidx = 0; cidx < 4; ++cidx)
#pragma unroll
    for (int i = 0; i < 16; ++i) o[cidx][i] = 0.f;
  if (n > 0) {
    const bf16_t* pb = prevT + ((size_t)(bh * 32 + n) * 128 + r) * 128 + 8 * h;
#pragma unroll
    for (int cidx = 0; cidx < 4; ++cidx)
#pragma unroll
      for (int s = 0; s < 8; ++s) {
        const bf16x8 pf = *(const bf16x8*)(pb + (size_t)(32 * cidx) * 128 + 16 * s);
        o[cidx] = MFMA32(qf[s], pf, o[cidx]);
      }
#pragma unroll
    for (int i = 0; i < 16; ++i) {
      const float xi = __builtin_amdgcn_exp2f(log2g * (float)(32 * half + crow(i, h) + 1));
#pragma unroll
      for (int cidx = 0; cidx < 4; ++cidx) o[cidx][i] *= xi;
    }
  }
#pragma unroll 1
  for (int tile = 0; tile < 2; ++tile) {
    const int kpos0 = n * 64 + 32 * tile;
    u32x4 vr[8];
    vtile_load(vr, base + 5120 + (size_t)kpos0 * INW, lane);
    f32x16 st;
#pragma unroll
    for (int i = 0; i < 16; ++i) st[i] = 0.f;
#pragma unroll
    for (int s = 0; s < 8; ++s) {
      const bf16x8 kf = *(const bf16x8*)(base + 4096 + (size_t)(kpos0 + r) * INW + 16 * s + 8 * h);
      st = MFMA32(kf, qf[s], st);
    }
#pragma unroll
    for (int i = 0; i < 16; ++i) {
      const float dist = fabsf((float)((32 * half + r) - (32 * tile + crow(i, h))));
      st[i] *= SCALE * __builtin_amdgcn_exp2f(log2g * dist);
    }
    vtile_store(vr, wl, lane);
    wave_lds_fence();
    pv_accum(o, st, wl, lane);
  }
#pragma unroll
  for (int i = 0; i < 16; ++i) {
    const float mu = half_sum((o[0][i] + o[1][i]) + (o[2][i] + o[3][i])) * (1.f / 128.f);
    float d[4], qq = 0.f;
#pragma unroll
    for (int cidx = 0; cidx < 4; ++cidx) { d[cidx] = o[cidx][i] - mu; qq += d[cidx] * d[cidx]; }
    const float rr = rsqrtf(half_sum(qq) * (1.f / 128.f) + 1e-6f);
    const size_t tok = (size_t)(b * S + qpos0 + crow(i, h));
    const bf16_t* grow = proj + tok * INW + 6144 + hd * HD + r;
    bf16_t* orow = mixed + tok * D + 1024 + hd * HD + r;
#pragma unroll
    for (int cidx = 0; cidx < 4; ++cidx) {
      const float g = __uint_as_float((unsigned)grow[32 * cidx] << 16);
      const float sg = g / (1.f + __expf(-g));
      orow[32 * cidx] = (bf16_t)(pk2(d[cidx] * rr * rnw[hd * HD + 32 * cidx + r] * sg, 0.f) & 0xffffu);
    }
  }
}
constexpr int Q_STATE = NB * 8 * 16, Q_SB = NB * 8 * (S / 32), Q_QUANT = 2 * 16384 / 64, Q_TOTAL = Q_STATE + Q_SB + Q_QUANT;
__device__ __forceinline__ unsigned queue_pop(unsigned* ctr) {
  unsigned it = 0;
  if (mk_lane_id() == 0) it = __hip_atomic_fetch_add(ctr, 1u, __ATOMIC_RELAXED, __HIP_MEMORY_SCOPE_AGENT);
  return (unsigned)__builtin_amdgcn_readfirstlane((int)it);
}
__device__ __forceinline__ void p3_attn_a(const Ctx& c) {
  LAS unsigned char* wl = c.lds + c.wave * WAVE_LDS;
  const int gw = blockIdx.x * 8 + c.wave, NW = c.G * 8;
  for (int t = gw; t < Q_SB; t += NW) sb_task(c, t, wl);
  if (c.wave < 2) for (int t = blockIdx.x * 2 + c.wave; t < Q_STATE; t += c.G * 2) state_task(c, t, wl);
}
__device__ __forceinline__ void p4_attn_b(const Ctx& c) {
  LAS unsigned char* wl = c.lds + c.wave * WAVE_LDS;
  const int gw = blockIdx.x * 8 + c.wave, NW = c.G * 8;
  for (int t = gw; t < NB * 8 * 64; t += NW) retout_task(c, t, wl);
}

__device__ __forceinline__ void p5_ln1(const Ctx& c) {
  float* y1 = (float*)(c.ws + WS_Y1);
  bf16_t* x1b = (bf16_t*)(c.ws + WS_X1B);
  const float* w = c.in[5];
  const float* bb = c.in[6];
  const int lane = mk_lane_id(), gw = blockIdx.x * 8 + c.wave, NW = c.G * 8;
  for (int row = gw; row < T; row += NW) {
    float* p = y1 + (size_t)row * D;
    f32x4 v[8];
    float s = 0.f;
#pragma unroll
    for (int i = 0; i < 8; ++i) { v[i] = *(const f32x4*)(p + (i * 64 + lane) * 4); s += (v[i][0] + v[i][1]) + (v[i][2] + v[i][3]); }
    const float mu = wave_sum(s) * (1.f / D);
    float q = 0.f;
#pragma unroll
    for (int i = 0; i < 8; ++i) { const f32x4 d = v[i] - mu; q += (d[0] * d[0] + d[1] * d[1]) + (d[2] * d[2] + d[3] * d[3]); }
    const float rr = rsqrtf(wave_sum(q) * (1.f / D) + 1e-5f);
#pragma unroll
    for (int i = 0; i < 8; ++i) {
      const int col = (i * 64 + lane) * 4;
      const f32x4 wv = *(const f32x4*)(w + col), bv = *(const f32x4*)(bb + col);
      const f32x4 o = (v[i] - mu) * rr * wv + bv;
      *(f32x4*)(p + col) = o;
      uint2 pkd; pkd.x = pk2(o[0], o[1]); pkd.y = pk2(o[2], o[3]);
      *(uint2*)(x1b + (size_t)row * D + col) = pkd;
      v[i] = o;
    }
    float mx = 0.f;
#pragma unroll
    for (int i = 0; i < 8; ++i) mx = fmaxf(mx, fmaxf(fmaxf(fabsf(v[i][0]), fabsf(v[i][1])), fmaxf(fabsf(v[i][2]), fabsf(v[i][3]))));
    mx = fmaxf(wave_max(mx), 1e-30f);
    const float inv = 127.f / mx;
    unsigned* xq = (unsigned*)(c.ws + WS_X1Q + (size_t)row * D);
#pragma unroll
    for (int i = 0; i < 8; ++i) {
      unsigned w = 0;
#pragma unroll
      for (int k = 0; k < 4; ++k) { const int q = (int)rintf(v[i][k] * inv); w |= ((unsigned)q & 255u) << (8 * k); }
      xq[i * 64 + lane] = w;
    }
    if (lane == 0) ((float*)(c.ws + WS_SX))[row] = mx * (1.f / 127.f);
  }
}

__device__ __forceinline__ void p7_route_naive(const Ctx& c) {
  const bf16_t* qp = (const bf16_t*)(c.ws + WS_QP);
  const float* sk = c.in[8];
  int* eidx = (int*)(c.ws + WS_EIDX);
  float* egate = (float*)(c.ws + WS_EGATE);
  const int lane = mk_lane_id(), gw = blockIdx.x * 8 + c.wave, NW = c.G * 8;
  const float NEG = -3.0e38f;
  LAS int* ke = (LAS int*)c.lds;
  LAS float* kg = (LAS float*)(c.lds + 512);
  int* sorted_e = (int*)(c.ws + WS_SE);
  float* sorted_g = (float*)(c.ws + WS_SG);
  for (int th = gw; th < T * 8; th += NW) {
    const int t = th >> 3, h = th & 7;
    float st0 = 0.f, st1 = 0.f; int it0 = 0, it1 = 0;
#pragma unroll 1
    for (int cc = 0; cc < 2; ++cc) {
      const bf16_t* q = qp + (size_t)t * D + h * 256 + cc * 128;
      const float* k0 = sk + ((size_t)((h * 2 + cc) * NKEYS + lane)) * 128;
      const float* k1 = k0 + 64 * 128;
      float v0 = 0.f, v1 = 0.f;
      for (int d = 0; d < 128; d += 4) {
        const uint2 qq = *(const uint2*)(q + d);
        const float q0 = bflo(qq.x), q1 = bfhi(qq.x), q2 = bflo(qq.y), q3 = bfhi(qq.y);
        const float4 a = *(const float4*)(k0 + d);
        const float4 bq = *(const float4*)(k1 + d);
        v0 += q0 * a.x + q1 * a.y + q2 * a.z + q3 * a.w;
        v1 += q0 * bq.x + q1 * bq.y + q2 * bq.z + q3 * bq.w;
      }
      float mys = 0.f; int myi = 0;
      for (int it = 0; it < 16; ++it) {
        const float m = wave_max(fmaxf(v0, v1));
        int cand = 9999;
        if (v1 == m) cand = lane + 64;
        if (v0 == m) cand = lane;
        const int sel = wave_min_i(cand);
        if (sel == lane) v0 = NEG;
        if (sel == lane + 64) v1 = NEG;
        if (lane == it) { mys = m; myi = sel; }
      }
      if (cc == 0) { st0 = mys; it0 = myi; } else { st1 = mys; it1 = myi; }
    }
    float cv[4];
#pragma unroll
    for (int j = 0; j < 4; ++j) cv[j] = __shfl(st0, lane >> 2) + __shfl(st1, (lane & 3) * 4 + j);
    float mybest = 0.f; int mypos = 0;
    for (int it = 0; it < 16; ++it) {
      const float lm = fmaxf(fmaxf(cv[0], cv[1]), fmaxf(cv[2], cv[3]));
      const float m = wave_max(lm);
      int cand = 9999;
#pragma unroll
      for (int j = 3; j >= 0; --j) if (cv[j] == m) cand = lane * 4 + j;
      const int sel = wave_min_i(cand);
#pragma unroll
      for (int j = 0; j < 4; ++j) if (sel == lane * 4 + j) cv[j] = NEG;
      if (lane == it) { mybest = m; mypos = sel; }
    }
    const float mx = __shfl(mybest, 0);
    const float e = (lane < 16) ? expf(mybest - mx) : 0.f;
    const float den = wave_sum(e);
    const int ia = __shfl(it0, mypos >> 4), ib = __shfl(it1, mypos & 15);
    if (lane < 16) {
      eidx[(size_t)th * 16 + lane] = ia * NKEYS + ib;
      egate[(size_t)th * 16 + lane] = e / den;
      ke[h * 16 + lane] = ia * NKEYS + ib;
      kg[h * 16 + lane] = e / den;
    }
    __syncthreads();
    if ((c.wave * 64 + mk_lane_id()) < 128) {
      const int me = ke[(c.wave * 64 + mk_lane_id())];
      int rank = 0;
      for (int j = 0; j < 128; ++j) { const int o = ke[j]; rank += (o < me || (o == me && j < (c.wave * 64 + mk_lane_id()))) ? 1 : 0; }
      sorted_e[(size_t)t * 128 + rank] = me;
      sorted_g[(size_t)t * 128 + rank] = kg[(c.wave * 64 + mk_lane_id())];
    }
    __syncthreads();
  }
}

__device__ __forceinline__ void p8_peer_naive(const Ctx& c) {
  const float* x1 = (const float*)(c.ws + WS_Y1);
  const int* eidx = (const int*)(c.ws + WS_EIDX);
  const float* egate = (const float*)(c.ws + WS_EGATE);
  const float* eu = c.in[9];
  const float* ev = c.in[10];
  const float* w = c.in[11];
  const float* bb = c.in[12];
  LAS float* xs = (LAS float*)c.lds;
  LAS float* hh = xs + D;
  LAS int* ei = (LAS int*)(hh + 128);
  LAS float* red = (LAS float*)(ei + 128);
  const int tid = (c.wave * 64 + mk_lane_id()), lane = mk_lane_id(), wv = c.wave;
  for (int t = blockIdx.x; t < T; t += c.G) {
    *(f32x4*)(xs + tid * 4) = *(const f32x4*)(x1 + (size_t)t * D + tid * 4);
    if (tid < 128) ei[tid] = eidx[(size_t)t * 128 + tid];
    __syncthreads();
    for (int a = wv * 16; a < wv * 16 + 16; ++a) {
      const float* u = eu + (size_t)ei[a] * D;
      float s = 0.f;
#pragma unroll
      for (int i = 0; i < 8; ++i) {
        const f32x4 uv = *(const f32x4*)(u + (i * 64 + lane) * 4);
        const f32x4 xv = *(const LAS f32x4*)(xs + (i * 64 + lane) * 4);
        s += uv[0] * xv[0] + uv[1] * xv[1] + uv[2] * xv[2] + uv[3] * xv[3];
      }
      s = wave_sum(s);
      const float act = 0.5f * s * (1.f + erff(s * 0.7071067811865476f));
      if (lane == 0) hh[a] = egate[(size_t)t * 128 + a] * act;
    }
    __syncthreads();
    f32x4 acc = {0.f, 0.f, 0.f, 0.f};
    for (int a = 0; a < 128; ++a) {
      const f32x4 v = *(const f32x4*)(ev + (size_t)ei[a] * D + tid * 4);
      acc += v * hh[a];
    }
    const f32x4 y = *(const LAS f32x4*)(xs + tid * 4) * ALPHA + acc;
    float s = wave_sum((y[0] + y[1]) + (y[2] + y[3]));
    if (lane == 0) red[wv] = s;
    __syncthreads();
    float mu = 0.f;
#pragma unroll
    for (int i = 0; i < 8; ++i) mu += red[i];
    mu *= (1.f / D);
    const f32x4 d = y - mu;
    float q = wave_sum((d[0] * d[0] + d[1] * d[1]) + (d[2] * d[2] + d[3] * d[3]));
    if (lane == 0) red[8 + wv] = q;
    __syncthreads();
    float var = 0.f;
#pragma unroll
    for (int i = 0; i < 8; ++i) var += red[8 + i];
    const float rr = rsqrtf(var * (1.f / D) + 1e-5f);
    const f32x4 wv4 = *(const f32x4*)(w + tid * 4), bv = *(const f32x4*)(bb + tid * 4);
    *(f32x4*)(c.out + (size_t)t * D + tid * 4) = d * rr * wv4 + bv;
    __syncthreads();
  }
}

__device__ __forceinline__ unsigned fkey(float f) { const unsigned u = __float_as_uint(f); return (u & 0x80000000u) ? ~u : (u | 0x80000000u); }
__device__ __forceinline__ float funkey(unsigned k) { return __uint_as_float((k & 0x80000000u) ? (k & 0x7fffffffu) : ~k); }
template <int N> __device__ __forceinline__ void sort_desc(unsigned (&a)[N]) {
#pragma unroll
  for (int k = 2; k <= N; k <<= 1)
#pragma unroll
    for (int j = k >> 1; j > 0; j >>= 1)
#pragma unroll
      for (int i = 0; i < N; ++i) {
        const int l = i ^ j;
        if (l > i) {
          const unsigned x = a[i], y = a[l], mx = x > y ? x : y, mn = x > y ? y : x;
          if ((i & k) == 0) { a[i] = mx; a[l] = mn; } else { a[i] = mn; a[l] = mx; }
        }
      }
}
__device__ __forceinline__ void merge16(unsigned (&a)[16], const unsigned (&b)[16]) {
#pragma unroll
  for (int i = 0; i < 16; ++i) { const unsigned y = b[15 - i]; a[i] = a[i] > y ? a[i] : y; }
#pragma unroll
  for (int j = 8; j > 0; j >>= 1)
#pragma unroll
    for (int i = 0; i < 16; ++i) {
      const int l = i ^ j;
      if (l > i) { const unsigned x = a[i], y = a[l]; a[i] = x > y ? x : y; a[l] = x > y ? y : x; }
    }
}
__device__ __forceinline__ void top16_of_64(const unsigned (&v)[64], unsigned (&out)[16]) {
  unsigned g[4][16];
#pragma unroll
  for (int q = 0; q < 4; ++q) {
#pragma unroll
    for (int i = 0; i < 16; ++i) g[q][i] = v[16 * q + i];
    sort_desc<16>(g[q]);
  }
  merge16(g[0], g[1]); merge16(g[2], g[3]); merge16(g[0], g[2]);
#pragma unroll
  for (int i = 0; i < 16; ++i) out[i] = g[0][i];
}
constexpr int ROUTE_KE_OFF = 81920;
constexpr int ROUTE_KG_OFF = ROUTE_KE_OFF + 16384;
struct StairTab { int a[64], b[64]; };
__host__ __device__ constexpr StairTab make_stair() {
  StairTab t{}; int n = 0;
  for (int a = 0; a < 16; ++a) for (int b = 0; b < 16; ++b) if ((a + 1) * (b + 1) <= 16) { t.a[n] = a; t.b[n] = b; ++n; }
  for (; n < 64; ++n) { t.a[n] = -1; t.b[n] = -1; }
  return t;
}
__device__ __forceinline__ void p8_route(const Ctx& c) {
  const bf16_t* qp = (const bf16_t*)(c.ws + WS_QP);
  const bf16_t* skb = (const bf16_t*)(c.ws + WS_SKB);
  int* sorted_e = (int*)(c.ws + WS_SE);
  float* sorted_g = (float*)(c.ws + WS_SG);
  const int lane = mk_lane_id(), r = lane & 31, hh = lane >> 5, head = c.wave;
  LAS unsigned char* wl = c.lds + c.wave * WAVE_LDS;
  LAS int* ke = (LAS int*)(c.lds + ROUTE_KE_OFF);
  LAS float* kg = (LAS float*)(c.lds + ROUTE_KG_OFF);
  constexpr StairTab ST = make_stair();
  for (int tg = blockIdx.x; tg < T / 32; tg += c.G) {
    const int t0 = tg * 32;
    unsigned top[2][16];
#pragma unroll
    for (int cc = 0; cc < 2; ++cc) {
      bf16x8 qf[8];
#pragma unroll
      for (int s = 0; s < 8; ++s) qf[s] = *(const bf16x8*)(qp + (size_t)(t0 + r) * D + head * 256 + cc * 128 + 16 * s + 8 * hh);
      unsigned mine[16];
#pragma unroll
      for (int kt = 0; kt < 4; ++kt) {
        f32x16 sc;
#pragma unroll
        for (int i = 0; i < 16; ++i) sc[i] = 0.f;
        const bf16_t* krow_p = skb + ((size_t)((head * 2 + cc) * NKEYS + 32 * kt + r)) * 128 + 8 * hh;
#pragma unroll
        for (int s = 0; s < 8; ++s) sc = MFMA32(*(const bf16x8*)(krow_p + 16 * s), qf[s], sc);
        unsigned v[16];
#pragma unroll
        for (int i = 0; i < 16; ++i) {
          const int kidx = 32 * kt + (i & 3) + 8 * (i >> 2) + 4 * hh;
          v[i] = (fkey(sc[i]) & ~127u) | (unsigned)(127 - kidx);
        }
        sort_desc<16>(v);
        if (kt == 0) {
#pragma unroll
          for (int i = 0; i < 16; ++i) mine[i] = v[i];
        } else merge16(mine, v);
        __builtin_amdgcn_sched_barrier(0);
      }
      unsigned other[16];
#pragma unroll
      for (int i = 0; i < 16; ++i) other[i] = (unsigned)__shfl_xor((int)mine[i], 32);
      merge16(mine, other);
#pragma unroll
      for (int i = 0; i < 16; ++i) top[cc][i] = mine[i];
    }
    float f0[16], f1[16];
#pragma unroll
    for (int i = 0; i < 16; ++i) { f0[i] = funkey(top[0][i] & ~127u); f1[i] = funkey(top[1][i] & ~127u); }
    unsigned best[16];
#pragma unroll
    for (int q = 0; q < 4; ++q) {
      unsigned cv[16];
#pragma unroll
      for (int i = 0; i < 16; ++i) {
        const int n = 16 * q + i;
        if (ST.a[n] >= 0) cv[i] = (fkey(f0[ST.a[n]] + f1[ST.b[n]]) & ~255u) | (unsigned)(255 - (ST.a[n] * 16 + ST.b[n]));
        else cv[i] = 0u;
      }
      sort_desc<16>(cv);
      if (q == 0) {
#pragma unroll
        for (int i = 0; i < 16; ++i) best[i] = cv[i];
      } else merge16(best, cv);
      __builtin_amdgcn_sched_barrier(0);
    }
    LAS unsigned* tb = (LAS unsigned*)(wl + lane * 32);
#pragma unroll
    for (int w4 = 0; w4 < 4; ++w4) {
      unsigned p0 = 0, p1 = 0;
#pragma unroll
      for (int k = 0; k < 4; ++k) { p0 |= (127u - (top[0][4 * w4 + k] & 127u)) << (8 * k); p1 |= (127u - (top[1][4 * w4 + k] & 127u)) << (8 * k); }
      tb[w4] = p0; tb[4 + w4] = p1;
    }
    wave_lds_fence();
    const float mx = funkey(best[0] & ~255u);
    float ex[16], den = 0.f;
#pragma unroll
    for (int i = 0; i < 16; ++i) { ex[i] = __expf(funkey(best[i] & ~255u) - mx); den += ex[i]; }
    const float inv = 1.f / den;
#pragma unroll
    for (int i = 0; i < 8; ++i) {
      const unsigned bk = hh ? best[8 + i] : best[i];
      const float gt = (hh ? ex[8 + i] : ex[i]) * inv;
      const int pos = 255 - (int)(bk & 255u);
      const int ia = ((LAS unsigned char*)tb)[pos >> 4], ib = ((LAS unsigned char*)tb)[16 + (pos & 15)];
      ke[r * 128 + head * 16 + 8 * hh + i] = ia * NKEYS + ib;
      kg[r * 128 + head * 16 + 8 * hh + i] = gt;
    }
    __syncthreads();
    {
      const int tt = (c.wave * 64 + mk_lane_id()) >> 4, e8 = ((c.wave * 64 + mk_lane_id()) & 15) * 8;
      int me[8], rank[8];
#pragma unroll
      for (int j = 0; j < 8; ++j) { me[j] = ke[tt * 128 + e8 + j]; rank[j] = 0; }
      for (int o = 0; o < 128; ++o) {
        const int ov = ke[tt * 128 + o];
#pragma unroll
        for (int j = 0; j < 8; ++j) rank[j] += (ov < me[j] || (ov == me[j] && o < e8 + j)) ? 1 : 0;
      }
#if defined(MK_NOSORT)
#pragma unroll
      for (int j = 0; j < 8; ++j) rank[j] = e8 + j;
#endif
#pragma unroll
      for (int j = 0; j < 8; ++j) {
        sorted_e[(size_t)(t0 + tt) * 128 + rank[j]] = me[j];
        sorted_g[(size_t)(t0 + tt) * 128 + rank[j]] = kg[tt * 128 + e8 + j];
      }
    }
    __syncthreads();
  }
}

typedef __bf16 bf16x2v __attribute__((ext_vector_type(2)));
__device__ __forceinline__ float dot2bf(unsigned a, unsigned b, float acc) {
  return __builtin_amdgcn_fdot2_f32_bf16(__builtin_bit_cast(bf16x2v, a), __builtin_bit_cast(bf16x2v, b), acc, false);
}
__device__ __forceinline__ int rdlane_i(int v, int l) { return __builtin_amdgcn_readlane(v, l); }
__device__ __forceinline__ float rdlane_f(float v, int l) { return __int_as_float(__builtin_amdgcn_readlane(__float_as_int(v), l)); }
template <int CTRL> __device__ __forceinline__ int dpp_mov_i(int v) { return __builtin_amdgcn_update_dpp(0, v, CTRL, 0xf, 0xf, true); }
__device__ __forceinline__ int wave_sum_i_dpp(int v) {
  v += dpp_mov_i<0xB1>(v);
  v += dpp_mov_i<0x4E>(v);
  v += dpp_mov_i<0x141>(v);
  v += dpp_mov_i<0x140>(v);
  return __builtin_amdgcn_readlane(v, 0) + __builtin_amdgcn_readlane(v, 16) + __builtin_amdgcn_readlane(v, 32) + __builtin_amdgcn_readlane(v, 48);
}
__device__ __forceinline__ float gelu_as(float v) {
  const float av = fabsf(v), t = __builtin_amdgcn_rcpf(av * 0.2316418882f + 1.0f);
  float q = t * 0.5307027145f + (-0.7265760135f); q = q * t + 0.7107068705f; q = q * t + (-0.142248368f); q = q * t + 0.127414796f; q = q * t;
  const float e = __builtin_amdgcn_exp2f((v * v) * (-0.72134752044f));
  const float m = v * (q * e);
  return v < 0.f ? m : v - m;
}
constexpr int PEER_D1 = 8, PEER_D2 = 2;
__device__ __forceinline__ void p9_peer(const Ctx& c) {
  const unsigned char* x1q = (const unsigned char*)(c.ws + WS_X1Q);
  const float* sx = (const float*)(c.ws + WS_SX);
  const float* x1 = (const float*)(c.ws + WS_Y1);
  const int* sorted_e = (const int*)(c.ws + WS_SE);
  const float* sorted_g = (const float*)(c.ws + WS_SG);
  const unsigned char* uq = (const unsigned char*)(c.ws + WS_UQ);
  const unsigned char* vq = (const unsigned char*)(c.ws + WS_VQ);
  const float* su = (const float*)(c.ws + WS_SU);
  const float* sv = (const float*)(c.ws + WS_SV);
  const float* lw = c.in[11];
  const float* lb = c.in[12];
  const int lane = mk_lane_id(), gw = blockIdx.x * 8 + c.wave, NW = c.G * 8;
  LAS int* le = (LAS int*)(c.lds + c.wave * WAVE_LDS);
  LAS float* lsc = (LAS float*)(le + 512);
  LAS float* lg = lsc + 512;
  LAS float* lh = lg + 512;
  LAS int* lpi = (LAS int*)(lh + 512);
  for (int tb = gw * 4; tb < T; tb += NW * 4) {
    int lq = lane;
    asm volatile("" : "+v"(lq));
    u32x4 xr[4][2];
#pragma unroll
    for (int tk = 0; tk < 4; ++tk) {
      const size_t t = (size_t)(tb + tk);
      const float sxt = sx[t];
#pragma unroll
      for (int hh = 0; hh < 2; ++hh) {
        const int e = sorted_e[t * 128 + 64 * hh + lq];
        le[tk * 128 + 64 * hh + lq] = e;
        lsc[tk * 128 + 64 * hh + lq] = su[e] * sxt;
        lg[tk * 128 + 64 * hh + lq] = sorted_g[t * 128 + 64 * hh + lq] * sv[e];
      }
#pragma unroll
      for (int i = 0; i < 2; ++i) xr[tk][i] = *(const u32x4*)(x1q + t * D + 1024 * i + 16 * lq);
    }
    wave_lds_fence();
#pragma unroll 1
    for (int hf = 0; hf < 2; ++hf) {
      u32x4 rows[PEER_D1][4];
#define PEER_ISSUE1(SL, P) do { _Pragma("unroll") for (int tk_ = 0; tk_ < 4; ++tk_) \
        rows[SL][tk_] = *(const u32x4*)(uq + (size_t)__builtin_amdgcn_readfirstlane(le[tk_ * 128 + (P)]) * D + 1024 * hf + 16 * lane); } while (0)
#define PEER_CONSUME1(SL, P) do { _Pragma("unroll") for (int tk_ = 0; tk_ < 4; ++tk_) { int ia_ = 0, ib_ = 0; \
        const u32x4 xh_ = hf ? xr[tk_][1] : xr[tk_][0]; \
        ia_ = __builtin_amdgcn_sdot4((int)rows[SL][tk_][0], (int)xh_[0], ia_, false); ib_ = __builtin_amdgcn_sdot4((int)rows[SL][tk_][1], (int)xh_[1], ib_, false); \
        ia_ = __builtin_amdgcn_sdot4((int)rows[SL][tk_][2], (int)xh_[2], ia_, false); ib_ = __builtin_amdgcn_sdot4((int)rows[SL][tk_][3], (int)xh_[3], ib_, false); \
        const int part_ = wave_sum_i_dpp(ia_ + ib_); \
        if (hf == 0) { if (lane == 0) lpi[tk_ * 128 + (P)] = part_; } \
        else { const float sacc_ = (float)(part_ + lpi[tk_ * 128 + (P)]) * lsc[tk_ * 128 + (P)]; \
               if (lane == 0) lh[tk_ * 128 + (P)] = gelu_as(sacc_) * lg[tk_ * 128 + (P)]; } } } while (0)
#pragma unroll
      for (int sl = 0; sl < PEER_D1; ++sl) PEER_ISSUE1(sl, sl);
#pragma unroll 1
      for (int p0 = 0; p0 < 128 - PEER_D1; p0 += PEER_D1) {
#pragma unroll
        for (int sl = 0; sl < PEER_D1; ++sl) { PEER_CONSUME1(sl, p0 + sl); PEER_ISSUE1(sl, p0 + sl + PEER_D1); }
      }
#pragma unroll
      for (int sl = 0; sl < PEER_D1; ++sl) PEER_CONSUME1(sl, 128 - PEER_D1 + sl);
#undef PEER_ISSUE1
#undef PEER_CONSUME1
      wave_lds_fence();
    }
    wave_lds_fence();
    int lcol = 16 * lane;
    asm volatile("" : "+v"(lcol));
#pragma unroll 1
    for (int hf = 0; hf < 2; ++hf) {
      float acc[4][16], hsum[4];
#pragma unroll
      for (int tk = 0; tk < 4; ++tk) {
        hsum[tk] = 0.f;
#pragma unroll
        for (int j = 0; j < 4; ++j) {
          const f32x4 xv = *(const f32x4*)(x1 + (size_t)(tb + tk) * D + 1024 * hf + lcol + 4 * j);
#pragma unroll
          for (int k = 0; k < 4; ++k) acc[tk][4 * j + k] = ALPHA * xv[k];
        }
      }
      u32x4 rows[PEER_D2][4]; float hw[PEER_D2][4];
#define PEER_ISSUE2(SL, P) do { _Pragma("unroll") for (int tk_ = 0; tk_ < 4; ++tk_) { \
        rows[SL][tk_] = *(const u32x4*)(vq + (size_t)__builtin_amdgcn_readfirstlane(le[tk_ * 128 + (P)]) * D + 1024 * hf + 16 * lane); \
        hw[SL][tk_] = lh[tk_ * 128 + (P)]; } } while (0)
#define PEER_CONSUME2(SL) do { _Pragma("unroll") for (int tk_ = 0; tk_ < 4; ++tk_) { const float hv_ = hw[SL][tk_]; hsum[tk_] += hv_; \
        _Pragma("unroll") for (int j_ = 0; j_ < 4; ++j_) { const unsigned w_ = rows[SL][tk_][j_]; \
          acc[tk_][4 * j_ + 0] += hv_ * (float)(w_ & 255u); acc[tk_][4 * j_ + 1] += hv_ * (float)((w_ >> 8) & 255u); \
          acc[tk_][4 * j_ + 2] += hv_ * (float)((w_ >> 16) & 255u); acc[tk_][4 * j_ + 3] += hv_ * (float)(w_ >> 24); } } } while (0)
#pragma unroll
      for (int sl = 0; sl < PEER_D2; ++sl) PEER_ISSUE2(sl, sl);
#pragma unroll 1
      for (int p0 = 0; p0 < 128 - PEER_D2; p0 += PEER_D2) {
#pragma unroll
        for (int sl = 0; sl < PEER_D2; ++sl) { PEER_CONSUME2(sl); PEER_ISSUE2(sl, p0 + sl + PEER_D2); }
      }
#pragma unroll
      for (int sl = 0; sl < PEER_D2; ++sl) PEER_CONSUME2(sl);
#undef PEER_ISSUE2
#undef PEER_CONSUME2
#pragma unroll
      for (int tk = 0; tk < 4; ++tk)
#pragma unroll
        for (int j = 0; j < 4; ++j) {
          f32x4 o;
#pragma unroll
          for (int k = 0; k < 4; ++k) o[k] = acc[tk][4 * j + k] - 128.f * hsum[tk];
          *(f32x4*)(c.out + (size_t)(tb + tk) * D + 1024 * hf + lcol + 4 * j) = o;
        }
    }
    asm volatile("" : "+v"(lcol));
#pragma unroll 1
    for (int tk = 0; tk < 4; ++tk) {
      float* orow = c.out + (size_t)(tb + tk) * D + lcol;
      f32x4 y[8];
      float ssum = 0.f;
#pragma unroll
      for (int i = 0; i < 8; ++i) { y[i] = *(const f32x4*)(orow + 1024 * (i >> 2) + 4 * (i & 3)); ssum += (y[i][0] + y[i][1]) + (y[i][2] + y[i][3]); }
      const float mu = wave_sum(ssum) * (1.f / D);
      float q = 0.f;
#pragma unroll
      for (int i = 0; i < 8; ++i) { y[i] = y[i] - mu; q += (y[i][0] * y[i][0] + y[i][1] * y[i][1]) + (y[i][2] * y[i][2] + y[i][3] * y[i][3]); }
      const float rr = rsqrtf(wave_sum(q) * (1.f / D) + 1e-5f);
#pragma unroll
      for (int i = 0; i < 8; ++i) {
        const int col = 1024 * (i >> 2) + 4 * (i & 3);
        const f32x4 wv = *(const f32x4*)(lw + lcol + col), bv = *(const f32x4*)(lb + lcol + col);
        *(f32x4*)(orow + col) = y[i] * rr * wv + bv;
      }
    }
    wave_lds_fence();
  }
}

#ifndef MK_N_LAUNCHES
#define MK_N_LAUNCHES 1
#endif
constexpr int NPHASE = 9;
#ifndef MK_PROBE_PHASE
#define MK_PROBE_PHASE -1
#define MK_PROBE_REPS 1
#endif
struct Args { const float* in[13]; float* out; unsigned char* ws; int ph_lo, ph_hi; };

__global__ void __launch_bounds__(NTHR, 2) k_main(Args a) {
  extern __shared__ __attribute__((aligned(16))) unsigned char lds_raw[];
  Ctx c;
#pragma unroll
  for (int i = 0; i < 13; ++i) c.in[i] = a.in[i];
  c.out = a.out; c.ws = a.ws; c.lds = (LAS unsigned char*)lds_raw;
  c.wave = __builtin_amdgcn_readfirstlane((int)(threadIdx.x >> 6)); c.G = gridDim.x;
  volatile LAS unsigned* misc = (volatile LAS unsigned*)(c.lds + pg8::STAGE_BYTES);
  if (c.wave == 0 && mk_lane_id() < 16) misc[mk_lane_id()] = 0u;
  __syncthreads();
  const int lo = a.ph_lo, hi = a.ph_hi;
  XcdBarrier bar; bar.wave = (unsigned)c.wave; bar.bar = (unsigned*)(c.ws + WS_CTL); bar.x = 0; bar.st = misc;
  if (hi - lo > 1) bar = xcd_barrier_post((unsigned*)(c.ws + WS_CTL), misc, (unsigned)c.wave);
  bf16_t* xb = (bf16_t*)(c.ws + WS_XB);
#define IN(k) (lo <= (k) && (k) < hi)
#ifndef MK_ONLY
#define MK_ONLY -1
#endif
#define PHASE(k, ...) do { if (IN(k) && (MK_ONLY < 0 || MK_ONLY == (k))) { \
    _Pragma("unroll 1") for (int it_ = 0; it_ < (((k) == MK_PROBE_PHASE) ? MK_PROBE_REPS : 1); ++it_) { if (it_ > 0) xcd_barrier(bar); __VA_ARGS__; } \
    if (IN((k) + 1)) xcd_barrier(bar); } } while (0)
  PHASE(0, p0_prologue(c));
  PHASE(1, {
    pg8::Gemm g{xb, (const bf16_t*)(c.ws + WS_WIN), T, INW, D};
    pg8::StaticOrder so; so.init(T, INW, c.G, (int)blockIdx.x);
    pg8::EpiProjRot E{(bf16_t*)(c.ws + WS_PROJ), INW, 3072, 5120, (const float*)(c.ws + WS_ROT), (const float*)(c.ws + WS_ROT) + S * 64, S - 1};
    pg8::gemm_phase<pg8::EpiProjRot, pg8::StaticOrder, false>(c.lds, g, so, E, nullptr, c.wave);
    { const int nfull = so.nwg % c.G;
      if (nfull != 0 && (int)blockIdx.x >= nfull) { const int nq = (c.G - nfull) * 8, per = (2 * 16384 + nq - 1) / nq, r0 = (((int)blockIdx.x - nfull) * 8 + c.wave) * per;
        if (r0 < 2 * 16384) quant_rows(c, r0, min(per, 2 * 16384 - r0)); } } });
  PHASE(2, p3_attn_a(c));
  PHASE(3, p4_attn_b(c));
  PHASE(4, {
    pg8::Gemm g{(const bf16_t*)(c.ws + WS_MIXED), (const bf16_t*)(c.ws + WS_WOUT), T, D, D};
    pg8::StaticOrder so; so.init(T, D, c.G, (int)blockIdx.x);
    pg8::EpiResF32 E{(float*)(c.ws + WS_Y1), D, c.in[0], ALPHA};
    pg8::gemm_phase<pg8::EpiResF32, pg8::StaticOrder, false>(c.lds, g, so, E, nullptr, c.wave); });
  PHASE(5, { p5_ln1(c); if (((T / 256) * (INW / 256)) % c.G == 0) for (int rr0 = (blockIdx.x * 8 + c.wave) * 16; rr0 < 2 * 16384; rr0 += c.G * 8 * 16) quant_rows(c, rr0, 16); });
  PHASE(6, {
    pg8::Gemm g{(const bf16_t*)(c.ws + WS_X1B), (const bf16_t*)(c.ws + WS_WPQ), T, D, D};
    pg8::StaticOrder so; so.init(T, D, c.G, (int)blockIdx.x);
    pg8::EpiBf16Plain E{(bf16_t*)(c.ws + WS_QP), D};
    pg8::gemm_phase<pg8::EpiBf16Plain, pg8::StaticOrder, false>(c.lds, g, so, E, nullptr, c.wave); });
  PHASE(7, p8_route(c));
  PHASE(8, p9_peer(c));
#undef PHASE
#undef IN
}
}

extern "C" void kernel_launch(void* const* d_in, const int* in_sizes, int n_in, void* d_out, int out_size, void* d_ws, size_t ws_size,
                              hipStream_t stream) {
  using namespace mk;
  static int grid = 0;
  if (grid == 0) {
    if (n_in != 13 || ws_size < WS_END) { grid = -1; return; }
    int dev = 0, cus = 0, per_cu = 0;
    if (hipGetDevice(&dev) != hipSuccess || hipDeviceGetAttribute(&cus, hipDeviceAttributeMultiprocessorCount, dev) != hipSuccess) { grid = -1; return; }
    if (hipFuncSetAttribute((const void*)k_main, hipFuncAttributeMaxDynamicSharedMemorySize, LDS_BYTES) != hipSuccess) { grid = -1; return; }
    if (hipOccupancyMaxActiveBlocksPerMultiprocessor(&per_cu, (const void*)k_main, NTHR, LDS_BYTES) != hipSuccess || per_cu < 1) { (void)hipGetLastError(); per_cu = 1; }
    grid = cus;
  }
  if (grid < 0) return;
  (void)hipMemsetAsync((char*)d_ws + WS_CTL, 0, CTL_BYTES, stream);
  Args a{};
  for (int i = 0; i < 13; ++i) a.in[i] = (const float*)d_in[i];
  a.out = (float*)d_out; a.ws = (unsigned char*)d_ws;
#if MK_N_LAUNCHES == 1
  a.ph_lo = 0; a.ph_hi = NPHASE;
  hipLaunchKernelGGL(k_main, dim3(grid), dim3(NTHR), LDS_BYTES, stream, a);
#else
  for (int p = 0; p < NPHASE; ++p) { a.ph_lo = p; a.ph_hi = p + 1; hipLaunchKernelGGL(k_main, dim3(grid), dim3(NTHR), LDS_BYTES, stream, a); }
#endif
}
```

```cpp
#include <hip/hip_runtime.h>
#include <stdint.h>
#include <math.h>
__device__ __forceinline__ int mk_lane_id() { return (int)__builtin_amdgcn_mbcnt_hi(~0u, __builtin_amdgcn_mbcnt_lo(~0u, 0u)); }
#define MK_N_LAUNCHES 1
namespace pg8 {
#define PG8_LAS __attribute__((address_space(3)))
typedef unsigned short bf16_t;
typedef short bf16x8 __attribute__((ext_vector_type(8)));
typedef float f32x4 __attribute__((ext_vector_type(4)));
typedef unsigned u32x4 __attribute__((ext_vector_type(4)));
constexpr int BM = 256, BK = 64, HALF = 128, HTB = HALF * BK * 2  , STAGE_BYTES = 8 * HTB, NXCD = 8, WGM = 8;

__host__ __device__ __forceinline__ int lds_byte(int r, int c) { const int st = (r >> 4) * 2 + (c >> 5), rr = r & 15, cc = c & 31, ob = rr * 64 + cc * 2; return st * 1024 + (ob ^ (((ob >> 9) & 1) << 5)); }
__host__ __device__ __forceinline__ void stage_rc(int b, int& R, int& C) { const int st = b / 1024, sb = b % 1024, swz = sb ^ (((sb >> 9) & 1) << 5); R = (st >> 1) * 16 + swz / 64; C = (st & 1) * 32 + (swz % 64) / 2; }
__host__ __device__ __forceinline__ int perm32(int rho) { const int n = rho >> 4, i = rho & 15; return 8 * (i >> 2) + 4 * n + (i & 3); }

struct Unit { int pm, pn; };
struct Gemm { const bf16_t* A; const bf16_t* Bt; int M, N, K; };

struct StaticOrder {
    int nM, nN, nwg, G, c;
    __host__ __device__ void init(int M, int N, int G_, int c_) { nM = M / BM; nN = N / BM; nwg = nM * nN; G = G_; c = c_; }
    __host__ __device__ bool next(int i, Unit& u) const {
        const long L = (long)i * G + c; if (L >= nwg) return false;
        int wgid = (int)L; { const int q = nwg / NXCD, r = nwg % NXCD, xcd = wgid % NXCD, off = wgid / NXCD; wgid = (xcd < r ? xcd * (q + 1) : r * (q + 1) + (xcd - r) * q) + off; }
        const int nig = WGM * nN, gid = wgid / nig, fm = gid * WGM, gsz = (nM - fm) < WGM ? (nM - fm) : WGM;
        u.pm = fm + ((wgid % nig) % gsz); u.pn = (wgid % nig) / gsz; return true;
    }
    __device__ __forceinline__ void a_ready(const Unit&) const {}
    __device__ __forceinline__ void done(const Unit&) const {}
};
typedef __bf16 bf16x2_t __attribute__((ext_vector_type(2)));
typedef float f32x2_t __attribute__((ext_vector_type(2)));
__device__ __forceinline__ unsigned pk2(float lo, float hi) { f32x2_t v = {lo, hi}; bf16x2_t r = __builtin_convertvector(v, bf16x2_t); return __builtin_bit_cast(unsigned, r); }
struct EpiBf16Plain {
    static constexpr bool PERM = true, AFTER_DRAIN = false;
    bf16_t* O; int ldc;
    __device__ __forceinline__ void operator()(const f32x4 (&acc)[2][2][4][2], const Unit& u, int wr, int wc, int fr, int fq) const {
        const int row0 = u.pm * BM + wr * 64 + fr, col0 = u.pn * BM + wc * 32 + 8 * fq;
#pragma unroll
        for (int ai = 0; ai < 2; ++ai)
#pragma unroll
            for (int m = 0; m < 4; ++m) { bf16_t* rowp = O + (size_t)(row0 + ai * HALF + m * 16) * ldc + col0;
#pragma unroll
                for (int bj = 0; bj < 2; ++bj) { const f32x4 v0 = acc[ai][bj][m][0], v1 = acc[ai][bj][m][1];
                    u32x4 w; w.x = pk2(v0[0], v0[1]); w.y = pk2(v0[2], v0[3]); w.z = pk2(v1[0], v1[1]); w.w = pk2(v1[2], v1[3]);
                    *(u32x4*)(rowp + bj * HALF) = w; } }
    }
};
struct EpiResF32 {
    static constexpr bool PERM = false, AFTER_DRAIN = false;
    float* C; int ldc; const float* base; float alpha;
    __device__ __forceinline__ void operator()(const f32x4 (&acc)[2][2][4][2], const Unit& u, int wr, int wc, int fr, int fq) const {
        const int row0 = u.pm * BM + wr * 64 + fr, col0 = u.pn * BM + wc * 32 + 4 * fq;
#pragma unroll
        for (int ai = 0; ai < 2; ++ai)
#pragma unroll
            for (int m = 0; m < 4; ++m) { const size_t ro = (size_t)(row0 + ai * HALF + m * 16) * ldc + col0;
#pragma unroll
                for (int bj = 0; bj < 2; ++bj)
#pragma unroll
                    for (int n = 0; n < 2; ++n) { const f32x4 b = *(const f32x4*)(base + ro + bj * HALF + n * 16);
                        *(f32x4*)(C + ro + bj * HALF + n * 16) = acc[ai][bj][m][n] + b * alpha; } }
    }
};
struct EpiProjRot {
    static constexpr bool PERM = true, AFTER_DRAIN = false;
    bf16_t* O; int ldc; int rot_lo, rot_hi; const float* cs; const float* sn; int seq_mask;
    __device__ __forceinline__ void operator()(const f32x4 (&acc)[2][2][4][2], const Unit& u, int wr, int wc, int fr, int fq) const {
        const int row0 = u.pm * BM + wr * 64 + fr, colt = u.pn * BM, col0 = colt + wc * 32 + 8 * fq;
        const bool rot = (colt >= rot_lo) && (colt < rot_hi);
#pragma unroll
        for (int ai = 0; ai < 2; ++ai)
#pragma unroll
            for (int m = 0; m < 4; ++m) { const int row = row0 + ai * HALF + m * 16; bf16_t* rowp = O + (size_t)row * ldc;
#pragma unroll
                for (int bj = 0; bj < 2; ++bj) { const f32x4 v0 = acc[ai][bj][m][0], v1 = acc[ai][bj][m][1];
                    if (!rot) { u32x4 w; w.x = pk2(v0[0], v0[1]); w.y = pk2(v0[2], v0[3]); w.z = pk2(v1[0], v1[1]); w.w = pk2(v1[2], v1[3]);
                        *(u32x4*)(rowp + col0 + bj * HALF) = w; }
                    else { const int d0 = 16 * wc + 4 * fq;
                        const f32x4 c4 = *(const f32x4*)(cs + (size_t)(row & seq_mask) * 64 + d0), s4 = *(const f32x4*)(sn + (size_t)(row & seq_mask) * 64 + d0);
                        const f32x4 lo = v0 * c4 - v1 * s4, hi = v1 * c4 + v0 * s4;
                        uint2 wl, wh; wl.x = pk2(lo[0], lo[1]); wl.y = pk2(lo[2], lo[3]); wh.x = pk2(hi[0], hi[1]); wh.y = pk2(hi[2], hi[3]);
                        bf16_t* hp = rowp + colt + bj * HALF + d0;
                        *(uint2*)hp = wl; *(uint2*)(hp + 64) = wh; } } }
    }
};
struct EpiResBf16 {
    static constexpr bool PERM = true, AFTER_DRAIN = false;
    bf16_t* O; int ldc; const bf16_t* base; float alpha;
    __device__ __forceinline__ void operator()(const f32x4 (&acc)[2][2][4][2], const Unit& u, int wr, int wc, int fr, int fq) const {
        const int row0 = u.pm * BM + wr * 64 + fr, col0 = u.pn * BM + wc * 32 + 8 * fq;
#pragma unroll
        for (int ai = 0; ai < 2; ++ai)
#pragma unroll
            for (int m = 0; m < 4; ++m) { const size_t ro = (size_t)(row0 + ai * HALF + m * 16) * ldc + col0;
#pragma unroll
                for (int bj = 0; bj < 2; ++bj) { const f32x4 v0 = acc[ai][bj][m][0], v1 = acc[ai][bj][m][1];
                    const u32x4 xb4 = *(const u32x4*)(base + ro + bj * HALF);
                    u32x4 w;
                    w.x = pk2(v0[0] + alpha * __uint_as_float(xb4.x << 16), v0[1] + alpha * __uint_as_float(xb4.x & 0xffff0000u));
                    w.y = pk2(v0[2] + alpha * __uint_as_float(xb4.y << 16), v0[3] + alpha * __uint_as_float(xb4.y & 0xffff0000u));
                    w.z = pk2(v1[0] + alpha * __uint_as_float(xb4.z << 16), v1[1] + alpha * __uint_as_float(xb4.z & 0xffff0000u));
                    w.w = pk2(v1[2] + alpha * __uint_as_float(xb4.w << 16), v1[3] + alpha * __uint_as_float(xb4.w & 0xffff0000u));
                    *(u32x4*)(O + ro + bj * HALF) = w; } }
    }
};

template <class Epi, class Sched, bool STAMP = false>
__device__ __forceinline__ void gemm_phase(PG8_LAS unsigned char* lds, const Gemm g, const Sched& S, const Epi& E, unsigned long long* stamps, const int wid) {
    const int lane = mk_lane_id(), tid = wid * 64 + lane, wr = wid >> 2, wc = wid & 3, fr = lane & 15, fq = lane >> 4;
    const int K = g.K, nt = K / BK;
    int ts_lo = 0, ts_hi = 0, nts = 0; const unsigned long long rt_entry = STAMP ? (unsigned long long)wall_clock64() : 0ull;
#define PG8_STAMP() do { if (STAMP && wid == 0 && nts < 64) { const unsigned long long _c = (unsigned long long)clock64(); \
        ts_lo = (lane == nts) ? (int)(unsigned)_c : ts_lo; ts_hi = (lane == nts) ? (int)(unsigned)(_c >> 32) : ts_hi; ++nts; } } while (0)
    PG8_STAMP();
    unsigned voffA[2], voffB[2];
#pragma unroll
    for (int i = 0; i < 2; ++i) { int R, C; stage_rc(tid * 16 + i * 8192, R, C); const int Rb = Epi::PERM ? ((R & ~31) + perm32(R & 31)) : R;
        voffA[i] = (unsigned)(R * K + C) * 2u; voffB[i] = (unsigned)(Rb * K + C) * 2u; }
    const size_t kstep = (size_t)(BK * 2);
    const size_t hstep = (size_t)HALF * K * 2;
    const size_t tstep = 2 * hstep;
    const unsigned ldsw = (unsigned)wid * 1024u;
    const int aoff = lds_byte(wr * 64 + fr, fq * 8), boff = lds_byte(wc * 32 + fr, fq * 8);
#define PG8_SA(b, h) (((b) * 2 + (h)) * HTB)
#define PG8_SB(b, h) ((4 + (b) * 2 + (h)) * HTB)
#define PG8_STAGE(bufoff, gbase, voff) do { _Pragma("unroll") for (int _i = 0; _i < 2; ++_i) \
        __builtin_amdgcn_global_load_lds((const unsigned*)((const char*)(gbase) + (voff)[_i]), (PG8_LAS unsigned*)(lds + (bufoff) + ldsw + _i * 8192), 16, 0, 0); } while (0)
#define PG8_LDA(dst, b, h) do { _Pragma("unroll") for (int m = 0; m < 4; ++m) _Pragma("unroll") for (int k = 0; k < 2; ++k) dst[m][k] = *(const PG8_LAS bf16x8*)(lds + PG8_SA(b, h) + aoff + m * 2048 + k * 1024); } while (0)
#define PG8_LDB(dst, b, h) do { _Pragma("unroll") for (int n = 0; n < 2; ++n) _Pragma("unroll") for (int k = 0; k < 2; ++k) dst[n][k] = *(const PG8_LAS bf16x8*)(lds + PG8_SB(b, h) + boff + n * 2048 + k * 1024); } while (0)
#define PG8_MMA(ai, bj, At, Bt) do { __builtin_amdgcn_s_setprio(1); _Pragma("unroll") for (int m = 0; m < 4; ++m) _Pragma("unroll") for (int n = 0; n < 2; ++n) _Pragma("unroll") for (int k = 0; k < 2; ++k) \
        acc[ai][bj][m][n] = __builtin_amdgcn_mfma_f32_16x16x32_bf16(Bt[n][k], At[m][k], acc[ai][bj][m][n], 0, 0, 0); __builtin_amdgcn_s_setprio(0); } while (0)
#define PG8_WAIT_V(n) asm volatile("s_waitcnt vmcnt(" #n ")" ::: "memory")
#define PG8_WAIT_L(n) asm volatile("s_waitcnt lgkmcnt(" #n ")" ::: "memory")
#define PG8_BAR __builtin_amdgcn_s_barrier()
#define PG8_SCHED __builtin_amdgcn_sched_barrier(0)
    Unit cur, nxt; int ui = 0;
    if (!S.next(0, cur)) return;
    f32x4 acc[2][2][4][2];
#pragma unroll
    for (int a = 0; a < 2; ++a)
#pragma unroll
        for (int b = 0; b < 2; ++b)
#pragma unroll
            for (int m = 0; m < 4; ++m)
#pragma unroll
                for (int n = 0; n < 2; ++n) acc[a][b][m][n] = (f32x4){0.f, 0.f, 0.f, 0.f};
    bf16x8 At[4][2], B0[2][2], B1[2][2];
    const char* cA = (const char*)g.A + (size_t)cur.pm * tstep; const char* cB = (const char*)g.Bt + (size_t)cur.pn * tstep;
    S.a_ready(cur);
    PG8_STAGE(PG8_SB(0, 0), cB, voffB); PG8_STAGE(PG8_SA(0, 0), cA, voffA); PG8_STAGE(PG8_SB(0, 1), cB + hstep, voffB); PG8_STAGE(PG8_SA(0, 1), cA + hstep, voffA);
    if (wr == 1) PG8_BAR;
    PG8_WAIT_V(4); PG8_BAR;
    PG8_STAGE(PG8_SB(1, 0), cB + kstep, voffB); PG8_STAGE(PG8_SA(1, 0), cA + kstep, voffA); PG8_STAGE(PG8_SB(1, 1), cB + hstep + kstep, voffB);
    PG8_WAIT_V(6); PG8_BAR;
    PG8_STAMP();
    for (;;) {
        const bool has_next = S.next(ui + 1, nxt);
        const char* nA = has_next ? (const char*)g.A + (size_t)nxt.pm * tstep : cA; const char* nB = has_next ? (const char*)g.Bt + (size_t)nxt.pn * tstep : cB;
        for (int t = 0; t < nt; t += 2) {
            const bool last = (t == nt - 2);
            const char* a1 = cA + (size_t)(t + 1) * kstep;
            const char* a2 = last ? nA : cA + (size_t)(t + 2) * kstep; const char* b2 = last ? nB : cB + (size_t)(t + 2) * kstep;
            const char* a3 = a2 + kstep; const char* b3 = b2 + kstep;
            if (last && has_next) S.a_ready(nxt);
            PG8_LDB(B0, 0, 0); PG8_SCHED; PG8_LDA(At, 0, 0); PG8_STAGE(PG8_SA(1, 1), a1 + hstep, voffA);
            PG8_WAIT_L(8); PG8_BAR; PG8_WAIT_L(0); PG8_MMA(0, 0, At, B0); PG8_BAR; PG8_SCHED;
            PG8_LDB(B1, 0, 1); PG8_STAGE(PG8_SB(0, 0), b2, voffB);
            PG8_BAR; PG8_WAIT_L(0); PG8_MMA(0, 1, At, B1); PG8_BAR;
            PG8_LDA(At, 0, 1); PG8_STAGE(PG8_SA(0, 0), a2, voffA);
            PG8_BAR; PG8_WAIT_L(0); PG8_MMA(1, 0, At, B0); PG8_BAR; PG8_SCHED;
            PG8_STAGE(PG8_SB(0, 1), b2 + hstep, voffB);
            PG8_WAIT_V(6); PG8_BAR; PG8_MMA(1, 1, At, B1); PG8_BAR;
            PG8_LDB(B0, 1, 0); PG8_SCHED; PG8_LDA(At, 1, 0); PG8_STAGE(PG8_SA(0, 1), a2 + hstep, voffA);
            PG8_WAIT_L(8); PG8_BAR; PG8_WAIT_L(0); PG8_MMA(0, 0, At, B0); PG8_BAR; PG8_SCHED;
            PG8_LDB(B1, 1, 1); PG8_STAGE(PG8_SB(1, 0), b3, voffB);
            PG8_BAR; PG8_WAIT_L(0); PG8_MMA(0, 1, At, B1); PG8_BAR;
            PG8_LDA(At, 1, 1); PG8_STAGE(PG8_SA(1, 0), a3, voffA);
            PG8_BAR; PG8_WAIT_L(0); PG8_MMA(1, 0, At, B0); PG8_BAR; PG8_SCHED;
            PG8_STAGE(PG8_SB(1, 1), b3 + hstep, voffB);
            PG8_WAIT_V(6); PG8_BAR; PG8_MMA(1, 1, At, B1); PG8_BAR;
        }
        PG8_STAMP();
        if constexpr (!Epi::AFTER_DRAIN) { E(acc, cur, wr, wc, fr, fq); S.done(cur); }
        PG8_STAMP();
        if (!has_next) break;
#pragma unroll
        for (int a = 0; a < 2; ++a)
#pragma unroll
            for (int b = 0; b < 2; ++b)
#pragma unroll
                for (int m = 0; m < 4; ++m)
#pragma unroll
                    for (int n = 0; n < 2; ++n) acc[a][b][m][n] = (f32x4){0.f, 0.f, 0.f, 0.f};
        cur = nxt; cA = nA; cB = nB; ++ui;
    }
    PG8_WAIT_V(0);
    if (wr == 0) PG8_BAR;
    PG8_BAR;
    if constexpr (Epi::AFTER_DRAIN) { E.fused(acc, cur, wr, wc, fr, fq, lds, wid, lane); S.done(cur); }
    PG8_STAMP();
    if (STAMP && wid == 0) { stamps[lane] = lane < nts ? (((unsigned long long)(unsigned)ts_hi << 32) | (unsigned)ts_lo) : 0ull;
        if (lane == 62) stamps[62] = rt_entry; if (lane == 63) stamps[63] = (unsigned long long)wall_clock64(); }
#undef PG8_STAMP
#undef PG8_SA
#undef PG8_SB
#undef PG8_STAGE
#undef PG8_LDA
#undef PG8_LDB
#undef PG8_MMA
#undef PG8_WAIT_V
#undef PG8_WAIT_L
#undef PG8_BAR
#undef PG8_SCHED
}
}
#define XB_TMO      128
#define XB_XCNT(j)  (256  + 64 * (j))
#define XB_XSUB(j)  (1280 + 64 * (j))
#define XB_XGEN(j)  (2304 + 64 * (j))
#define XB_TOP      3328
#define XB_TOPGEN   3392
#define XCD_BAR_WORDS 3456
#define XB_SPIN_CAP (1u << 18)
#define LAS __attribute__((address_space(3)))

__device__ __forceinline__ unsigned xb_ld(unsigned* p)              { return __hip_atomic_load(p, __ATOMIC_RELAXED, __HIP_MEMORY_SCOPE_AGENT); }
__device__ __forceinline__ unsigned xb_add(unsigned* p, unsigned v) { return __hip_atomic_fetch_add(p, v, __ATOMIC_RELAXED, __HIP_MEMORY_SCOPE_AGENT); }
__device__ __forceinline__ unsigned xb_xcc_id() { return (unsigned)__builtin_amdgcn_s_getreg((3 << 11) | 20) & 0xFu; }
#define XB_SPIN(cond, bar) do { unsigned _sp = 0; while (cond) { __builtin_amdgcn_s_sleep(1); \
    if ((++_sp & 255u) == 0u) { if (xb_ld(&(bar)[XB_TMO])) break; if (_sp > XB_SPIN_CAP) { atomicAdd(&(bar)[XB_TMO], 1u); break; } } } } while (0)

struct XcdBarrier {
    unsigned wave;
    unsigned* bar; unsigned x;
    volatile LAS unsigned* st;
};

__device__ __forceinline__ XcdBarrier xcd_barrier_post(unsigned* bar, volatile LAS unsigned* st, unsigned wave) {
    XcdBarrier b; b.wave = wave; b.bar = bar; b.x = xb_xcc_id(); b.st = st;
    if (wave == 0u && mk_lane_id() == 0) (void)xb_add(&bar[XB_XCNT(b.x)], 1u);
    return b;
}
__device__ __forceinline__ void xcd_barrier_complete(unsigned* bar, unsigned x, unsigned& nloc, unsigned& nx) {
    const unsigned G = gridDim.x * gridDim.y * gridDim.z;
    unsigned sum, cnt, mine, sp = 0u;
    for (;;) {
        sum = 0u; cnt = 0u; mine = 0u;
#pragma unroll
        for (unsigned j = 0; j < 16; ++j) { const unsigned c = xb_ld(&bar[XB_XCNT(j)]); sum += c; cnt += (c > 0u) ? 1u : 0u; mine = (j == x) ? c : mine; }
        if (sum == G) break;
        __builtin_amdgcn_s_sleep(1);
        if ((++sp & 255u) == 0u) { if (xb_ld(&bar[XB_TMO])) break; if (sp > XB_SPIN_CAP) { atomicAdd(&bar[XB_TMO], 1u); break; } }
    }
    nloc = mine > 0u ? mine : 1u; nx = cnt > 0u ? cnt : 1u;
}

__device__ __forceinline__ void xcd_barrier(const XcdBarrier& b) {
    asm volatile("s_waitcnt vmcnt(0)" ::: "memory");
    __syncthreads();
    if (b.wave == 0u && mk_lane_id() == 0) {
        unsigned* bar = b.bar;
        __builtin_amdgcn_s_waitcnt(0);
        unsigned nloc = b.st[0], nx = b.st[1];
        if (nloc == 0u) { xcd_barrier_complete(bar, b.x, nloc, nx); b.st[0] = nloc; b.st[1] = nx; }
        const unsigned old = xb_add(&bar[XB_XSUB(b.x)], 1u);
        const unsigned gen = old / nloc;
        if (old + 1u == (gen + 1u) * nloc) {
            __builtin_amdgcn_fence(__ATOMIC_RELEASE, "agent");
            asm volatile("s_waitcnt vmcnt(0)" ::: "memory");
            const unsigned og = xb_add(&bar[XB_TOP], 1u);
            const unsigned tg = og / nx;
            if (og + 1u == (tg + 1u) * nx) xb_add(&bar[XB_TOPGEN], 1u);
            else XB_SPIN(xb_ld(&bar[XB_TOPGEN]) == tg, bar);
            __builtin_amdgcn_fence(__ATOMIC_ACQUIRE, "agent");
            xb_add(&bar[XB_XGEN(b.x)], 1u);
            asm volatile("s_waitcnt vmcnt(0)" ::: "memory");
        } else {
            XB_SPIN(xb_ld(&bar[XB_XGEN(b.x)]) == gen, bar);
            __builtin_amdgcn_fence(__ATOMIC_ACQUIRE, "agent");
            asm volatile("s_waitcnt vmcnt(0)" ::: "memory");
        }
    }
    __syncthreads();
}
namespace mk {
typedef unsigned short bf16_t;
typedef float f32x4 __attribute__((ext_vector_type(4)));
using pg8::pk2;
constexpr int D = 2048, NB = 4, S = 2048, T = NB * S, HD = 128, INW = 7168;
constexpr int NKEYS = 128;
constexpr float ALPHA = 1.189207115002721f;
constexpr int NTHR = 512;
constexpr size_t MiB = (size_t)1 << 20;
constexpr size_t WS_CTL = 0;
constexpr size_t CTL_BYTES = 64 * 1024;
constexpr size_t WS_XB = 1 * MiB;
constexpr size_t WS_WIN = 33 * MiB;
constexpr size_t WS_WOUT = 61 * MiB;
constexpr size_t WS_WPQ = 69 * MiB;
constexpr size_t WS_SKB = 77 * MiB;
constexpr size_t WS_ROT = 78 * MiB;
constexpr size_t WS_PROJ = 80 * MiB;
constexpr size_t WS_MIXED = 192 * MiB;
constexpr size_t WS_Y1 = 224 * MiB;
constexpr size_t WS_X1B = 288 * MiB;
constexpr size_t WS_QP = 320 * MiB;
constexpr size_t WS_EIDX = 352 * MiB;
constexpr size_t WS_EGATE = 356 * MiB;
constexpr size_t WS_PREV = 360 * MiB;
constexpr size_t WS_SE = 392 * MiB;
constexpr size_t WS_SG = 396 * MiB;
constexpr size_t WS_UQ = 417 * MiB;
constexpr size_t WS_VQ = 449 * MiB;
constexpr size_t WS_SU = 400 * MiB;
constexpr size_t WS_SV = 400 * MiB + 65536;
constexpr size_t WS_SX = 400 * MiB + 131072;
constexpr size_t WS_X1Q = 401 * MiB;
constexpr size_t WS_END = 481 * MiB;
constexpr size_t CTL_QUEUE = 32768;
constexpr int LDS_MISC = 2048;
constexpr int LDS_BYTES = pg8::STAGE_BYTES + LDS_MISC;

__device__ __forceinline__ float bflo(unsigned u) { return __uint_as_float(u << 16); }
__device__ __forceinline__ float bfhi(unsigned u) { return __uint_as_float(u & 0xffff0000u); }
__device__ __forceinline__ float wave_sum(float v) {
#pragma unroll
  for (int o = 32; o > 0; o >>= 1) v += __shfl_xor(v, o);
  return v;
}
__device__ __forceinline__ float wave_max(float v) {
#pragma unroll
  for (int o = 32; o > 0; o >>= 1) v = fmaxf(v, __shfl_xor(v, o));
  return v;
}
__device__ __forceinline__ int wave_min_i(int v) {
#pragma unroll
  for (int o = 32; o > 0; o >>= 1) v = min(v, __shfl_xor(v, o));
  return v;
}

struct Ctx {
  const float* in[13];
  float* out;
  unsigned char* ws;
  LAS unsigned char* lds;
  int wave, G;
};

__device__ __forceinline__ void transpose_bf16(const Ctx& c, const float* __restrict__ w, bf16_t* __restrict__ wt, int K, int N, int rot_lo = 0, int rot_hi = 0) {
  LAS float* tile = (LAS float*)c.lds;
  const int ntk = K / 64, ntiles = ntk * (N / 64);
  for (int tile_i = blockIdx.x; tile_i < ntiles; tile_i += c.G) {
    const int k0 = (tile_i % ntk) * 64, n0 = (tile_i / ntk) * 64;
    {
      const int r = (c.wave * 64 + mk_lane_id()) >> 3, c8 = ((c.wave * 64 + mk_lane_id()) & 7) * 8;
      const float4 a = *(const float4*)(w + (size_t)(k0 + r) * N + n0 + c8);
      const float4 b = *(const float4*)(w + (size_t)(k0 + r) * N + n0 + c8 + 4);
      LAS float* p = tile + r * 65 + c8;
      p[0] = a.x; p[1] = a.y; p[2] = a.z; p[3] = a.w; p[4] = b.x; p[5] = b.y; p[6] = b.z; p[7] = b.w;
    }
    __syncthreads();
    {
      const int n = (c.wave * 64 + mk_lane_id()) >> 3, k8 = ((c.wave * 64 + mk_lane_id()) & 7) * 8;
      float v[8];
#pragma unroll
      for (int j = 0; j < 8; ++j) v[j] = tile[(k8 + j) * 65 + n];
      uint4 o; o.x = pk2(v[0], v[1]); o.y = pk2(v[2], v[3]); o.z = pk2(v[4], v[5]); o.w = pk2(v[6], v[7]);
      int nrow = n0 + n;
      if (nrow >= rot_lo && nrow < rot_hi) { const int d = nrow & 127; nrow = (nrow & ~127) + 8 * ((d & 63) >> 2) + (d & 3) + 4 * (d >> 6); }
      *(uint4*)(wt + (size_t)nrow * K + k0 + k8) = o;
    }
    __syncthreads();
  }
}
__device__ __forceinline__ void p0_prologue(const Ctx& c) {
  const size_t gtid = (size_t)blockIdx.x * NTHR + (c.wave * 64 + mk_lane_id()), gstride = (size_t)c.G * NTHR;
  {
    const float4* x4 = (const float4*)c.in[0];
    uint4* xb4 = (uint4*)(c.ws + WS_XB);
    for (size_t i = gtid; i < (size_t)T * D / 8; i += gstride) {
      const float4 a = x4[2 * i], b = x4[2 * i + 1];
      uint4 o; o.x = pk2(a.x, a.y); o.y = pk2(a.z, a.w); o.z = pk2(b.x, b.y); o.w = pk2(b.z, b.w);
      xb4[i] = o;
    }
  }
  transpose_bf16(c, c.in[1], (bf16_t*)(c.ws + WS_WIN), D, INW, 3072, 5120);
  transpose_bf16(c, c.in[4], (bf16_t*)(c.ws + WS_WOUT), D, D);
  transpose_bf16(c, c.in[7], (bf16_t*)(c.ws + WS_WPQ), D, D);
  {
    const float4* s4 = (const float4*)c.in[8];
    uint4* d4 = (uint4*)(c.ws + WS_SKB);
    for (size_t i = gtid; i < (size_t)8 * 2 * 128 * 128 / 8; i += gstride) {
      const float4 a = s4[2 * i], b = s4[2 * i + 1];
      uint4 o; o.x = pk2(a.x, a.y); o.y = pk2(a.z, a.w); o.z = pk2(b.x, b.y); o.w = pk2(b.z, b.w);
      d4[i] = o;
    }
  }
  {
    float* cs = (float*)(c.ws + WS_ROT);
    float* sn = cs + S * 64;
    for (size_t i = gtid; i < (size_t)S * 64; i += gstride) {
      const int s = (int)(i >> 6), f = (int)(i & 63);
      const float inv_freq = (float)pow(10000.0, -(2.0 * f) / 128.0);
      const float ang = (float)s * inv_freq;
      cs[i] = (float)cos((double)ang);
      sn[i] = (float)sin((double)ang);
    }
  }
}

__device__ __forceinline__ void p2_rotate(const Ctx& c) {
  bf16_t* proj = (bf16_t*)(c.ws + WS_PROJ);
  const float* cs = (const float*)(c.ws + WS_ROT);
  const float* sn = cs + S * 64;
  const size_t gtid = (size_t)blockIdx.x * NTHR + (c.wave * 64 + mk_lane_id()), gstride = (size_t)c.G * NTHR;
  for (size_t it = gtid; it < (size_t)T * 128; it += gstride) {
    const int row = (int)(it >> 7), rem = (int)(it & 127);
    const int which = rem >> 6, h = (rem >> 3) & 7, i0 = (rem & 7) * 8;
    const int s = row & (S - 1);
    bf16_t* p = proj + (size_t)row * INW + 3072 + which * 1024 + h * HD + i0;
    const uint4 lo = *(const uint4*)p, hi = *(const uint4*)(p + 64);
    const float4 c0 = *(const float4*)(cs + s * 64 + i0), c1 = *(const float4*)(cs + s * 64 + i0 + 4);
    const float4 s0 = *(const float4*)(sn + s * 64 + i0), s1 = *(const float4*)(sn + s * 64 + i0 + 4);
    const float cv[8] = {c0.x, c0.y, c0.z, c0.w, c1.x, c1.y, c1.z, c1.w};
    const float sv[8] = {s0.x, s0.y, s0.z, s0.w, s1.x, s1.y, s1.z, s1.w};
    const unsigned lw[4] = {lo.x, lo.y, lo.z, lo.w}, hw[4] = {hi.x, hi.y, hi.z, hi.w};
    unsigned ol[4], oh[4];
#pragma unroll
    for (int j = 0; j < 4; ++j) {
      const float l0 = bflo(lw[j]), l1 = bfhi(lw[j]), h0 = bflo(hw[j]), h1 = bfhi(hw[j]);
      const float nl0 = l0 * cv[2 * j] - h0 * sv[2 * j], nl1 = l1 * cv[2 * j + 1] - h1 * sv[2 * j + 1];
      const float nh0 = h0 * cv[2 * j] + l0 * sv[2 * j], nh1 = h1 * cv[2 * j + 1] + l1 * sv[2 * j + 1];
      ol[j] = pk2(nl0, nl1); oh[j] = pk2(nh0, nh1);
    }
    uint4 a; a.x = ol[0]; a.y = ol[1]; a.z = ol[2]; a.w = ol[3];
    uint4 b; b.x = oh[0]; b.y = oh[1]; b.z = oh[2]; b.w = oh[3];
    *(uint4*)p = a; *(uint4*)(p + 64) = b;
  }
}

__device__ __forceinline__ void quant_rows(const Ctx& c, int rr0, int nrows) {
  const int lane = mk_lane_id();
  const int rend = rr0 + nrows;
  f32x4 va[8], vb[8];
#define QR_LOAD(V, RR) do { const int rr_ = (RR) < rend ? (RR) : rend - 1; const float* src_ = ((rr_ >> 14) ? c.in[10] : c.in[9]) + (size_t)(rr_ & 16383) * D; \
    _Pragma("unroll") for (int i_ = 0; i_ < 8; ++i_) V[i_] = *(const f32x4*)(src_ + (i_ * 64 + lane) * 4); } while (0)
#define QR_DO(V, RR) do { if ((RR) < rend) { const int which_ = (RR) >> 14, row_ = (RR) & 16383; float mx_ = 0.f; \
    _Pragma("unroll") for (int i_ = 0; i_ < 8; ++i_) mx_ = fmaxf(mx_, fmaxf(fmaxf(fabsf(V[i_][0]), fabsf(V[i_][1])), fmaxf(fabsf(V[i_][2]), fabsf(V[i_][3])))); \
    mx_ = fmaxf(wave_max(mx_), 1e-30f); const float inv_ = 127.f / mx_; const int off_ = which_ ? 128 : 0; \
    unsigned* dst_ = (unsigned*)(c.ws + (which_ ? WS_VQ : WS_UQ) + (size_t)row_ * D); \
    _Pragma("unroll") for (int i_ = 0; i_ < 8; ++i_) { unsigned w_ = 0; \
      _Pragma("unroll") for (int k_ = 0; k_ < 4; ++k_) { const int q_ = (int)rintf(V[i_][k_] * inv_) + off_; w_ |= ((unsigned)q_ & 255u) << (8 * k_); } \
      dst_[i_ * 64 + lane] = w_; } \
    if (lane == 0) ((float*)(c.ws + (which_ ? WS_SV : WS_SU)))[row_] = mx_ * (1.f / 127.f); } } while (0)
  QR_LOAD(va, rr0); QR_LOAD(vb, rr0 + 1);
  for (int rr = rr0; rr < rend; rr += 2) {
    QR_DO(va, rr); QR_LOAD(va, rr + 2);
    QR_DO(vb, rr + 1); QR_LOAD(vb, rr + 3);
  }
#undef QR_LOAD
#undef QR_DO
}

__device__ __forceinline__ void p3_attn_naive(const Ctx& c) {
  const bf16_t* proj = (const bf16_t*)(c.ws + WS_PROJ);
  bf16_t* mixed = (bf16_t*)(c.ws + WS_MIXED);
  const float* sbw = c.in[2];
  const float* rnw = c.in[3];
  const int lane = mk_lane_id(), gw = blockIdx.x * 8 + c.wave, NW = c.G * 8;
  const float scale = 0.08838834764831845f;
  for (int r = gw; r < NB * 8 * S; r += NW) {
    const int bh = r >> 11, t = r & (S - 1), b = bh >> 3, h = bh & 7;
    const bf16_t* base = proj + (size_t)b * S * INW + h * HD + lane * 2;
    const unsigned qw = *(const unsigned*)(base + (size_t)t * INW);
    const float qx = bflo(qw), qy = bfhi(qw);
    float ox = 0.f, oy = 0.f, run = 0.f;
    for (int s = t - 1; s >= 0; --s) {
      const unsigned kw = *(const unsigned*)(base + (size_t)s * INW + 1024);
      const unsigned vw = *(const unsigned*)(base + (size_t)s * INW + 2048);
      const float z = wave_sum(qx * bflo(kw) + qy * bfhi(kw)) * scale;
      const float l1p = log1pf(expf(-fabsf(z)));
      const float sp = fmaxf(z, 0.f) + l1p;
      const float ls = fminf(z, 0.f) - l1p;
      const float a = expf(ls - run);
      ox += a * bflo(vw); oy += a * bfhi(vw);
      run += sp;
      if (run > 104.f) break;
    }
    const float ms = wave_sum(ox * ox + oy * oy) * (1.f / 128.f);
    const float rr = rsqrtf(ms + 1e-6f);
    const float2 wv = *(const float2*)(sbw + h * HD + lane * 2);
    *(unsigned*)(mixed + (size_t)(b * S + t) * D + h * HD + lane * 2) = pk2(ox * rr * wv.x, oy * rr * wv.y);
  }
  for (int r = gw; r < NB * 8 * S; r += NW) {
    const int bh = r >> 11, tt = r & (S - 1), b = bh >> 3, h = bh & 7;
    const int t = (bh & 1) ? (S - 1 - tt) : tt;
    const bf16_t* base = proj + (size_t)b * S * INW + h * HD + lane * 2;
    const unsigned qw = *(const unsigned*)(base + (size_t)t * INW + 3072);
    const float qx = bflo(qw), qy = bfhi(qw);
    const float log_g = log1pf(-exp2f(-5.f - (float)h));
    const int s_end = ((t >> 6) + 1) << 6;
    float ox = 0.f, oy = 0.f;
    for (int s = 0; s < s_end; ++s) {
      const unsigned kw = *(const unsigned*)(base + (size_t)s * INW + 4096);
      const unsigned vw = *(const unsigned*)(base + (size_t)s * INW + 5120);
      const float dist = fabsf((float)(t - s));
      const float z = wave_sum(qx * bflo(kw) + qy * bfhi(kw)) * scale * expf(log_g * dist);
      ox += z * bflo(vw); oy += z * bfhi(vw);
    }
    const float mu = wave_sum(ox + oy) * (1.f / 128.f);
    const float dx = ox - mu, dy = oy - mu;
    const float var = wave_sum(dx * dx + dy * dy) * (1.f / 128.f);
    const float rr = rsqrtf(var + 1e-6f);
    const float2 wv = *(const float2*)(rnw + h * HD + lane * 2);
    const unsigned gwd = *(const unsigned*)(base + (size_t)t * INW + 6144);
    const float gx = bflo(gwd), gy = bfhi(gwd);
    const float sx = gx / (1.f + expf(-gx)), sy = gy / (1.f + expf(-gy));
    *(unsigned*)(mixed + (size_t)(b * S + t) * D + 1024 + h * HD + lane * 2) = pk2(dx * rr * wv.x * sx, dy * rr * wv.y * sy);
  }
}

typedef short bf16x8 __attribute__((ext_vector_type(8)));
typedef short s16x4 __attribute__((ext_vector_type(4)));
typedef float f32x16 __attribute__((ext_vector_type(16)));
typedef unsigned u32x4 __attribute__((ext_vector_type(4)));
#define MFMA32(a, b, c) __builtin_amdgcn_mfma_f32_32x32x16_bf16((a), (b), (c), 0, 0, 0)
constexpr int WAVE_LDS = 10240;
constexpr int VRS = 320;
constexpr float SCALE = 0.08838834764831845f;
constexpr float LOG2E = 1.4426950408889634f;
__device__ __forceinline__ int crow(int reg, int h) { return (reg & 3) + 8 * (reg >> 2) + 4 * h; }
__device__ __forceinline__ int krow(int s, int h, int j) { return 16 * s + 8 * (j >> 2) + 4 * h + (j & 3); }
__device__ __forceinline__ bf16x8 pack8(const f32x16& x, const int s) {
  u32x4 p;
  p[0] = pk2(x[8 * s + 0], x[8 * s + 1]); p[1] = pk2(x[8 * s + 2], x[8 * s + 3]);
  p[2] = pk2(x[8 * s + 4], x[8 * s + 5]); p[3] = pk2(x[8 * s + 6], x[8 * s + 7]);
  return __builtin_bit_cast(bf16x8, p);
}
__device__ __forceinline__ s16x4 tr16(LAS unsigned char* p) { return __builtin_amdgcn_ds_read_tr16_b64_v4i16((LAS s16x4*)p); }
__device__ __forceinline__ bf16x8 cat8(s16x4 lo, s16x4 hi) { return __builtin_shufflevector(lo, hi, 0, 1, 2, 3, 4, 5, 6, 7); }
__device__ __forceinline__ void wave_lds_fence() { asm volatile("s_waitcnt lgkmcnt(0)" ::: "memory"); }
__device__ __forceinline__ float half_sum(float v) {
#pragma unroll
  for (int o = 16; o > 0; o >>= 1) v += __shfl_xor(v, o);
  return v;
}
__device__ __forceinline__ void vtile_load(u32x4 (&vr)[8], const bf16_t* vbase, int lane) {
#pragma unroll
  for (int it = 0; it < 8; ++it) vr[it] = *(const u32x4*)(vbase + (size_t)(4 * it + (lane >> 4)) * INW + (lane & 15) * 8);
}
__device__ __forceinline__ void vtile_store(const u32x4 (&vr)[8], LAS unsigned char* wl, int lane) {
#pragma unroll
  for (int it = 0; it < 8; ++it) *(LAS u32x4*)(wl + (4 * it + (lane >> 4)) * VRS + (lane & 15) * 16) = vr[it];
}
__device__ __forceinline__ void pv_accum(f32x16 (&o)[4], const f32x16& a, LAS unsigned char* wl, int lane) {
  const int h = lane >> 5, i16 = lane & 15, q = i16 >> 2, p = i16 & 3, blk = (lane >> 4) & 1;
  const bf16x8 pa0 = pack8(a, 0), pa1 = pack8(a, 1);
  LAS unsigned char* b0 = wl + (4 * h + q) * VRS + (16 * blk + 4 * p) * 2;
#pragma unroll
  for (int cidx = 0; cidx < 4; ++cidx) {
#pragma unroll
    for (int s = 0; s < 2; ++s) {
      const s16x4 lo = tr16(b0 + (16 * s) * VRS + cidx * 64);
      const s16x4 hi = tr16(b0 + (16 * s + 8) * VRS + cidx * 64);
      o[cidx] = MFMA32(s == 0 ? pa0 : pa1, cat8(lo, hi), o[cidx]);
    }
  }
}

__device__ __forceinline__ void sb_task(const Ctx& c, int task, LAS unsigned char* wl) {
  const bf16_t* proj = (const bf16_t*)(c.ws + WS_PROJ);
  bf16_t* mixed = (bf16_t*)(c.ws + WS_MIXED);
  const float* sbw = c.in[2];
  const int lane = mk_lane_id(), r = lane & 31, h = lane >> 5;
  const int qb = task & 63, bh = task >> 6, b = bh >> 3, hd = bh & 7, q0 = qb * 32;
  const bf16_t* base = proj + (size_t)b * S * INW + hd * HD;
  bf16x8 qf[8];
#pragma unroll
  for (int s = 0; s < 8; ++s) qf[s] = *(const bf16x8*)(base + (size_t)(q0 + r) * INW + 16 * s + 8 * h);
  bf16x8 tf[2];
#pragma unroll
  for (int s = 0; s < 2; ++s)
#pragma unroll
    for (int jj = 0; jj < 8; ++jj) tf[s][jj] = (krow(s, h, jj) > r) ? (short)0x3F80 : (short)0;
  f32x16 o[4];
#pragma unroll
  for (int cidx = 0; cidx < 4; ++cidx)
#pragma unroll
    for (int i = 0; i < 16; ++i) o[cidx][i] = 0.f;
  float R = 0.f;
  const float c2 = SCALE * LOG2E;
  for (int k0 = q0; k0 >= 0; k0 -= 32) {
    u32x4 vr[8];
    vtile_load(vr, base + 2048 + (size_t)k0 * INW, lane);
    f32x16 st;
#pragma unroll
    for (int i = 0; i < 16; ++i) st[i] = 0.f;
#pragma unroll
    for (int s = 0; s < 8; ++s) {
      const bf16x8 kf = *(const bf16x8*)(base + 1024 + (size_t)(k0 + r) * INW + 16 * s + 8 * h);
      st = MFMA32(kf, qf[s], st);
    }
    const bool diag = (k0 == q0);
    f32x16 sp, m;
#pragma unroll
    for (int i = 0; i < 16; ++i) {
      const float y = st[i] * c2;
      const float e = __builtin_amdgcn_exp2f(-fabsf(y));
      const float l = __builtin_amdgcn_logf(1.f + e);
      const bool valid = !diag || (crow(i, h) < r);
      sp[i] = valid ? (fmaxf(y, 0.f) + l) : 0.f;
      st[i] = y; m[i] = R;
    }
    m = MFMA32(tf[0], pack8(sp, 0), m);
    m = MFMA32(tf[1], pack8(sp, 1), m);
    f32x16 a;
#pragma unroll
    for (int i = 0; i < 16; ++i) {
      const bool valid = !diag || (crow(i, h) < r);
      const float v = __builtin_amdgcn_exp2f(st[i] - sp[i] - m[i]);
      a[i] = valid ? v : 0.f;
    }
    R = __shfl(m[0] + sp[0], r);
    vtile_store(vr, wl, lane);
    wave_lds_fence();
    pv_accum(o, a, wl, lane);
    if (__all(R > 150.5f)) break;
  }
#pragma unroll
  for (int i = 0; i < 16; ++i) {
    const float ss = half_sum(o[0][i] * o[0][i] + o[1][i] * o[1][i] + o[2][i] * o[2][i] + o[3][i] * o[3][i]);
    const float rr = rsqrtf(ss * (1.f / 128.f) + 1e-6f);
    bf16_t* orow = mixed + (size_t)(b * S + q0 + crow(i, h)) * D + hd * HD + r;
#pragma unroll
    for (int cidx = 0; cidx < 4; ++cidx) orow[32 * cidx] = (bf16_t)(pk2(o[cidx][i] * rr * sbw[hd * HD + 32 * cidx + r], 0.f) & 0xffffu);
  }
}

__device__ __forceinline__ void state_task(const Ctx& c, int task, LAS unsigned char* wl) {
  const bf16_t* proj = (const bf16_t*)(c.ws + WS_PROJ);
  bf16_t* prevT = (bf16_t*)(c.ws + WS_PREV);
  const int lane = mk_lane_id(), r = lane & 31, h = lane >> 5;
  const int vblk = task & 3, dblk = (task >> 2) & 3, bh = task >> 4, b = bh >> 3, hd = bh & 7;
  const bf16_t* kbase = proj + (size_t)b * S * INW + 4096 + hd * HD + 32 * dblk;
  const bf16_t* vbase = proj + (size_t)b * S * INW + 5120 + hd * HD + 32 * vblk;
  const float log2g = __builtin_amdgcn_logf(1.f - exp2f(-5.f - (float)hd));
  const float cd = exp2f(log2g * 64.f);
  f32x16 acc;
#pragma unroll
  for (int i = 0; i < 16; ++i) acc[i] = 0.f;
  const int i16 = lane & 15, q = i16 >> 2, p = i16 & 3, blk = (lane >> 4) & 1;
  LAS unsigned char* kt = wl;
  LAS unsigned char* vt = wl + 4096;
  const int toff = (8 * h + q) * 64 + (16 * blk + 4 * p) * 2;
  constexpr int SD = 2;
  u32x4 kq[SD][4], vv[SD][4];
#define ST_ISSUE(SL, N) do { const int n_ = (N) < S / 64 ? (N) : S / 64 - 1; _Pragma("unroll") for (int it_ = 0; it_ < 4; ++it_) { \
      const int idx_ = it_ * 64 + lane, row_ = idx_ >> 2, ch_ = idx_ & 3; \
      kq[SL][it_] = *(const u32x4*)(kbase + (size_t)(n_ * 64 + row_) * INW + 8 * ch_); \
      vv[SL][it_] = *(const u32x4*)(vbase + (size_t)(n_ * 64 + row_) * INW + 8 * ch_); } } while (0)
#pragma unroll
  for (int sl = 0; sl < SD; ++sl) ST_ISSUE(sl, sl);
#pragma unroll 1
  for (int n0 = 0; n0 < S / 64; n0 += SD) {
#pragma unroll
    for (int sl = 0; sl < SD; ++sl) {
      const int n = n0 + sl;
      bf16_t* pp = prevT + ((size_t)(bh * 32 + n) * 128 + 32 * vblk + r) * 128 + 32 * dblk + 4 * h;
#pragma unroll
      for (int g = 0; g < 4; ++g) {
        uint2 w; w.x = pk2(acc[4 * g], acc[4 * g + 1]); w.y = pk2(acc[4 * g + 2], acc[4 * g + 3]);
        *(uint2*)(pp + 8 * g) = w;
      }
#pragma unroll
      for (int it = 0; it < 4; ++it) {
        const int idx = it * 64 + lane, row = idx >> 2, ch = idx & 3;
        *(LAS u32x4*)(kt + row * 64 + ch * 16) = kq[sl][it];
        *(LAS u32x4*)(vt + row * 64 + ch * 16) = vv[sl][it];
      }
      ST_ISSUE(sl, n + SD);
      wave_lds_fence();
#pragma unroll
      for (int i = 0; i < 16; ++i) acc[i] *= cd;
#pragma unroll
      for (int s = 0; s < 4; ++s) {
        const s16x4 klo = tr16(kt + toff + (16 * s) * 64), khi = tr16(kt + toff + (16 * s + 4) * 64);
        const s16x4 vlo = tr16(vt + toff + (16 * s) * 64), vhi = tr16(vt + toff + (16 * s + 4) * 64);
        const u32x4 kraw = __builtin_bit_cast(u32x4, cat8(klo, khi));
        u32x4 ks;
#pragma unroll
        for (int jj = 0; jj < 4; ++jj) {
          const float z0 = SCALE * __builtin_amdgcn_exp2f(log2g * (float)(63 - (16 * s + 8 * h + 2 * jj)));
          const float z1 = SCALE * __builtin_amdgcn_exp2f(log2g * (float)(63 - (16 * s + 8 * h + 2 * jj + 1)));
          ks[jj] = pk2(bflo(kraw[jj]) * z0, bfhi(kraw[jj]) * z1);
        }
        acc = MFMA32(__builtin_bit_cast(bf16x8, ks), cat8(vlo, vhi), acc);
      }
    }
  }
#undef ST_ISSUE
}

__device__ __forceinline__ void retout_task(const Ctx& c, int task, LAS unsigned char* wl) {
  const bf16_t* proj = (const bf16_t*)(c.ws + WS_PROJ);
  const bf16_t* prevT = (const bf16_t*)(c.ws + WS_PREV);
  bf16_t* mixed = (bf16_t*)(c.ws + WS_MIXED);
  const float* rnw = c.in[3];
  const int lane = mk_lane_id(), r = lane & 31, h = lane >> 5;
  const int half = task & 1, n = (task >> 1) & 31, bh = task >> 6, b = bh >> 3, hd = bh & 7;
  const bf16_t* base = proj + (size_t)b * S * INW + hd * HD;
  const float log2g = __builtin_amdgcn_logf(1.f - exp2f(-5.f - (float)hd));
  const int qpos0 = n * 64 + 32 * half;
  bf16x8 qf[8];
#pragma unroll
  for (int s = 0; s < 8; ++s) qf[s] = *(const bf16x8*)(base + 3072 + (size_t)(qpos0 + r) * INW + 16 * s + 8 * h);
  f32x16 o[4];
#pragma unroll
  for (int cidx = 0; cidx < 4; ++cidx)
#pragma unroll
    for (int i = 0; i < 16; ++i) o[cidx][i] = 0.f;
  if (n > 0) {
    const bf16_t* pb = prevT + ((size_t)(bh * 32 + n) * 128 + r) * 128 + 8 * h;
#pragma unroll
    for (int cidx = 0; cidx < 4; ++cidx)
#pragma unroll
      for (int s = 0; s < 8; ++s) {
        const bf16x8 pf = *(const bf16x8*)(pb + (size_t)(32 * cidx) * 128 + 16 * s);
        o[cidx] = MFMA32(qf[s], pf, o[cidx]);
      }
#pragma unroll
    for (int i = 0; i < 16; ++i) {
      const float xi = __builtin_amdgcn_exp2f(log2g * (float)(32 * half + crow(i, h) + 1));
#pragma unroll
      for (int cidx = 0; cidx < 4; ++cidx) o[cidx][i] *= xi;
    }
  }
#pragma unroll 1
  for (int tile = 0; tile < 2; ++tile) {
    const int kpos0 = n * 64 + 32 * tile;
    u32x4 vr[8];
    vtile_load(vr, base + 5120 + (size_t)kpos0 * INW, lane);
    f32x16 st;
#pragma unroll
    for (int i = 0; i < 16; ++i) st[i] = 0.f;
#pragma unroll
    for (int s = 0; s < 8; ++s) {
      const bf16x8 kf = *(const bf16x8*)(base + 4096 + (size_t)(kpos0 + r) * INW + 16 * s + 8 * h);
      st = MFMA32(kf, qf[s], st);
    }
#pragma unroll
    for (int i = 0; i < 16; ++i) {
      const float dist = fabsf((float)((32 * half + r) - (32 * tile + crow(i, h))));
      st[i] *= SCALE * __builtin_amdgcn_exp2f(log2g * dist);
    }
    vtile_store(vr, wl, lane);
    wave_lds_fence();
    pv_accum(o, st, wl, lane);
  }
#pragma unroll
  for (int i = 0; i < 16; ++i) {
    const float mu = half_sum((o[0][i] + o[1][i]) + (o[2][i] + o[3][i])) * (1.f / 128.f);
    float d[4], qq = 0.f;
#pragma unroll
    for (int cidx = 0; cidx < 4; ++cidx) { d[cidx] = o[cidx][i] - mu; qq += d[cidx] * d[cidx]; }
    const float rr = rsqrtf(half_sum(qq) * (1.f / 128.f) + 1e-6f);
    const size_t tok = (size_t)(b * S + qpos0 + crow(i, h));
    const bf16_t* grow = proj + tok * INW + 6144 + hd * HD + r;
    bf16_t* orow = mixed + tok * D + 1024 + hd * HD + r;
#pragma unroll
    for (int cidx = 0; cidx < 4; ++cidx) {
      const float g = __uint_as_float((unsigned)grow[32 * cidx] << 16);
      const float sg = g / (1.f + __expf(-g));
      orow[32 * cidx] = (bf16_t)(pk2(d[cidx] * rr * rnw[hd * HD + 32 * cidx + r] * sg, 0.f) & 0xffffu);
    }
  }
}
constexpr int Q_STATE = NB * 8 * 16, Q_SB = NB * 8 * (S / 32), Q_QUANT = 2 * 16384 / 64, Q_TOTAL = Q_STATE + Q_SB + Q_QUANT;
__device__ __forceinline__ unsigned queue_pop(unsigned* ctr) {
  unsigned it = 0;
  if (mk_lane_id() == 0) it = __hip_atomic_fetch_add(ctr, 1u, __ATOMIC_RELAXED, __HIP_MEMORY_SCOPE_AGENT);
  return (unsigned)__builtin_amdgcn_readfirstlane((int)it);
}
__device__ __forceinline__ void p3_attn_a(const Ctx& c) {
  LAS unsigned char* wl = c.lds + c.wave * WAVE_LDS;
  const int gw = blockIdx.x * 8 + c.wave, NW = c.G * 8;
  for (int t = gw; t < Q_SB; t += NW) sb_task(c, t, wl);
  if (c.wave < 2) for (int t = blockIdx.x * 2 + c.wave; t < Q_STATE; t += c.G * 2) state_task(c, t, wl);
}
__device__ __forceinline__ void p4_attn_b(const Ctx& c) {
  LAS unsigned char* wl = c.lds + c.wave * WAVE_LDS;
  const int gw = blockIdx.x * 8 + c.wave, NW = c.G * 8;
  for (int t = gw; t < NB * 8 * 64; t += NW) retout_task(c, t, wl);
}

__device__ __forceinline__ void p5_ln1(const Ctx& c) {
  const bf16_t* y1 = (const bf16_t*)(c.ws + WS_Y1);
  bf16_t* x1b = (bf16_t*)(c.ws + WS_X1B);
  const float* w = c.in[5];
  const float* bb = c.in[6];
  const int lane = mk_lane_id(), gw = blockIdx.x * 8 + c.wave, NW = c.G * 8;
  for (int row = gw; row < T; row += NW) {
    const bf16_t* p = y1 + (size_t)row * D;
    f32x4 v[8];
    float s = 0.f;
#pragma unroll
    for (int i = 0; i < 8; ++i) {
      const uint2 r2 = *(const uint2*)(p + (i * 64 + lane) * 4);
      v[i] = (f32x4){bflo(r2.x), bfhi(r2.x), bflo(r2.y), bfhi(r2.y)};
      s += (v[i][0] + v[i][1]) + (v[i][2] + v[i][3]);
    }
    const float mu = wave_sum(s) * (1.f / D);
    float q = 0.f;
#pragma unroll
    for (int i = 0; i < 8; ++i) { const f32x4 d = v[i] - mu; q += (d[0] * d[0] + d[1] * d[1]) + (d[2] * d[2] + d[3] * d[3]); }
    const float rr = rsqrtf(wave_sum(q) * (1.f / D) + 1e-5f);
#pragma unroll
    for (int i = 0; i < 8; ++i) {
      const int col = (i * 64 + lane) * 4;
      const f32x4 wv = *(const f32x4*)(w + col), bv = *(const f32x4*)(bb + col);
      const f32x4 o = (v[i] - mu) * rr * wv + bv;
      uint2 pkd; pkd.x = pk2(o[0], o[1]); pkd.y = pk2(o[2], o[3]);
      *(uint2*)(x1b + (size_t)row * D + col) = pkd;
      v[i] = o;
    }
    float mx = 0.f;
#pragma unroll
    for (int i = 0; i < 8; ++i) mx = fmaxf(mx, fmaxf(fmaxf(fabsf(v[i][0]), fabsf(v[i][1])), fmaxf(fabsf(v[i][2]), fabsf(v[i][3]))));
    mx = fmaxf(wave_max(mx), 1e-30f);
    const float inv = 127.f / mx;
    unsigned* xq = (unsigned*)(c.ws + WS_X1Q + (size_t)row * D);
#pragma unroll
    for (int i = 0; i < 8; ++i) {
      unsigned w4 = 0;
#pragma unroll
      for (int k = 0; k < 4; ++k) { const int qv = (int)rintf(v[i][k] * inv); w4 |= ((unsigned)qv & 255u) << (8 * k); }
      xq[i * 64 + lane] = w4;
    }
    if (lane == 0) ((float*)(c.ws + WS_SX))[row] = mx * (1.f / 127.f);
  }
}

__device__ __forceinline__ void p7_route_naive(const Ctx& c) {
  const bf16_t* qp = (const bf16_t*)(c.ws + WS_QP);
  const float* sk = c.in[8];
  int* eidx = (int*)(c.ws + WS_EIDX);
  float* egate = (float*)(c.ws + WS_EGATE);
  const int lane = mk_lane_id(), gw = blockIdx.x * 8 + c.wave, NW = c.G * 8;
  const float NEG = -3.0e38f;
  LAS int* ke = (LAS int*)c.lds;
  LAS float* kg = (LAS float*)(c.lds + 512);
  int* sorted_e = (int*)(c.ws + WS_SE);
  float* sorted_g = (float*)(c.ws + WS_SG);
  for (int th = gw; th < T * 8; th += NW) {
    const int t = th >> 3, h = th & 7;
    float st0 = 0.f, st1 = 0.f; int it0 = 0, it1 = 0;
#pragma unroll 1
    for (int cc = 0; cc < 2; ++cc) {
      const bf16_t* q = qp + (size_t)t * D + h * 256 + cc * 128;
      const float* k0 = sk + ((size_t)((h * 2 + cc) * NKEYS + lane)) * 128;
      const float* k1 = k0 + 64 * 128;
      float v0 = 0.f, v1 = 0.f;
      for (int d = 0; d < 128; d += 4) {
        const uint2 qq = *(const uint2*)(q + d);
        const float q0 = bflo(qq.x), q1 = bfhi(qq.x), q2 = bflo(qq.y), q3 = bfhi(qq.y);
        const float4 a = *(const float4*)(k0 + d);
        const float4 bq = *(const float4*)(k1 + d);
        v0 += q0 * a.x + q1 * a.y + q2 * a.z + q3 * a.w;
        v1 += q0 * bq.x + q1 * bq.y + q2 * bq.z + q3 * bq.w;
      }
      float mys = 0.f; int myi = 0;
      for (int it = 0; it < 16; ++it) {
        const float m = wave_max(fmaxf(v0, v1));
        int cand = 9999;
        if (v1 == m) cand = lane + 64;
        if (v0 == m) cand = lane;
        const int sel = wave_min_i(cand);
        if (sel == lane) v0 = NEG;
        if (sel == lane + 64) v1 = NEG;
        if (lane == it) { mys = m; myi = sel; }
      }
      if (cc == 0) { st0 = mys; it0 = myi; } else { st1 = mys; it1 = myi; }
    }
    float cv[4];
#pragma unroll
    for (int j = 0; j < 4; ++j) cv[j] = __shfl(st0, lane >> 2) + __shfl(st1, (lane & 3) * 4 + j);
    float mybest = 0.f; int mypos = 0;
    for (int it = 0; it < 16; ++it) {
      const float lm = fmaxf(fmaxf(cv[0], cv[1]), fmaxf(cv[2], cv[3]));
      const float m = wave_max(lm);
      int cand = 9999;
#pragma unroll
      for (int j = 3; j >= 0; --j) if (cv[j] == m) cand = lane * 4 + j;
      const int sel = wave_min_i(cand);
#pragma unroll
      for (int j = 0; j < 4; ++j) if (sel == lane * 4 + j) cv[j] = NEG;
      if (lane == it) { mybest = m; mypos = sel; }
    }
    const float mx = __shfl(mybest, 0);
    const float e = (lane < 16) ? expf(mybest - mx) : 0.f;
    const float den = wave_sum(e);
    const int ia = __shfl(it0, mypos >> 4), ib = __shfl(it1, mypos & 15);
    if (lane < 16) {
      eidx[(size_t)th * 16 + lane] = ia * NKEYS + ib;
      egate[(size_t)th * 16 + lane] = e / den;
      ke[h * 16 + lane] = ia * NKEYS + ib;
      kg[h * 16 + lane] = e / den;
    }
    __syncthreads();
    if ((c.wave * 64 + mk_lane_id()) < 128) {
      const int me = ke[(c.wave * 64 + mk_lane_id())];
      int rank = 0;
      for (int j = 0; j < 128; ++j) { const int o = ke[j]; rank += (o < me || (o == me && j < (c.wave * 64 + mk_lane_id()))) ? 1 : 0; }
      sorted_e[(size_t)t * 128 + rank] = me;
      sorted_g[(size_t)t * 128 + rank] = kg[(c.wave * 64 + mk_lane_id())];
    }
    __syncthreads();
  }
}

__device__ __forceinline__ void p8_peer_naive(const Ctx& c) {
  const float* x1 = (const float*)(c.ws + WS_Y1);
  const int* eidx = (const int*)(c.ws + WS_EIDX);
  const float* egate = (const float*)(c.ws + WS_EGATE);
  const float* eu = c.in[9];
  const float* ev = c.in[10];
  const float* w = c.in[11];
  const float* bb = c.in[12];
  LAS float* xs = (LAS float*)c.lds;
  LAS float* hh = xs + D;
  LAS int* ei = (LAS int*)(hh + 128);
  LAS float* red = (LAS float*)(ei + 128);
  const int tid = (c.wave * 64 + mk_lane_id()), lane = mk_lane_id(), wv = c.wave;
  for (int t = blockIdx.x; t < T; t += c.G) {
    *(f32x4*)(xs + tid * 4) = *(const f32x4*)(x1 + (size_t)t * D + tid * 4);
    if (tid < 128) ei[tid] = eidx[(size_t)t * 128 + tid];
    __syncthreads();
    for (int a = wv * 16; a < wv * 16 + 16; ++a) {
      const float* u = eu + (size_t)ei[a] * D;
      float s = 0.f;
#pragma unroll
      for (int i = 0; i < 8; ++i) {
        const f32x4 uv = *(const f32x4*)(u + (i * 64 + lane) * 4);
        const f32x4 xv = *(const LAS f32x4*)(xs + (i * 64 + lane) * 4);
        s += uv[0] * xv[0] + uv[1] * xv[1] + uv[2] * xv[2] + uv[3] * xv[3];
      }
      s = wave_sum(s);
      const float act = 0.5f * s * (1.f + erff(s * 0.7071067811865476f));
      if (lane == 0) hh[a] = egate[(size_t)t * 128 + a] * act;
    }
    __syncthreads();
    f32x4 acc = {0.f, 0.f, 0.f, 0.f};
    for (int a = 0; a < 128; ++a) {
      const f32x4 v = *(const f32x4*)(ev + (size_t)ei[a] * D + tid * 4);
      acc += v * hh[a];
    }
    const f32x4 y = *(const LAS f32x4*)(xs + tid * 4) * ALPHA + acc;
    float s = wave_sum((y[0] + y[1]) + (y[2] + y[3]));
    if (lane == 0) red[wv] = s;
    __syncthreads();
    float mu = 0.f;
#pragma unroll
    for (int i = 0; i < 8; ++i) mu += red[i];
    mu *= (1.f / D);
    const f32x4 d = y - mu;
    float q = wave_sum((d[0] * d[0] + d[1] * d[1]) + (d[2] * d[2] + d[3] * d[3]));
    if (lane == 0) red[8 + wv] = q;
    __syncthreads();
    float var = 0.f;
#pragma unroll
    for (int i = 0; i < 8; ++i) var += red[8 + i];
    const float rr = rsqrtf(var * (1.f / D) + 1e-5f);
    const f32x4 wv4 = *(const f32x4*)(w + tid * 4), bv = *(const f32x4*)(bb + tid * 4);
    *(f32x4*)(c.out + (size_t)t * D + tid * 4) = d * rr * wv4 + bv;
    __syncthreads();
  }
}

__device__ __forceinline__ unsigned fkey(float f) { const unsigned u = __float_as_uint(f); return (u & 0x80000000u) ? ~u : (u | 0x80000000u); }
__device__ __forceinline__ float funkey(unsigned k) { return __uint_as_float((k & 0x80000000u) ? (k & 0x7fffffffu) : ~k); }
template <int N> __device__ __forceinline__ void sort_desc(unsigned (&a)[N]) {
#pragma unroll
  for (int k = 2; k <= N; k <<= 1)
#pragma unroll
    for (int j = k >> 1; j > 0; j >>= 1)
#pragma unroll
      for (int i = 0; i < N; ++i) {
        const int l = i ^ j;
        if (l > i) {
          const unsigned x = a[i], y = a[l], mx = x > y ? x : y, mn = x > y ? y : x;
          if ((i & k) == 0) { a[i] = mx; a[l] = mn; } else { a[i] = mn; a[l] = mx; }
        }
      }
}
__device__ __forceinline__ void merge16(unsigned (&a)[16], const unsigned (&b)[16]) {
#pragma unroll
  for (int i = 0; i < 16; ++i) { const unsigned y = b[15 - i]; a[i] = a[i] > y ? a[i] : y; }
#pragma unroll
  for (int j = 8; j > 0; j >>= 1)
#pragma unroll
    for (int i = 0; i < 16; ++i) {
      const int l = i ^ j;
      if (l > i) { const unsigned x = a[i], y = a[l]; a[i] = x > y ? x : y; a[l] = x > y ? y : x; }
    }
}
__device__ __forceinline__ void top16_of_64(const unsigned (&v)[64], unsigned (&out)[16]) {
  unsigned g[4][16];
#pragma unroll
  for (int q = 0; q < 4; ++q) {
#pragma unroll
    for (int i = 0; i < 16; ++i) g[q][i] = v[16 * q + i];
    sort_desc<16>(g[q]);
  }
  merge16(g[0], g[1]); merge16(g[2], g[3]); merge16(g[0], g[2]);
#pragma unroll
  for (int i = 0; i < 16; ++i) out[i] = g[0][i];
}
constexpr int ROUTE_KE_OFF = 81920;
constexpr int ROUTE_KG_OFF = ROUTE_KE_OFF + 16384;
struct StairTab { int a[64], b[64]; };
__host__ __device__ constexpr StairTab make_stair() {
  StairTab t{}; int n = 0;
  for (int a = 0; a < 16; ++a) for (int b = 0; b < 16; ++b) if ((a + 1) * (b + 1) <= 16) { t.a[n] = a; t.b[n] = b; ++n; }
  for (; n < 64; ++n) { t.a[n] = -1; t.b[n] = -1; }
  return t;
}
__device__ __forceinline__ void p8_route(const Ctx& c) {
  const bf16_t* qp = (const bf16_t*)(c.ws + WS_QP);
  const bf16_t* skb = (const bf16_t*)(c.ws + WS_SKB);
  int* sorted_e = (int*)(c.ws + WS_SE);
  float* sorted_g = (float*)(c.ws + WS_SG);
  const int lane = mk_lane_id(), r = lane & 31, hh = lane >> 5, head = c.wave;
  LAS unsigned char* wl = c.lds + c.wave * WAVE_LDS;
  LAS int* ke = (LAS int*)(c.lds + ROUTE_KE_OFF);
  LAS float* kg = (LAS float*)(c.lds + ROUTE_KG_OFF);
  constexpr StairTab ST = make_stair();
  for (int tg = blockIdx.x; tg < T / 32; tg += c.G) {
    const int t0 = tg * 32;
    unsigned top[2][16];
#pragma unroll
    for (int cc = 0; cc < 2; ++cc) {
      bf16x8 qf[8];
#pragma unroll
      for (int s = 0; s < 8; ++s) qf[s] = *(const bf16x8*)(qp + (size_t)(t0 + r) * D + head * 256 + cc * 128 + 16 * s + 8 * hh);
      unsigned mine[16];
#pragma unroll
      for (int kt = 0; kt < 4; ++kt) {
        f32x16 sc;
#pragma unroll
        for (int i = 0; i < 16; ++i) sc[i] = 0.f;
        const bf16_t* krow_p = skb + ((size_t)((head * 2 + cc) * NKEYS + 32 * kt + r)) * 128 + 8 * hh;
#pragma unroll
        for (int s = 0; s < 8; ++s) sc = MFMA32(*(const bf16x8*)(krow_p + 16 * s), qf[s], sc);
        unsigned v[16];
#pragma unroll
        for (int i = 0; i < 16; ++i) {
          const int kidx = 32 * kt + (i & 3) + 8 * (i >> 2) + 4 * hh;
          v[i] = (fkey(sc[i]) & ~127u) | (unsigned)(127 - kidx);
        }
        sort_desc<16>(v);
        if (kt == 0) {
#pragma unroll
          for (int i = 0; i < 16; ++i) mine[i] = v[i];
        } else merge16(mine, v);
        __builtin_amdgcn_sched_barrier(0);
      }
      unsigned other[16];
#pragma unroll
      for (int i = 0; i < 16; ++i) other[i] = (unsigned)__shfl_xor((int)mine[i], 32);
      merge16(mine, other);
#pragma unroll
      for (int i = 0; i < 16; ++i) top[cc][i] = mine[i];
    }
    float f0[16], f1[16];
#pragma unroll
    for (int i = 0; i < 16; ++i) { f0[i] = funkey(top[0][i] & ~127u); f1[i] = funkey(top[1][i] & ~127u); }
    unsigned best[16];
#pragma unroll
    for (int q = 0; q < 4; ++q) {
      unsigned cv[16];
#pragma unroll
      for (int i = 0; i < 16; ++i) {
        const int n = 16 * q + i;
        if (ST.a[n] >= 0) cv[i] = (fkey(f0[ST.a[n]] + f1[ST.b[n]]) & ~255u) | (unsigned)(255 - (ST.a[n] * 16 + ST.b[n]));
        else cv[i] = 0u;
      }
      sort_desc<16>(cv);
      if (q == 0) {
#pragma unroll
        for (int i = 0; i < 16; ++i) best[i] = cv[i];
      } else merge16(best, cv);
      __builtin_amdgcn_sched_barrier(0);
    }
    LAS unsigned* tb = (LAS unsigned*)(wl + lane * 32);
#pragma unroll
    for (int w4 = 0; w4 < 4; ++w4) {
      unsigned p0 = 0, p1 = 0;
#pragma unroll
      for (int k = 0; k < 4; ++k) { p0 |= (127u - (top[0][4 * w4 + k] & 127u)) << (8 * k); p1 |= (127u - (top[1][4 * w4 + k] & 127u)) << (8 * k); }
      tb[w4] = p0; tb[4 + w4] = p1;
    }
    wave_lds_fence();
    const float mx = funkey(best[0] & ~255u);
    float ex[16], den = 0.f;
#pragma unroll
    for (int i = 0; i < 16; ++i) { ex[i] = __expf(funkey(best[i] & ~255u) - mx); den += ex[i]; }
    const float inv = 1.f / den;
#pragma unroll
    for (int i = 0; i < 8; ++i) {
      const unsigned bk = hh ? best[8 + i] : best[i];
      const float gt = (hh ? ex[8 + i] : ex[i]) * inv;
      const int pos = 255 - (int)(bk & 255u);
      const int ia = ((LAS unsigned char*)tb)[pos >> 4], ib = ((LAS unsigned char*)tb)[16 + (pos & 15)];
      ke[r * 128 + head * 16 + 8 * hh + i] = ia * NKEYS + ib;
      kg[r * 128 + head * 16 + 8 * hh + i] = gt;
    }
    __syncthreads();
    {
      const int tt = (c.wave * 64 + mk_lane_id()) >> 4, e8 = ((c.wave * 64 + mk_lane_id()) & 15) * 8;
      int me[8], rank[8];
#pragma unroll
      for (int j = 0; j < 8; ++j) { me[j] = ke[tt * 128 + e8 + j]; rank[j] = 0; }
      for (int o = 0; o < 128; ++o) {
        const int ov = ke[tt * 128 + o];
#pragma unroll
        for (int j = 0; j < 8; ++j) rank[j] += (ov < me[j] || (ov == me[j] && o < e8 + j)) ? 1 : 0;
      }
#if defined(MK_NOSORT)
#pragma unroll
      for (int j = 0; j < 8; ++j) rank[j] = e8 + j;
#endif
#pragma unroll
      for (int j = 0; j < 8; ++j) {
        sorted_e[(size_t)(t0 + tt) * 128 + rank[j]] = me[j];
        sorted_g[(size_t)(t0 + tt) * 128 + rank[j]] = kg[tt * 128 + e8 + j];
      }
    }
    __syncthreads();
  }
}

typedef __bf16 bf16x2v __attribute__((ext_vector_type(2)));
__device__ __forceinline__ float dot2bf(unsigned a, unsigned b, float acc) {
  return __builtin_amdgcn_fdot2_f32_bf16(__builtin_bit_cast(bf16x2v, a), __builtin_bit_cast(bf16x2v, b), acc, false);
}
__device__ __forceinline__ int rdlane_i(int v, int l) { return __builtin_amdgcn_readlane(v, l); }
__device__ __forceinline__ float rdlane_f(float v, int l) { return __int_as_float(__builtin_amdgcn_readlane(__float_as_int(v), l)); }
template <int CTRL> __device__ __forceinline__ int dpp_mov_i(int v) { return __builtin_amdgcn_update_dpp(0, v, CTRL, 0xf, 0xf, true); }
__device__ __forceinline__ int wave_sum_i_dpp(int v) {
  v += dpp_mov_i<0xB1>(v);
  v += dpp_mov_i<0x4E>(v);
  v += dpp_mov_i<0x141>(v);
  v += dpp_mov_i<0x140>(v);
  return __builtin_amdgcn_readlane(v, 0) + __builtin_amdgcn_readlane(v, 16) + __builtin_amdgcn_readlane(v, 32) + __builtin_amdgcn_readlane(v, 48);
}
__device__ __forceinline__ float gelu_as(float v) {
  const float av = fabsf(v), t = __builtin_amdgcn_rcpf(av * 0.2316418882f + 1.0f);
  float q = t * 0.5307027145f + (-0.7265760135f); q = q * t + 0.7107068705f; q = q * t + (-0.142248368f); q = q * t + 0.127414796f; q = q * t;
  const float e = __builtin_amdgcn_exp2f((v * v) * (-0.72134752044f));
  const float m = v * (q * e);
  return v < 0.f ? m : v - m;
}
constexpr int PEER_D1 = 8, PEER_D2 = 2;
__device__ __forceinline__ void p9_peer(const Ctx& c) {
  const unsigned char* x1q = (const unsigned char*)(c.ws + WS_X1Q);
  const float* sx = (const float*)(c.ws + WS_SX);
  const bf16_t* x1b = (const bf16_t*)(c.ws + WS_X1B);
  const int* sorted_e = (const int*)(c.ws + WS_SE);
  const float* sorted_g = (const float*)(c.ws + WS_SG);
  const unsigned char* uq = (const unsigned char*)(c.ws + WS_UQ);
  const unsigned char* vq = (const unsigned char*)(c.ws + WS_VQ);
  const float* su = (const float*)(c.ws + WS_SU);
  const float* sv = (const float*)(c.ws + WS_SV);
  const float* lw = c.in[11];
  const float* lb = c.in[12];
  const int lane = mk_lane_id(), gw = blockIdx.x * 8 + c.wave, NW = c.G * 8;
  LAS int* le = (LAS int*)(c.lds + c.wave * WAVE_LDS);
  LAS float* lsc = (LAS float*)(le + 512);
  LAS float* lg = lsc + 512;
  LAS float* lh = lg + 512;
  LAS int* lpi = (LAS int*)(lh + 512);
  for (int tb = gw * 4; tb < T; tb += NW * 4) {
    int lq = lane;
    asm volatile("" : "+v"(lq));
    u32x4 xr[4][2];
#pragma unroll
    for (int tk = 0; tk < 4; ++tk) {
      const size_t t = (size_t)(tb + tk);
      const float sxt = sx[t];
#pragma unroll
      for (int hh = 0; hh < 2; ++hh) {
        const int e = sorted_e[t * 128 + 64 * hh + lq];
        le[tk * 128 + 64 * hh + lq] = e;
        lsc[tk * 128 + 64 * hh + lq] = su[e] * sxt;
        lg[tk * 128 + 64 * hh + lq] = sorted_g[t * 128 + 64 * hh + lq] * sv[e];
      }
#pragma unroll
      for (int i = 0; i < 2; ++i) xr[tk][i] = *(const u32x4*)(x1q + t * D + 1024 * i + 16 * lq);
    }
    wave_lds_fence();
#pragma unroll 1
    for (int hf = 0; hf < 2; ++hf) {
      u32x4 rows[PEER_D1][4];
#define PEER_ISSUE1(SL, P) do { _Pragma("unroll") for (int tk_ = 0; tk_ < 4; ++tk_) \
        rows[SL][tk_] = *(const u32x4*)(uq + (size_t)__builtin_amdgcn_readfirstlane(le[tk_ * 128 + (P)]) * D + 1024 * hf + 16 * lane); } while (0)
#define PEER_CONSUME1(SL, P) do { _Pragma("unroll") for (int tk_ = 0; tk_ < 4; ++tk_) { int ia_ = 0, ib_ = 0; \
        const u32x4 xh_ = hf ? xr[tk_][1] : xr[tk_][0]; \
        ia_ = __builtin_amdgcn_sdot4((int)rows[SL][tk_][0], (int)xh_[0], ia_, false); ib_ = __builtin_amdgcn_sdot4((int)rows[SL][tk_][1], (int)xh_[1], ib_, false); \
        ia_ = __builtin_amdgcn_sdot4((int)rows[SL][tk_][2], (int)xh_[2], ia_, false); ib_ = __builtin_amdgcn_sdot4((int)rows[SL][tk_][3], (int)xh_[3], ib_, false); \
        const int part_ = wave_sum_i_dpp(ia_ + ib_); \
        if (hf == 0) { if (lane == 0) lpi[tk_ * 128 + (P)] = part_; } \
        else { const float sacc_ = (float)(part_ + lpi[tk_ * 128 + (P)]) * lsc[tk_ * 128 + (P)]; \
               if (lane == 0) lh[tk_ * 128 + (P)] = gelu_as(sacc_) * lg[tk_ * 128 + (P)]; } } } while (0)
#pragma unroll
      for (int sl = 0; sl < PEER_D1; ++sl) PEER_ISSUE1(sl, sl);
#pragma unroll 1
      for (int p0 = 0; p0 < 128 - PEER_D1; p0 += PEER_D1) {
#pragma unroll
        for (int sl = 0; sl < PEER_D1; ++sl) { PEER_CONSUME1(sl, p0 + sl); PEER_ISSUE1(sl, p0 + sl + PEER_D1); }
      }
#pragma unroll
      for (int sl = 0; sl < PEER_D1; ++sl) PEER_CONSUME1(sl, 128 - PEER_D1 + sl);
#undef PEER_ISSUE1
#undef PEER_CONSUME1
      wave_lds_fence();
    }
    wave_lds_fence();
    int lcol = 16 * lane;
    asm volatile("" : "+v"(lcol));
#pragma unroll 1
    for (int hf = 0; hf < 2; ++hf) {
      float acc[4][16], hsum[4];
#pragma unroll
      for (int tk = 0; tk < 4; ++tk) {
        hsum[tk] = 0.f;
#pragma unroll
        for (int j = 0; j < 4; ++j) {
          const uint2 xv = *(const uint2*)(x1b + (size_t)(tb + tk) * D + 1024 * hf + lcol + 4 * j);
          acc[tk][4 * j + 0] = ALPHA * bflo(xv.x); acc[tk][4 * j + 1] = ALPHA * bfhi(xv.x); acc[tk][4 * j + 2] = ALPHA * bflo(xv.y); acc[tk][4 * j + 3] = ALPHA * bfhi(xv.y);
        }
      }
      u32x4 rows[PEER_D2][4]; float hw[PEER_D2][4];
#define PEER_ISSUE2(SL, P) do { _Pragma("unroll") for (int tk_ = 0; tk_ < 4; ++tk_) { \
        rows[SL][tk_] = *(const u32x4*)(vq + (size_t)__builtin_amdgcn_readfirstlane(le[tk_ * 128 + (P)]) * D + 1024 * hf + 16 * lane); \
        hw[SL][tk_] = lh[tk_ * 128 + (P)]; } } while (0)
#define PEER_CONSUME2(SL) do { _Pragma("unroll") for (int tk_ = 0; tk_ < 4; ++tk_) { const float hv_ = hw[SL][tk_]; hsum[tk_] += hv_; \
        _Pragma("unroll") for (int j_ = 0; j_ < 4; ++j_) { const unsigned w_ = rows[SL][tk_][j_]; \
          acc[tk_][4 * j_ + 0] += hv_ * (float)(w_ & 255u); acc[tk_][4 * j_ + 1] += hv_ * (float)((w_ >> 8) & 255u); \
          acc[tk_][4 * j_ + 2] += hv_ * (float)((w_ >> 16) & 255u); acc[tk_][4 * j_ + 3] += hv_ * (float)(w_ >> 24); } } } while (0)
#pragma unroll
      for (int sl = 0; sl < PEER_D2; ++sl) PEER_ISSUE2(sl, sl);
#pragma unroll 1
      for (int p0 = 0; p0 < 128 - PEER_D2; p0 += PEER_D2) {
#pragma unroll
        for (int sl = 0; sl < PEER_D2; ++sl) { PEER_CONSUME2(sl); PEER_ISSUE2(sl, p0 + sl + PEER_D2); }
      }
#pragma unroll
      for (int sl = 0; sl < PEER_D2; ++sl) PEER_CONSUME2(sl);
#undef PEER_ISSUE2
#undef PEER_CONSUME2
#pragma unroll
      for (int tk = 0; tk < 4; ++tk)
#pragma unroll
        for (int j = 0; j < 4; ++j) {
          f32x4 o;
#pragma unroll
          for (int k = 0; k < 4; ++k) o[k] = acc[tk][4 * j + k] - 128.f * hsum[tk];
          *(f32x4*)(c.out + (size_t)(tb + tk) * D + 1024 * hf + lcol + 4 * j) = o;
        }
    }
    asm volatile("" : "+v"(lcol));
#pragma unroll 1
    for (int tk = 0; tk < 4; ++tk) {
      float* orow = c.out + (size_t)(tb + tk) * D + lcol;
      f32x4 y[8];
      float ssum = 0.f;
#pragma unroll
      for (int i = 0; i < 8; ++i) { y[i] = *(const f32x4*)(orow + 1024 * (i >> 2) + 4 * (i & 3)); ssum += (y[i][0] + y[i][1]) + (y[i][2] + y[i][3]); }
      const float mu = wave_sum(ssum) * (1.f / D);
      float q = 0.f;
#pragma unroll
      for (int i = 0; i < 8; ++i) { y[i] = y[i] - mu; q += (y[i][0] * y[i][0] + y[i][1] * y[i][1]) + (y[i][2] * y[i][2] + y[i][3] * y[i][3]); }
      const float rr = rsqrtf(wave_sum(q) * (1.f / D) + 1e-5f);
#pragma unroll
      for (int i = 0; i < 8; ++i) {
        const int col = 1024 * (i >> 2) + 4 * (i & 3);
        const f32x4 wv = *(const f32x4*)(lw + lcol + col), bv = *(const f32x4*)(lb + lcol + col);
        *(f32x4*)(orow + col) = y[i] * rr * wv + bv;
      }
    }
    wave_lds_fence();
  }
}

#ifndef MK_N_LAUNCHES
#define MK_N_LAUNCHES 1
#endif
constexpr int NPHASE = 9;
#ifndef MK_PROBE_PHASE
#define MK_PROBE_PHASE -1
#define MK_PROBE_REPS 1
#endif
struct Args { const float* in[13]; float* out; unsigned char* ws; int ph_lo, ph_hi; };

__global__ void __launch_bounds__(NTHR, 2) k_main(Args a) {
  extern __shared__ __attribute__((aligned(16))) unsigned char lds_raw[];
  Ctx c;
#pragma unroll
  for (int i = 0; i < 13; ++i) c.in[i] = a.in[i];
  c.out = a.out; c.ws = a.ws; c.lds = (LAS unsigned char*)lds_raw;
  c.wave = __builtin_amdgcn_readfirstlane((int)(threadIdx.x >> 6)); c.G = gridDim.x;
  volatile LAS unsigned* misc = (volatile LAS unsigned*)(c.lds + pg8::STAGE_BYTES);
  if (c.wave == 0 && mk_lane_id() < 16) misc[mk_lane_id()] = 0u;
  __syncthreads();
  const int lo = a.ph_lo, hi = a.ph_hi;
  XcdBarrier bar; bar.wave = (unsigned)c.wave; bar.bar = (unsigned*)(c.ws + WS_CTL); bar.x = 0; bar.st = misc;
  if (hi - lo > 1) bar = xcd_barrier_post((unsigned*)(c.ws + WS_CTL), misc, (unsigned)c.wave);
  bf16_t* xb = (bf16_t*)(c.ws + WS_XB);
#define IN(k) (lo <= (k) && (k) < hi)
#ifndef MK_ONLY
#define MK_ONLY -1
#endif
#define PHASE(k, ...) do { if (IN(k) && (MK_ONLY < 0 || MK_ONLY == (k))) { \
    _Pragma("unroll 1") for (int it_ = 0; it_ < (((k) == MK_PROBE_PHASE) ? MK_PROBE_REPS : 1); ++it_) { if (it_ > 0) xcd_barrier(bar); __VA_ARGS__; } \
    if (IN((k) + 1)) xcd_barrier(bar); } } while (0)
  PHASE(0, p0_prologue(c));
  PHASE(1, {
    pg8::Gemm g{xb, (const bf16_t*)(c.ws + WS_WIN), T, INW, D};
    pg8::StaticOrder so; so.init(T, INW, c.G, (int)blockIdx.x);
    pg8::EpiProjRot E{(bf16_t*)(c.ws + WS_PROJ), INW, 3072, 5120, (const float*)(c.ws + WS_ROT), (const float*)(c.ws + WS_ROT) + S * 64, S - 1};
    pg8::gemm_phase<pg8::EpiProjRot, pg8::StaticOrder, false>(c.lds, g, so, E, nullptr, c.wave);
    { const int nfull = so.nwg % c.G;
      if (nfull != 0 && (int)blockIdx.x >= nfull) { const int nq = (c.G - nfull) * 8, per = (2 * 16384 + nq - 1) / nq, r0 = (((int)blockIdx.x - nfull) * 8 + c.wave) * per;
        if (r0 < 2 * 16384) quant_rows(c, r0, min(per, 2 * 16384 - r0)); } } });
  PHASE(2, p3_attn_a(c));
  PHASE(3, p4_attn_b(c));
  PHASE(4, {
    pg8::Gemm g{(const bf16_t*)(c.ws + WS_MIXED), (const bf16_t*)(c.ws + WS_WOUT), T, D, D};
    pg8::StaticOrder so; so.init(T, D, c.G, (int)blockIdx.x);
    pg8::EpiResBf16 E{(bf16_t*)(c.ws + WS_Y1), D, (const bf16_t*)(c.ws + WS_XB), ALPHA};
    pg8::gemm_phase<pg8::EpiResBf16, pg8::StaticOrder, false>(c.lds, g, so, E, nullptr, c.wave); });
  PHASE(5, { p5_ln1(c); if (((T / 256) * (INW / 256)) % c.G == 0) for (int rr0 = (blockIdx.x * 8 + c.wave) * 16; rr0 < 2 * 16384; rr0 += c.G * 8 * 16) quant_rows(c, rr0, 16); });
  PHASE(6, {
    pg8::Gemm g{(const bf16_t*)(c.ws + WS_X1B), (const bf16_t*)(c.ws + WS_WPQ), T, D, D};
    pg8::StaticOrder so; so.init(T, D, c.G, (int)blockIdx.x);
    pg8::EpiBf16Plain E{(bf16_t*)(c.ws + WS_QP), D};
    pg8::gemm_phase<pg8::EpiBf16Plain, pg8::StaticOrder, false>(c.lds, g, so, E, nullptr, c.wave); });
  PHASE(7, p8_route(c));
  PHASE(8, p9_peer(c));
#undef PHASE
#undef IN
}
}

extern "C" void kernel_launch(void* const* d_in, const int* in_sizes, int n_in, void* d_out, int out_size, void* d_ws, size_t ws_size,
                              hipStream_t stream) {
  using namespace mk;
  static int grid = 0;
  if (grid == 0) {
    if (n_in != 13 || ws_size < WS_END) { grid = -1; return; }
    int dev = 0, cus = 0, per_cu = 0;
    if (hipGetDevice(&dev) != hipSuccess || hipDeviceGetAttribute(&cus, hipDeviceAttributeMultiprocessorCount, dev) != hipSuccess) { grid = -1; return; }
    if (hipFuncSetAttribute((const void*)k_main, hipFuncAttributeMaxDynamicSharedMemorySize, LDS_BYTES) != hipSuccess) { grid = -1; return; }
    if (hipOccupancyMaxActiveBlocksPerMultiprocessor(&per_cu, (const void*)k_main, NTHR, LDS_BYTES) != hipSuccess || per_cu < 1) { (void)hipGetLastError(); per_cu = 1; }
    grid = cus;
  }
  if (grid < 0) return;
  (void)hipMemsetAsync((char*)d_ws + WS_CTL, 0, CTL_BYTES, stream);
  Args a{};
  for (int i = 0; i < 13; ++i) a.in[i] = (const float*)d_in[i];
  a.out = (float*)d_out; a.ws = (unsigned char*)d_ws;
#if MK_N_LAUNCHES == 1
  a.ph_lo = 0; a.ph_hi = NPHASE;
  hipLaunchKernelGGL(k_main, dim3(grid), dim3(NTHR), LDS_BYTES, stream, a);
#else
  for (int p = 0; p < NPHASE; ++p) { a.ph_lo = p; a.ph_hi = p + 1; hipLaunchKernelGGL(k_main, dim3(grid), dim3(NTHR), LDS_BYTES, stream, a); }
#endif
}
```
